# Optimizing an MI355X kernel written in HIP

```python
import jax
import jax.numpy as jnp
from jax import lax
import numpy as np

D_MODEL = 1024
BATCH = 4
SEQ = 4096
DEPTH = 2

GRID_W = 64
CTX_LEN = 256
HEAD_DIM = 64
D_MIX = 1024
RWKV_HEADS = 4
RWKV_W = RWKV_HEADS * HEAD_DIM
DECAY_LORA = 64
ICLR_LORA = 64
GATE_LORA = 128
GQA_HEADS = 4
GQA_KV_HEADS = 2
GQA_W = GQA_HEADS * HEAD_DIM
GQA_KV_W = GQA_KV_HEADS * HEAD_DIM
MLA_HEADS = 4
MLA_NOPE = 64
MLA_ROPE = 32
MLA_V = 64
MLA_Q_LORA = 256
MLA_KV_LORA = 128
NAT_HEADS = 4
NAT_W = NAT_HEADS * HEAD_DIM
NAT_WIN_R = 8
NAT_WIN_C = 16
D_FF = 2816
N_EXPERTS = 8
TOP_K = 2
Q_BLOCK = 128
ROPE_THETA = 10000.0
RMS_EPS = 1e-6
GN_EPS = 64e-5
RWKV_COLS = 3 * RWKV_W + DECAY_LORA + ICLR_LORA + GATE_LORA
GQA_COLS = GQA_W + 2 * GQA_KV_W
MLA_COLS = MLA_Q_LORA + MLA_KV_LORA + MLA_ROPE
NAT_COLS = 3 * NAT_W
IN_COLS = RWKV_COLS + GQA_COLS + MLA_COLS + NAT_COLS
GROUP_SPLITS = [RWKV_COLS, RWKV_COLS + GQA_COLS, RWKV_COLS + GQA_COLS + MLA_COLS]
RWKV_SPLITS = [RWKV_W, 2 * RWKV_W, 3 * RWKV_W, 3 * RWKV_W + DECAY_LORA, 3 * RWKV_W + DECAY_LORA + ICLR_LORA]
N_DENSE = (DEPTH + 1) // 2
N_MOE = DEPTH // 2

kernel_name = 'hybrid_diffusion_parallel_heads'

f32 = jnp.float32


def rms_norm(x, g, eps=RMS_EPS):
    xf = x.astype(f32)
    y = xf * lax.rsqrt(jnp.mean(jnp.square(xf), axis=-1, keepdims=True) + eps)
    return (y * g.astype(f32)).astype(x.dtype)


def heads(t, n):
    return t.reshape(t.shape[:-1] + (n, t.shape[-1] // n))


def to_heads_first(t):
    return t.transpose(0, 2, 1, 3)


def q_groups(q, n_groups):
    B, T, H, d = q.shape
    return q.reshape(B, T, n_groups, H // n_groups, d).transpose(0, 2, 3, 1, 4)


def merge_groups(o):
    B, G, R, T, d = o.shape
    return o.transpose(0, 3, 1, 2, 4).reshape(B, T, G * R * d)


def axial_rope_tables(n, rot_dim):
    t = jnp.arange(n)
    row = (t // GRID_W).astype(f32)
    col = (t % GRID_W).astype(f32)
    quarter = rot_dim // 4
    inv_freq = ROPE_THETA ** (-jnp.arange(quarter, dtype=f32) / quarter)
    ang = jnp.concatenate([row[:, None] * inv_freq, col[:, None] * inv_freq], axis=-1)
    return jnp.cos(ang)[:, None, :], jnp.sin(ang)[:, None, :]


def apply_rope(x, cos, sin):
    half = x.shape[-1] // 2
    x1 = x[..., :half].astype(f32)
    x2 = x[..., half:].astype(f32)
    return jnp.concatenate([x1 * cos - x2 * sin, x1 * sin + x2 * cos], axis=-1).astype(x.dtype)


def attend(q, k, v, scale):
    s = jnp.einsum('bgrqd,bgkd->bgrqk', q, k).astype(f32) * scale
    p = jax.nn.softmax(s, axis=-1).astype(v.dtype)
    return jnp.einsum('bgrqk,bgkd->bgrqd', p, v)


def blocked_attend(q, k, v, scale):
    B, G, R, N, dq = q.shape
    nb = N // Q_BLOCK
    qb = jnp.moveaxis(q.reshape(B, G, R, nb, Q_BLOCK, dq), 3, 0)
    ob = lax.map(lambda qi: attend(qi, k, v, scale), qb)
    return jnp.moveaxis(ob, 0, 3).reshape(B, G, R, N, v.shape[-1])


def centred_shift(p):
    zero = jnp.zeros_like(p[:, :1])
    prev = jnp.concatenate([zero, p[:, :-1]], axis=1)
    nxt = jnp.concatenate([p[:, 1:], zero], axis=1)
    return 0.5 * (prev + nxt)


def rwkv_step(S, inp):
    r, w, k, v, kk, a = inp
    sa = jnp.einsum('bhvk,bhk->bhv', S, -kk)
    S = S * w[:, :, None, :] + sa[..., None] * (kk * a)[:, :, None, :] + v[..., None] * k[:, :, None, :]
    return S, jnp.einsum('bhvk,bhk->bhv', S, r)


def rwkv_scan(seqs):
    B, T, H, dh = seqs[0].shape
    tm = tuple(jnp.moveaxis(s.astype(f32), 1, 0) for s in seqs)
    _, y = lax.scan(rwkv_step, jnp.zeros((B, H, dh, dh), f32), tm)
    return jnp.moveaxis(y, 0, 1)


def rwkv_mixer(p_lat, p_ctx, mu, w0, w_up, a0, a_up, g_up, k_k, k_a, r_k, ln_g, ln_b, need_ctx):
    n_ctx = p_ctx.shape[1]

    def shared(p):
        p = p + mu * (centred_shift(p) - p)
        r, k, v, xw, xa, xg = jnp.split(p, RWKV_SPLITS, axis=-1)
        kk = heads(k * k_k, RWKV_HEADS).astype(f32)
        kk = kk * lax.rsqrt(jnp.sum(kk * kk, axis=-1, keepdims=True) + 1e-12)
        return r, k, v, xw, xa, xg, kk

    def directional(f, d):
        r, k, v, xw, xa, _, kk = f
        w_log = -jax.nn.softplus(-(w0[d] + jnp.tanh(xw) @ w_up[d])) - 0.5
        decay = jnp.exp(-jnp.exp(w_log.astype(f32)))
        a = jax.nn.sigmoid(a0[d] + xa @ a_up[d])
        kd = k * (1.0 + (a - 1.0) * k_a)
        return tuple(heads(t, RWKV_HEADS) for t in (r, decay, kd, v)) + (kk, heads(a, RWKV_HEADS))

    def read_out(y, dirf):
        r, _, kd, v = dirf[:4]
        mean = jnp.mean(y, axis=-1, keepdims=True)
        var = jnp.mean(jnp.square(y - mean), axis=-1, keepdims=True)
        yn = ((y - mean) * lax.rsqrt(var + GN_EPS)).reshape(y.shape[:2] + (RWKV_W,))
        yn = yn * ln_g.astype(f32) + ln_b.astype(f32)
        bonus = jnp.sum((r * kd * r_k).astype(f32), axis=-1, keepdims=True) * v.astype(f32)
        return yn + bonus.reshape(yn.shape)

    f_lat, f_ctx = shared(p_lat), shared(p_ctx)
    outs_lat, outs_ctx = [], []
    for d in range(2):
        d_lat, d_ctx = directional(f_lat, d), directional(f_ctx, d)
        if d == 0:
            seqs = tuple(jnp.concatenate([sc, sl], axis=1) for sc, sl in zip(d_ctx, d_lat))
        else:
            seqs = tuple(jnp.concatenate([sc[:, ::-1], sl[:, ::-1]], axis=1) for sc, sl in zip(d_ctx, d_lat))
        y = rwkv_scan(seqs)
        y_ctx, y_lat = y[:, :n_ctx], y[:, n_ctx:]
        if d == 1:
            y_ctx, y_lat = y_ctx[:, ::-1], y_lat[:, ::-1]
        outs_lat.append(read_out(y_lat, d_lat))
        if need_ctx:
            outs_ctx.append(read_out(y_ctx, d_ctx))
    y_lat = ((outs_lat[0] + outs_lat[1]) * (jax.nn.sigmoid(f_lat[5]) @ g_up)).astype(p_lat.dtype)
    y_ctx = None
    if need_ctx:
        y_ctx = ((outs_ctx[0] + outs_ctx[1]) * (jax.nn.sigmoid(f_ctx[5]) @ g_up)).astype(p_ctx.dtype)
    return y_lat, y_ctx


def gqa_mixer(p_lat, p_ctx, q_g, k_g, cos, sin, need_ctx):
    scale = HEAD_DIM ** -0.5

    def split(p):
        return jnp.split(p, [GQA_W, GQA_W + GQA_KV_W], axis=-1)

    q_l, k_l, v_l = split(p_lat)
    q_c, k_c, v_c = split(p_ctx)
    q_l = apply_rope(rms_norm(heads(q_l, GQA_HEADS), q_g), cos, sin)
    k_l = apply_rope(rms_norm(heads(k_l, GQA_KV_HEADS), k_g), cos, sin)
    k_c = rms_norm(heads(k_c, GQA_KV_HEADS), k_g)
    v_l, v_c = heads(v_l, GQA_KV_HEADS), heads(v_c, GQA_KV_HEADS)
    keys = to_heads_first(jnp.concatenate([k_l, k_c], axis=1))
    vals = to_heads_first(jnp.concatenate([v_l, v_c], axis=1))
    y_lat = merge_groups(blocked_attend(q_groups(q_l, GQA_KV_HEADS), keys, vals, scale))
    y_ctx = None
    if need_ctx:
        q_c = rms_norm(heads(q_c, GQA_HEADS), q_g)
        y_ctx = merge_groups(attend(q_groups(q_c, GQA_KV_HEADS), to_heads_first(k_c), to_heads_first(v_c), scale))
    return y_lat, y_ctx


def mla_mixer(p_lat, p_ctx, q_norm_g, w_uq, kv_norm_g, w_ukv, cos, sin, need_ctx):
    scale = (MLA_NOPE + MLA_ROPE) ** -0.5

    def split(p):
        return jnp.split(p, [MLA_Q_LORA, MLA_Q_LORA + MLA_KV_LORA], axis=-1)

    def queries(cq, rope):
        q = heads(rms_norm(cq, q_norm_g) @ w_uq, MLA_HEADS)
        q_nope, q_rope = q[..., :MLA_NOPE], q[..., MLA_NOPE:]
        if rope:
            q_rope = apply_rope(q_rope, cos, sin)
        return jnp.concatenate([q_nope, q_rope], axis=-1)

    def keys_values(ckv, kr, rope):
        kv = heads(rms_norm(ckv, kv_norm_g) @ w_ukv, MLA_HEADS)
        k_nope, v = kv[..., :MLA_NOPE], kv[..., MLA_NOPE:]
        kr = kr[:, :, None, :]
        if rope:
            kr = apply_rope(kr, cos, sin)
        k = jnp.concatenate([k_nope, jnp.broadcast_to(kr, k_nope.shape[:-1] + (MLA_ROPE,))], axis=-1)
        return k, v

    cq_l, ckv_l, kr_l = split(p_lat)
    cq_c, ckv_c, kr_c = split(p_ctx)
    k_l, v_l = keys_values(ckv_l, kr_l, True)
    k_c, v_c = keys_values(ckv_c, kr_c, False)
    keys = to_heads_first(jnp.concatenate([k_l, k_c], axis=1))
    vals = to_heads_first(jnp.concatenate([v_l, v_c], axis=1))
    y_lat = merge_groups(blocked_attend(q_groups(queries(cq_l, True), MLA_HEADS), keys, vals, scale))
    y_ctx = None
    if need_ctx:
        y_ctx = merge_groups(attend(q_groups(queries(cq_c, False), MLA_HEADS), to_heads_first(k_c), to_heads_first(v_c), scale))
    return y_lat, y_ctx


def nat_mixer(p_lat, p_ctx, bias_tab, need_ctx):
    scale = HEAD_DIM ** -0.5
    q_l, k_l, v_l = (heads(t, NAT_HEADS) for t in jnp.split(p_lat, [NAT_W, 2 * NAT_W], axis=-1))
    q_c, k_c, v_c = (heads(t, NAT_HEADS) for t in jnp.split(p_ctx, [NAT_W, 2 * NAT_W], axis=-1))
    k_c, v_c = to_heads_first(k_c), to_heads_first(v_c)
    B, N, H, d = q_l.shape
    rows = N // GRID_W
    win_r = min(NAT_WIN_R, rows)

    def grid(t):
        return to_heads_first(t).reshape(B, H, rows, GRID_W, d)

    q_g, k_g, v_g = grid(q_l), grid(k_l), grid(v_l)
    row_start = jnp.clip(jnp.arange(rows) - win_r // 2, 0, rows - win_r)
    col = jnp.arange(GRID_W)
    col_idx = jnp.clip(col - NAT_WIN_C // 2, 0, GRID_W - NAT_WIN_C)[:, None] + jnp.arange(NAT_WIN_C)
    col_off = col_idx - col[:, None] + (NAT_WIN_C - 1)
    bias_col = bias_tab[:, :, col_off]
    n_win = win_r * NAT_WIN_C

    def row_block(inp):
        q_row, rs, i = inp
        k_win = lax.dynamic_slice_in_dim(k_g, rs, win_r, axis=2)[:, :, :, col_idx]
        v_win = lax.dynamic_slice_in_dim(v_g, rs, win_r, axis=2)[:, :, :, col_idx]
        bias = bias_col[:, rs + jnp.arange(win_r) - i + (NAT_WIN_R - 1)].transpose(0, 2, 1, 3)
        s_win = jnp.einsum('bhqd,bhrqcd->bhqrc', q_row, k_win).astype(f32) * scale + bias.astype(f32)
        s_ctx = jnp.einsum('bhqd,bhkd->bhqk', q_row, k_c).astype(f32) * scale
        s = jnp.concatenate([s_win.reshape(B, H, GRID_W, n_win), s_ctx], axis=-1)
        p = jax.nn.softmax(s, axis=-1).astype(v_g.dtype)
        p_win = p[..., :n_win].reshape(B, H, GRID_W, win_r, NAT_WIN_C)
        return jnp.einsum('bhqrc,bhrqcd->bhqd', p_win, v_win) + jnp.einsum('bhqk,bhkd->bhqd', p[..., n_win:], v_c)

    o = lax.map(row_block, (jnp.moveaxis(q_g, 2, 0), row_start, jnp.arange(rows)))
    y_lat = o.transpose(1, 0, 3, 2, 4).reshape(B, N, H * d)
    y_ctx = None
    if need_ctx:
        y_ctx = merge_groups(attend(q_groups(q_c, NAT_HEADS), k_c, v_c, scale))
    return y_lat, y_ctx


def swiglu(h, wg, wu, wd):
    return (jax.nn.silu(h @ wg) * (h @ wu)) @ wd


def moe_swiglu(h, router, wg, wu, wd):
    logits = (h @ router).astype(f32)
    top_vals, top_idx = lax.top_k(logits, TOP_K)
    top_w = jax.nn.softmax(top_vals, axis=-1)
    gates = jnp.sum(jax.nn.one_hot(top_idx, N_EXPERTS, dtype=f32) * top_w[..., None], axis=-2).astype(h.dtype)
    return sum(gates[..., e:e + 1] * swiglu(h, wg[e], wu[e], wd[e]) for e in range(N_EXPERTS))


def modulation(cond, w, b):
    return jnp.split(jax.nn.silu(cond) @ w + b, 6, axis=-1)


def setup_inputs(seed: int = 0) -> dict:
    key = jax.random.key(seed)
    ks = iter(jax.random.split(key, 48))

    def nrm(shape, scale):
        return scale * jax.random.normal(next(ks), shape, f32)

    return {
        'x': nrm((BATCH, SEQ, D_MODEL), 1.0),
        'c': nrm((BATCH, D_MODEL), 1.0),
        'ctx': nrm((BATCH, CTX_LEN, D_MODEL), 1.0),
        'c_ctx': nrm((D_MODEL,), 1.0),
        'mod_w': nrm((DEPTH, D_MODEL, 6 * D_MODEL), 0.5 * D_MODEL ** -0.5),
        'mod_b': nrm((DEPTH, 6 * D_MODEL), 0.02),
        'norm_g': 1.0 + nrm((DEPTH, 4, D_MODEL), 0.05),
        'w_in': nrm((DEPTH, D_MODEL, IN_COLS), D_MODEL ** -0.5),
        'w_out': nrm((DEPTH, D_MIX, D_MODEL), D_MIX ** -0.5),
        'rwkv_mu': jax.random.uniform(next(ks), (DEPTH, RWKV_COLS), f32),
        'rwkv_w0': jax.random.uniform(next(ks), (DEPTH, 2, RWKV_W), f32, -6.0, 1.0),
        'rwkv_w_up': nrm((DEPTH, 2, DECAY_LORA, RWKV_W), DECAY_LORA ** -0.5),
        'rwkv_a0': nrm((DEPTH, 2, RWKV_W), 0.1),
        'rwkv_a_up': nrm((DEPTH, 2, ICLR_LORA, RWKV_W), ICLR_LORA ** -0.5),
        'rwkv_g_up': nrm((DEPTH, GATE_LORA, RWKV_W), GATE_LORA ** -0.5),
        'rwkv_k_k': 0.85 + nrm((DEPTH, RWKV_W), 0.05),
        'rwkv_k_a': 1.0 + nrm((DEPTH, RWKV_W), 0.05),
        'rwkv_r_k': nrm((DEPTH, RWKV_HEADS, HEAD_DIM), 0.1),
        'rwkv_ln_g': 1.0 + nrm((DEPTH, RWKV_W), 0.05),
        'rwkv_ln_b': nrm((DEPTH, RWKV_W), 0.02),
        'gqa_q_g': 1.0 + nrm((DEPTH, HEAD_DIM), 0.05),
        'gqa_k_g': 1.0 + nrm((DEPTH, HEAD_DIM), 0.05),
        'mla_q_norm_g': 1.0 + nrm((DEPTH, MLA_Q_LORA), 0.05),
        'mla_w_uq': nrm((DEPTH, MLA_Q_LORA, MLA_HEADS * (MLA_NOPE + MLA_ROPE)), MLA_Q_LORA ** -0.5),
        'mla_kv_norm_g': 1.0 + nrm((DEPTH, MLA_KV_LORA), 0.05),
        'mla_w_ukv': nrm((DEPTH, MLA_KV_LORA, MLA_HEADS * (MLA_NOPE + MLA_V)), MLA_KV_LORA ** -0.5),
        'nat_bias': nrm((DEPTH, NAT_HEADS, 2 * NAT_WIN_R - 1, 2 * NAT_WIN_C - 1), 0.1),
        'ffn_w_gate': nrm((N_DENSE, D_MODEL, D_FF), D_MODEL ** -0.5),
        'ffn_w_up': nrm((N_DENSE, D_MODEL, D_FF), D_MODEL ** -0.5),
        'ffn_w_down': nrm((N_DENSE, D_FF, D_MODEL), D_FF ** -0.5),
        'moe_router': nrm((N_MOE, D_MODEL, N_EXPERTS), D_MODEL ** -0.5),
        'moe_w_gate': nrm((N_MOE, N_EXPERTS, D_MODEL, D_FF), D_MODEL ** -0.5),
        'moe_w_up': nrm((N_MOE, N_EXPERTS, D_MODEL, D_FF), D_MODEL ** -0.5),
        'moe_w_down': nrm((N_MOE, N_EXPERTS, D_FF, D_MODEL), D_FF ** -0.5),
    }


def reference(x, c, ctx, c_ctx, mod_w, mod_b, norm_g, w_in, w_out, rwkv_mu, rwkv_w0, rwkv_w_up, rwkv_a0,
              rwkv_a_up, rwkv_g_up, rwkv_k_k, rwkv_k_a, rwkv_r_k, rwkv_ln_g, rwkv_ln_b, gqa_q_g, gqa_k_g,
              mla_q_norm_g, mla_w_uq, mla_kv_norm_g, mla_w_ukv, nat_bias, ffn_w_gate, ffn_w_up, ffn_w_down,
              moe_router, moe_w_gate, moe_w_up, moe_w_down):
    n_lat, n_ctx = x.shape[1], ctx.shape[1]
    cos_g, sin_g = axial_rope_tables(n_lat, HEAD_DIM)
    cos_m, sin_m = axial_rope_tables(n_lat, MLA_ROPE)
    xc = ctx
    for l in range(DEPTH):
        need_ctx = l < DEPTH - 1
        m_lat = [m[:, None, :] for m in modulation(c, mod_w[l], mod_b[l])]
        m_ctx = modulation(c_ctx, mod_w[l], mod_b[l])
        gains = norm_g[l]

        h_lat = rms_norm(x, gains[0]) * (1.0 + m_lat[1]) + m_lat[0]
        h_ctx = rms_norm(xc, gains[0]) * (1.0 + m_ctx[1]) + m_ctx[0]
        rw_l, gq_l, ml_l, na_l = jnp.split(h_lat @ w_in[l], GROUP_SPLITS, axis=-1)
        rw_c, gq_c, ml_c, na_c = jnp.split(h_ctx @ w_in[l], GROUP_SPLITS, axis=-1)
        o_rw = rwkv_mixer(rw_l, rw_c, rwkv_mu[l], rwkv_w0[l], rwkv_w_up[l], rwkv_a0[l], rwkv_a_up[l], rwkv_g_up[l],
                          rwkv_k_k[l], rwkv_k_a[l], rwkv_r_k[l], rwkv_ln_g[l], rwkv_ln_b[l], need_ctx)
        o_gq = gqa_mixer(gq_l, gq_c, gqa_q_g[l], gqa_k_g[l], cos_g, sin_g, need_ctx)
        o_ml = mla_mixer(ml_l, ml_c, mla_q_norm_g[l], mla_w_uq[l], mla_kv_norm_g[l], mla_w_ukv[l], cos_m, sin_m, need_ctx)
        o_na = nat_mixer(na_l, na_c, nat_bias[l], need_ctx)
        y_lat = jnp.concatenate([o_rw[0], o_gq[0], o_ml[0], o_na[0]], axis=-1) @ w_out[l]
        x = x + m_lat[2] * rms_norm(y_lat, gains[1])
        if need_ctx:
            y_ctx = jnp.concatenate([o_rw[1], o_gq[1], o_ml[1], o_na[1]], axis=-1) @ w_out[l]
            xc = xc + m_ctx[2] * rms_norm(y_ctx, gains[1])

        h = rms_norm(x, gains[2]) * (1.0 + m_lat[4]) + m_lat[3]
        if need_ctx:
            h = jnp.concatenate([rms_norm(xc, gains[2]) * (1.0 + m_ctx[4]) + m_ctx[3], h], axis=1)
        if l % 2 == 0:
            f = swiglu(h, ffn_w_gate[l // 2], ffn_w_up[l // 2], ffn_w_down[l // 2])
        else:
            f = moe_swiglu(h, moe_router[l // 2], moe_w_gate[l // 2], moe_w_up[l // 2], moe_w_down[l // 2])
        if need_ctx:
            xc = xc + m_ctx[5] * rms_norm(f[:, :n_ctx], gains[3])
            f = f[:, n_ctx:]
        x = x + m_lat[5] * rms_norm(f, gains[3])
    return x
```

```cpp
#ifndef EMU
#include <hip/hip_runtime.h>
#include <cstdio>
#include <cstdint>
#endif

#ifndef CFG_B
#define CFG_B 4
#define CFG_T 4096
#define CFG_C 256
#endif
constexpr int NB = CFG_B, T = CFG_T, C = CFG_C, NK = T + C, D = 1024;
constexpr int TL = NB * T, TC = NB * C, MT = TL + TC;
constexpr int GW = 64, GROWS = T / GW;
constexpr int PW = 2816, FF = 2816, NE = 8;
constexpr int XG_ROWS = 2 * TL + NE * 256;
constexpr int XG_TILES = XG_ROWS / 256;
constexpr float RMS_EPS = 1e-6f, GN_EPS = 64e-5f, LOG2E = 1.4426950408889634f;
static_assert(T % 256 == 0 && C % 256 == 0 && GROWS >= 8, "shape assumptions");

enum { I_X = 0, I_C, I_CTX, I_CCTX, I_MODW, I_MODB, I_NORMG, I_WIN, I_WOUT, I_MU, I_W0, I_WUP, I_A0, I_AUP, I_GUP, I_KK, I_KA, I_RK, I_LNG, I_LNB,
       I_GQG, I_GKG, I_MQG, I_WUQ, I_MKVG, I_WUKV, I_NATB, I_FG, I_FU, I_FD, I_ROUTER, I_MG, I_MU2, I_MD, N_IN };

constexpr size_t al256(size_t x) { return (x + 255) & ~(size_t)255; }
constexpr size_t WS_CTL = 0, CTL_BYTES = 1u << 20;
constexpr size_t WS_MOD = WS_CTL + CTL_BYTES;
constexpr size_t WS_TABG = WS_MOD + al256((size_t)2 * (NB + 1) * 6144 * 4);
constexpr size_t WS_TABM = WS_TABG + al256((size_t)T * 64 * 4);
constexpr size_t WS_WIN = WS_TABM + al256((size_t)T * 32 * 4);
constexpr size_t WS_WOUT = WS_WIN + (size_t)2 * PW * D * 2;
constexpr size_t WS_WGU = WS_WOUT + (size_t)2 * D * D * 2;
constexpr size_t WS_WDN = WS_WGU + (size_t)2 * FF * D * 2;
constexpr size_t WS_WUQ = WS_WDN + (size_t)D * FF * 2;
constexpr size_t WS_WUKV = WS_WUQ + (size_t)2 * 512 * 256 * 2;
constexpr size_t WS_WLORA = WS_WUKV + (size_t)2 * 512 * 128 * 2;
constexpr size_t WS_XSC = WS_WLORA + (size_t)2 * 1280 * 256 * 2;
constexpr size_t WS_ROUTE = WS_XSC + (size_t)TC * D * 4;
constexpr size_t WS_ARENA = al256(WS_ROUTE + (size_t)TL * 24);
constexpr size_t A_XN = WS_ARENA;
constexpr size_t A_RWA = A_XN, A_CQN = A_RWA + (size_t)MT * 256 * 2, A_CKVN = A_CQN + (size_t)MT * 256 * 2;
constexpr size_t A_Y = A_XN;
constexpr size_t A_P = A_XN + (size_t)MT * D * 2;
constexpr size_t A_SCD = A_P;
constexpr size_t A_YO = A_P;
constexpr size_t SCD_BYTES = (size_t)2 * NB * 4 * NK * 192 * 4, P_BYTES = (size_t)MT * PW * 2;
constexpr size_t A_SCS = A_P + (SCD_BYTES > P_BYTES ? SCD_BYTES : P_BYTES);
constexpr size_t A_KSH = A_SCS + (size_t)NB * 4 * NK * 192 * 4;
constexpr size_t A_RHO = A_KSH;
constexpr size_t A_QG = A_KSH + (size_t)MT * 256 * 4;
constexpr size_t A_KG = A_QG + (size_t)MT * 256 * 2;
constexpr size_t A_QKVN = A_KG + (size_t)MT * 128 * 2;
constexpr size_t A_KM = A_QKVN + (size_t)MT * 896 * 2;
constexpr size_t A_QM = A_KM + (size_t)MT * 384 * 2;
constexpr size_t A_VM = A_QM + (size_t)MT * 384 * 2;
constexpr size_t A_RWG = A_VM + (size_t)MT * 256 * 2;
constexpr size_t A_YS = A_RWG + (size_t)MT * 256 * 4;
constexpr int GQ_UNITS = NB * 2 * (T / 128), GQ_SPLIT = GQ_UNITS / 4;
constexpr size_t A_GPO = A_YS + (size_t)2 * MT * 256 * 4;
constexpr size_t A_GST = A_GPO + (size_t)GQ_SPLIT * 2 * 8 * 32 * 64 * 2;
constexpr size_t A_MIX_END = A_GST + (size_t)GQ_SPLIT * 2 * 8 * 32 * 2 * 4;
constexpr int OS_NS = 4, FS_NS = 11;
constexpr size_t A_YOS = A_YO + (size_t)MT * D * 4;
constexpr size_t A_ACT = A_YO + (size_t)MT * D * 4;
constexpr size_t A_F = A_ACT + (size_t)MT * FF * 2;
constexpr size_t A_FS = A_F + (size_t)MT * D * 4;
constexpr size_t A_FFN_END = A_FS + (size_t)FS_NS * TC * D * 4;
static_assert(OS_NS * 256 == D && FS_NS * 256 == FF, "slices of 256");
constexpr size_t A_XG = WS_ARENA;
constexpr size_t A_ACTG = A_XG + (size_t)XG_ROWS * D * 2;
constexpr size_t A_MWGU = A_ACTG + (size_t)XG_ROWS * FF * 2;
constexpr size_t A_MWDN = A_MWGU + (size_t)NE * 2 * FF * D * 2;
constexpr size_t A_MOE_END = A_MWDN + (size_t)NE * D * FF * 2;
static_assert(A_MWGU >= A_YO + (size_t)MT * D * 4, "MoE weights are converted while Y (A_XN) and YO are live");
constexpr int MOE_NFULL = 2 * TL / 256, MOE_NS = 2, MOE_SK = FF / MOE_NS, MOE_TAILROWS = NE * 256;
constexpr size_t WS_MSLAB = WS_WGU;
static_assert((size_t)MOE_NS * MOE_TAILROWS * D * 4 <= (size_t)2 * FF * D * 2 + (size_t)D * FF * 2 && MOE_SK % 128 == 0 && (2 * TL) % 256 == 0, "MoE tail slabs");
constexpr size_t cmax(size_t a, size_t b) { return a > b ? a : b; }
constexpr size_t WS_NEED = cmax(cmax(A_MIX_END, A_FFN_END), A_MOE_END);

constexpr int CW_TMO = 0, CW_BAR = 4096, CW_QUEUE = 16384  , CW_CNT = 16384 + 1024  ;

typedef unsigned short bf16_t;
typedef short bf16x8 __attribute__((ext_vector_type(8)));
typedef short s16x4 __attribute__((ext_vector_type(4)));
typedef float f32x4 __attribute__((ext_vector_type(4)));
typedef float f32x16 __attribute__((ext_vector_type(16)));
typedef unsigned u32x4 __attribute__((ext_vector_type(4)));
typedef unsigned u32x2 __attribute__((ext_vector_type(2)));
#define DI __device__ __forceinline__

DI unsigned f2bf(float f) { unsigned u = __builtin_bit_cast(unsigned, f); return (u + 0x7fffu + ((u >> 16) & 1u)) >> 16; }
DI float bf2f(unsigned h) { return __builtin_bit_cast(float, h << 16); }
#ifdef EMU
DI unsigned pk2(float lo, float hi) { return f2bf(lo) | (f2bf(hi) << 16); }
#else
typedef float f32x2_t __attribute__((ext_vector_type(2))); typedef __bf16 bf16x2_t __attribute__((ext_vector_type(2)));
DI unsigned pk2(float lo, float hi) { const f32x2_t v = {lo, hi}; return __builtin_bit_cast(unsigned, __builtin_convertvector(v, bf16x2_t)); }
#endif
DI unsigned f2bf_hw(float f) { return pk2(f, 0.f) & 0xffffu; }
DI int crow(int r, int hi) { return (r & 3) + 8 * (r >> 2) + 4 * hi; }

#ifdef EMU
DI float dev_shfl_xor(float v, int m) { uint64_t d = __builtin_bit_cast(unsigned, v); emu_exchange_begin(&d, 1); int lane = (int)threadIdx.x & 63; float r = __builtin_bit_cast(float, (unsigned)emu_slot(lane ^ m)[0]); emu_exchange_end(); return r; }
DI f32x16 dev_mfma32(bf16x8 a, bf16x8 b, f32x16 c) {
  uint64_t d[4]; memcpy(d, &a, 16); memcpy(d + 2, &b, 16); emu_exchange_begin(d, 4);
  int lane = (int)threadIdx.x & 63, r = lane & 31, h = lane >> 5; f32x16 o;
  for (int i = 0; i < 16; ++i) { int row = crow(i, h); float s = c[i];
    for (int hh = 0; hh < 2; ++hh) { const short* A = (const short*)emu_slot(row + 32 * hh); const short* B = (const short*)(emu_slot(r + 32 * hh) + 2);
      for (int j = 0; j < 8; ++j) s += bf2f((unsigned short)A[j]) * bf2f((unsigned short)B[j]); }
    o[i] = s; }
  emu_exchange_end(); return o; }
DI s16x4 dev_tr16(const void* p) { uint64_t d = (uint64_t)p; emu_exchange_begin(&d, 1); int lane = (int)threadIdx.x & 63, G = lane >> 4, i16 = lane & 15; s16x4 o;
  for (int e = 0; e < 4; ++e) o[e] = ((const short*)emu_slot(16 * G + 4 * e + (i16 >> 2))[0])[i16 & 3];
  emu_exchange_end(); return o; }
DI void dev_wave_fence() { emu_wave_sync(); }
DI int dev_uniform(int x) { return x; }
DI float dev_max3(float a, float b, float c) { return fmaxf(fmaxf(a, b), c); }
DI void dev_mfma_settle(f32x16&, f32x16&) {}
DI bool dev_any(bool pr) { uint64_t d = pr ? 1 : 0; emu_exchange_begin(&d, 1); bool r = false; for (int i = 0; i < 64; ++i) r = r || (emu_slot(i)[0] != 0); emu_exchange_end(); return r; }
template <int CTRL> DI float dev_dpp(float v) { uint64_t d = __builtin_bit_cast(unsigned, v); emu_exchange_begin(&d, 1); int lane = (int)threadIdx.x & 63, src;
  if (CTRL == 0xB1) src = lane ^ 1; else if (CTRL == 0x4E) src = lane ^ 2; else if (CTRL == 0x141) src = (lane & ~7) | (7 - (lane & 7)); else src = (lane & ~15) | (15 - (lane & 15));
  float r = __builtin_bit_cast(float, (unsigned)emu_slot(src)[0]); emu_exchange_end(); return r; }
DI void dev_glds16(const void* g, char* lds_wave_base) { memcpy(lds_wave_base + ((int)threadIdx.x & 63) * 16, g, 16); }
template <int N> DI void dev_vmwait() {}
DI void dev_bar() { __syncthreads(); }
DI float dev_exp2(float x) { return exp2f(x); }
DI float dev_rsqrt(float x) { return 1.0f / sqrtf(x); }
DI float dev_rcp(float x) { return 1.0f / x; }
DI unsigned dev_atomic_add(unsigned* p, unsigned v) { return __atomic_fetch_add(p, v, __ATOMIC_RELAXED); }
DI unsigned dev_atomic_load(const unsigned* p) { return __atomic_load_n(p, __ATOMIC_RELAXED); }
DI int dev_lds_add(int* p, int v) { const int o = *p; *p = o + v; return o; }
#else
#define LAS __attribute__((address_space(3)))
#define GAS __attribute__((address_space(1)))
DI float dev_shfl_xor(float v, int m) { return __shfl_xor(v, m); }
DI f32x16 dev_mfma32(bf16x8 a, bf16x8 b, f32x16 c) { return __builtin_amdgcn_mfma_f32_32x32x16_bf16(a, b, c, 0, 0, 0); }
typedef short v4i16_t __attribute__((ext_vector_type(4)));
DI s16x4 dev_tr16(const void* p) { return __builtin_bit_cast(s16x4, __builtin_amdgcn_ds_read_tr16_b64_v4i16((LAS v4i16_t*)p)); }
DI void dev_wave_fence() { asm volatile("s_waitcnt lgkmcnt(0)" ::: "memory"); }
DI int dev_uniform(int x) { return __builtin_amdgcn_readfirstlane(x); }
DI void dev_mfma_settle(f32x16& a, f32x16& b) { asm volatile("s_nop 15\n\ts_nop 7" : "+v"(a), "+v"(b)); }
DI float dev_max3(float a, float b, float c) { float r; asm("v_max3_f32 %0, %1, %2, %3" : "=v"(r) : "v"(a), "v"(b), "v"(c)); return r; }
DI bool dev_any(bool pr) { return __any(pr) != 0; }
template <int CTRL> DI float dev_dpp(float v) { return __builtin_bit_cast(float, __builtin_amdgcn_update_dpp(0, __builtin_bit_cast(int, v), CTRL, 0xf, 0xf, true)); }
DI void dev_glds16(const void* g, char* lds_wave_base) {
  unsigned keep; const unsigned dst = (unsigned)__builtin_amdgcn_readfirstlane((int)(unsigned)(uintptr_t)lds_wave_base);
  asm volatile("s_mov_b32 %0, m0\n\ts_mov_b32 m0, %2\n\ts_nop 0\n\tglobal_load_lds_dwordx4 %1, off\n\ts_mov_b32 m0, %0" : "=&s"(keep) : "v"(g), "s"(dst) : "memory"); }
template <int N> DI void dev_vmwait() { asm volatile("s_waitcnt vmcnt(%0)" ::"n"(N) : "memory"); }
DI void dev_bar() { asm volatile("s_waitcnt lgkmcnt(0)" ::: "memory"); __builtin_amdgcn_s_barrier(); asm volatile("" ::: "memory"); }
DI float dev_exp2(float x) { return __builtin_amdgcn_exp2f(x); }
DI float dev_rsqrt(float x) { return __builtin_amdgcn_rsqf(x); }
DI float dev_rcp(float x) { return __builtin_amdgcn_rcpf(x); }
DI unsigned dev_atomic_add(unsigned* p, unsigned v) { return __hip_atomic_fetch_add(p, v, __ATOMIC_RELAXED, __HIP_MEMORY_SCOPE_AGENT); }
DI unsigned dev_atomic_load(const unsigned* p) { return __hip_atomic_load(p, __ATOMIC_RELAXED, __HIP_MEMORY_SCOPE_AGENT); }
DI int dev_lds_add(int* p, int v) { return __hip_atomic_fetch_add(p, v, __ATOMIC_RELAXED, __HIP_MEMORY_SCOPE_WORKGROUP); }
#endif

DI float sum16(float v) {
  v += dev_dpp<0xB1>(v); v += dev_dpp<0x4E>(v); v += dev_dpp<0x141>(v); v += dev_dpp<0x140>(v);
  return v;
}
#ifdef EMU
DI float dev_swapsum16(float v) { return v + dev_shfl_xor(v, 16); }
DI float dev_swapsum32(float v) { return v + dev_shfl_xor(v, 32); }
#else
DI float dev_swapsum16(float v) { auto rr = __builtin_amdgcn_permlane16_swap(__float_as_uint(v), __float_as_uint(v), false, false); return __uint_as_float(rr[0]) + __uint_as_float(rr[1]); }
DI float dev_swapsum32(float v) { auto rr = __builtin_amdgcn_permlane32_swap(__float_as_uint(v), __float_as_uint(v), false, false); return __uint_as_float(rr[0]) + __uint_as_float(rr[1]); }
#endif
DI float wave_sum(float v) { v = sum16(v); v = dev_swapsum16(v); v = dev_swapsum32(v); return v; }
DI float sum8(float v) {
  v += dev_dpp<0xB1>(v); v += dev_dpp<0x4E>(v); v += dev_dpp<0x141>(v);
  return v;
}
DI float sigmoidf_(float x) { return dev_rcp(1.0f + __expf(-x)); }
DI float siluf_(float x) { return x * dev_rcp(1.0f + __expf(-x)); }
DI float softplusf_(float x) { return x > 20.f ? x : log1pf(__expf(x)); }

typedef const float* cfptr_t;
#ifdef EMU
struct Params { cfptr_t in_[N_IN]; float* out; unsigned char* ws; DI cfptr_t in(int i) const { return in_[i]; } };
#else
struct Params { LAS cfptr_t* in_; float* out; unsigned char* ws;
  DI cfptr_t in(int i) const { const unsigned long long v = (unsigned long long)in_[i]; const unsigned lo = __builtin_amdgcn_readfirstlane((unsigned)v), hi = __builtin_amdgcn_readfirstlane((unsigned)(v >> 32));
    return (cfptr_t)(((unsigned long long)hi << 32) | lo); } };
#endif
template <class Tp> DI Tp* wsp(const Params& p, size_t off) { return (Tp*)(p.ws + off); }

DI int row_batch(int m) { return m < TL ? m / T : (m - TL) / C; }
DI int row_kpos(int m) { return m < TL ? m % T : T + (m - TL) % C; }
DI int kpos_row(int b, int kpos) { return kpos < T ? b * T + kpos : TL + b * C + (kpos - T); }
#ifndef EMU
namespace pg8 {
#define PG8_LAS __attribute__((address_space(3)))
typedef unsigned short bf16_t;
typedef short bf16x8 __attribute__((ext_vector_type(8)));
typedef float f32x4 __attribute__((ext_vector_type(4)));
typedef unsigned u32x4 __attribute__((ext_vector_type(4)));
constexpr int BM = 256, BK = 64, HALF = 128, HTB = HALF * BK * 2  , STAGE_BYTES = 8 * HTB, NXCD = 8, WGM = 8;

__host__ __device__ __forceinline__ int lds_byte(int r, int c) { const int st = (r >> 4) * 2 + (c >> 5), rr = r & 15, cc = c & 31, ob = rr * 64 + cc * 2; return st * 1024 + (ob ^ (((ob >> 9) & 1) << 5)); }
__host__ __device__ __forceinline__ void stage_rc(int b, int& R, int& C) { const int st = b / 1024, sb = b % 1024, swz = sb ^ (((sb >> 9) & 1) << 5); R = (st >> 1) * 16 + swz / 64; C = (st & 1) * 32 + (swz % 64) / 2; }
__host__ __device__ __forceinline__ int perm32(int rho) { const int n = rho >> 4, i = rho & 15; return 8 * (i >> 2) + 4 * n + (i & 3); }

struct Unit { int pm, pn, pc, ko, ks; };
struct Gemm { const bf16_t* A; const bf16_t* Bt; int M, N, K; int ld = 0; };

struct StaticOrder {
    int nM, nN, nwg, G, c;
    __host__ __device__ void init(int M, int N, int G_, int c_) { nM = M / BM; nN = N / BM; nwg = nM * nN; G = G_; c = c_; }
    __host__ __device__ bool next(int i, Unit& u) const {
        const long L = (long)i * G + c; if (L >= nwg) return false;
        int wgid = (int)L; { const int q = nwg / NXCD, r = nwg % NXCD, xcd = wgid % NXCD, off = wgid / NXCD; wgid = (xcd < r ? xcd * (q + 1) : r * (q + 1) + (xcd - r) * q) + off; }
        const int nig = WGM * nN, gid = wgid / nig, fm = gid * WGM, gsz = (nM - fm) < WGM ? (nM - fm) : WGM;
        u.pm = fm + ((wgid % nig) % gsz); u.pn = (wgid % nig) / gsz; u.pc = u.pn; u.ko = 0; u.ks = 0; return true;
    }
    __device__ __forceinline__ void a_ready(const Unit&) const {}
    __device__ __forceinline__ void done(const Unit&) const {}
};

template <class Epi, class Sched, bool ALIGN_EPI = false, bool SP2 = false>
__device__ __forceinline__ void gemm_phase(PG8_LAS unsigned char* lds, const Gemm g, const Sched& S, const Epi& E) {
    int tid_ = threadIdx.x; asm volatile("" : "+v"(tid_));
    const int tid = tid_, wid = __builtin_amdgcn_readfirstlane(tid >> 6), lane = tid & 63, wr = wid >> 2, wc = wid & 3, fr = lane & 15, fq = lane >> 4;
    const int K = g.K, nt = K / BK, LD = g.ld ? g.ld : g.K;
    unsigned voffA[2], voffB[2];
#pragma unroll
    for (int i = 0; i < 2; ++i) { int R, C; stage_rc(tid * 16 + i * 8192, R, C); const int Rb = Epi::PERM ? ((R & ~31) + perm32(R & 31)) : R;
        voffA[i] = (unsigned)(R * LD + C) * 2u; voffB[i] = (unsigned)(Rb * LD + C) * 2u; }
    const size_t kstep = (size_t)(BK * 2);
    const size_t hstep = (size_t)HALF * LD * 2;
    const size_t tstep = 2 * hstep;
    const unsigned ldsw = (unsigned)wid * 1024u;
    const int aoff = lds_byte(wr * 64 + fr, fq * 8), boff = lds_byte(wc * 32 + fr, fq * 8);
#define PG8_SA(b, h) (((b) * 2 + (h)) * HTB)
#define PG8_SB(b, h) ((4 + (b) * 2 + (h)) * HTB)
#define PG8_STAGE(bufoff, gbase, voff) do { _Pragma("unroll") for (int _i = 0; _i < 2; ++_i) \
        __builtin_amdgcn_global_load_lds((const unsigned*)((const char*)(gbase) + (voff)[_i]), (PG8_LAS unsigned*)(lds + (bufoff) + ldsw + _i * 8192), 16, 0, 0); } while (0)
#define PG8_LDA(dst, b, h) do { _Pragma("unroll") for (int m = 0; m < 4; ++m) _Pragma("unroll") for (int k = 0; k < 2; ++k) dst[m][k] = *(const PG8_LAS bf16x8*)(lds + PG8_SA(b, h) + aoff + m * 2048 + k * 1024); } while (0)
#define PG8_LDB(dst, b, h) do { _Pragma("unroll") for (int n = 0; n < 2; ++n) _Pragma("unroll") for (int k = 0; k < 2; ++k) dst[n][k] = *(const PG8_LAS bf16x8*)(lds + PG8_SB(b, h) + boff + n * 2048 + k * 1024); } while (0)
#define PG8_MMA(ai, bj, At, Bt) do { __builtin_amdgcn_s_setprio(1); _Pragma("unroll") for (int m = 0; m < 4; ++m) _Pragma("unroll") for (int n = 0; n < 2; ++n) _Pragma("unroll") for (int k = 0; k < 2; ++k) \
        acc[ai][bj][m][n] = __builtin_amdgcn_mfma_f32_16x16x32_bf16(Bt[n][k], At[m][k], acc[ai][bj][m][n], 0, 0, 0); __builtin_amdgcn_s_setprio(0); } while (0)
#define PG8_WAIT_V(n) asm volatile("s_waitcnt vmcnt(" #n ")" ::: "memory")
#define PG8_WAIT_L(n) asm volatile("s_waitcnt lgkmcnt(" #n ")" ::: "memory")
#define PG8_BAR __builtin_amdgcn_s_barrier()
#define PG8_SCHED __builtin_amdgcn_sched_barrier(0)
    Unit cur, nxt; int ui = 0;
    if (!S.next(0, cur)) return;
    f32x4 acc[2][2][4][2];
#pragma unroll
    for (int a = 0; a < 2; ++a)
#pragma unroll
        for (int b = 0; b < 2; ++b)
#pragma unroll
            for (int m = 0; m < 4; ++m)
#pragma unroll
                for (int n = 0; n < 2; ++n) acc[a][b][m][n] = (f32x4){0.f, 0.f, 0.f, 0.f};
    bf16x8 At[4][2], B0[2][2], B1[2][2];
    const char* cA = (const char*)g.A + (size_t)cur.pm * tstep + (size_t)cur.ko * 2; const char* cB = (const char*)g.Bt + (size_t)cur.pn * tstep + (size_t)cur.ko * 2;
    S.a_ready(cur);
    if constexpr (SP2) {
        PG8_STAGE(PG8_SB(0, 0), cB, voffB); PG8_STAGE(PG8_SB(0, 1), cB + hstep, voffB); PG8_STAGE(PG8_SA(0, 0), cA, voffA); PG8_STAGE(PG8_SA(0, 1), cA + hstep, voffA);
        if (wr == 1) PG8_BAR;
        PG8_WAIT_V(2); PG8_BAR;
        PG8_STAGE(PG8_SB(1, 0), cB + kstep, voffB); PG8_STAGE(PG8_SA(1, 0), cA + kstep, voffA); PG8_STAGE(PG8_SB(1, 1), cB + hstep + kstep, voffB);
        PG8_WAIT_V(6); PG8_BAR;
    } else {
        PG8_STAGE(PG8_SB(0, 0), cB, voffB); PG8_STAGE(PG8_SA(0, 0), cA, voffA); PG8_STAGE(PG8_SB(0, 1), cB + hstep, voffB); PG8_STAGE(PG8_SA(0, 1), cA + hstep, voffA);
        if (wr == 1) PG8_BAR;
        PG8_WAIT_V(4); PG8_BAR;
        PG8_STAGE(PG8_SB(1, 0), cB + kstep, voffB); PG8_STAGE(PG8_SA(1, 0), cA + kstep, voffA); PG8_STAGE(PG8_SB(1, 1), cB + hstep + kstep, voffB);
        PG8_WAIT_V(6); PG8_BAR;
    }
    for (;;) {
        const bool has_next = S.next(ui + 1, nxt);
        const char* nA = has_next ? (const char*)g.A + (size_t)nxt.pm * tstep + (size_t)nxt.ko * 2 : cA; const char* nB = has_next ? (const char*)g.Bt + (size_t)nxt.pn * tstep + (size_t)nxt.ko * 2 : cB;
        for (int t = 0; t < nt; t += 2) {
            const bool last = (t == nt - 2);
            const char* a1 = cA + (size_t)(t + 1) * kstep;
            const char* a2 = last ? nA : cA + (size_t)(t + 2) * kstep; const char* b2 = last ? nB : cB + (size_t)(t + 2) * kstep;
            const char* a3 = a2 + kstep; const char* b3 = b2 + kstep;
            if (last && has_next) S.a_ready(nxt);
            if constexpr (SP2) {
            PG8_LDB(B0, 0, 0); PG8_LDB(B1, 0, 1); PG8_SCHED; PG8_LDA(At, 0, 0); PG8_STAGE(PG8_SA(1, 1), a1 + hstep, voffA);
            PG8_WAIT_V(8); PG8_WAIT_L(0); PG8_BAR; PG8_MMA(0, 0, At, B0); PG8_MMA(0, 1, At, B1); PG8_BAR; PG8_SCHED;
            PG8_LDA(At, 0, 1); PG8_STAGE(PG8_SB(0, 0), b2, voffB); PG8_STAGE(PG8_SB(0, 1), b2 + hstep, voffB); PG8_STAGE(PG8_SA(0, 0), a2, voffA);
            PG8_WAIT_V(8); PG8_WAIT_L(0); PG8_BAR; PG8_MMA(1, 0, At, B0); PG8_MMA(1, 1, At, B1); PG8_BAR; PG8_SCHED;
            PG8_LDB(B0, 1, 0); PG8_LDB(B1, 1, 1); PG8_SCHED; PG8_LDA(At, 1, 0); PG8_STAGE(PG8_SA(0, 1), a2 + hstep, voffA);
            PG8_WAIT_V(8); PG8_WAIT_L(0); PG8_BAR; PG8_MMA(0, 0, At, B0); PG8_MMA(0, 1, At, B1); PG8_BAR; PG8_SCHED;
            PG8_LDA(At, 1, 1); PG8_STAGE(PG8_SB(1, 0), b3, voffB); PG8_STAGE(PG8_SB(1, 1), b3 + hstep, voffB); PG8_STAGE(PG8_SA(1, 0), a3, voffA);
            PG8_WAIT_V(8); PG8_WAIT_L(0); PG8_BAR; PG8_MMA(1, 0, At, B0); PG8_MMA(1, 1, At, B1); PG8_BAR; PG8_SCHED;
            } else {
            PG8_LDB(B0, 0, 0); PG8_SCHED; PG8_LDA(At, 0, 0); PG8_STAGE(PG8_SA(1, 1), a1 + hstep, voffA);
            PG8_WAIT_L(8); PG8_BAR; PG8_WAIT_L(0); PG8_MMA(0, 0, At, B0); PG8_BAR; PG8_SCHED;
            PG8_LDB(B1, 0, 1); PG8_STAGE(PG8_SB(0, 0), b2, voffB);
            PG8_BAR; PG8_WAIT_L(0); PG8_MMA(0, 1, At, B1); PG8_BAR;
            PG8_LDA(At, 0, 1); PG8_STAGE(PG8_SA(0, 0), a2, voffA);
            PG8_BAR; PG8_WAIT_L(0); PG8_MMA(1, 0, At, B0); PG8_BAR; PG8_SCHED;
            PG8_STAGE(PG8_SB(0, 1), b2 + hstep, voffB);
            PG8_WAIT_V(6); PG8_BAR; PG8_MMA(1, 1, At, B1); PG8_BAR;
            PG8_LDB(B0, 1, 0); PG8_SCHED; PG8_LDA(At, 1, 0); PG8_STAGE(PG8_SA(0, 1), a2 + hstep, voffA);
            PG8_WAIT_L(8); PG8_BAR; PG8_WAIT_L(0); PG8_MMA(0, 0, At, B0); PG8_BAR; PG8_SCHED;
            PG8_LDB(B1, 1, 1); PG8_STAGE(PG8_SB(1, 0), b3, voffB);
            PG8_BAR; PG8_WAIT_L(0); PG8_MMA(0, 1, At, B1); PG8_BAR;
            PG8_LDA(At, 1, 1); PG8_STAGE(PG8_SA(1, 0), a3, voffA);
            PG8_BAR; PG8_WAIT_L(0); PG8_MMA(1, 0, At, B0); PG8_BAR; PG8_SCHED;
            PG8_STAGE(PG8_SB(1, 1), b3 + hstep, voffB);
            PG8_WAIT_V(6); PG8_BAR; PG8_MMA(1, 1, At, B1); PG8_BAR;
            }
        }
        if constexpr (ALIGN_EPI) { if (wr == 0) PG8_BAR; }
        if constexpr (!Epi::AFTER_DRAIN) { E(acc, cur, wr, wc, fr, fq); S.done(cur); }
        if (!has_next) break;
#pragma unroll
        for (int a = 0; a < 2; ++a)
#pragma unroll
            for (int b = 0; b < 2; ++b)
#pragma unroll
                for (int m = 0; m < 4; ++m)
#pragma unroll
                    for (int n = 0; n < 2; ++n) acc[a][b][m][n] = (f32x4){0.f, 0.f, 0.f, 0.f};
        cur = nxt; cA = nA; cB = nB; ++ui;
        if constexpr (ALIGN_EPI) { if (wr == 1) PG8_BAR; }
    }
    PG8_WAIT_V(0);
    if constexpr (!ALIGN_EPI) { if (wr == 0) PG8_BAR; }
    PG8_BAR;
    if constexpr (Epi::AFTER_DRAIN) { E.fused(acc, cur, wr, wc, fr, fq, lds, wid, lane); S.done(cur); }
#undef PG8_SA
#undef PG8_SB
#undef PG8_STAGE
#undef PG8_LDA
#undef PG8_LDB
#undef PG8_MMA
#undef PG8_WAIT_V
#undef PG8_WAIT_L
#undef PG8_BAR
#undef PG8_SCHED
}
}
#define XB_TMO      128
#define XB_XCNT(j)  (256  + 64 * (j))
#define XB_XSUB(j)  (1280 + 64 * (j))
#define XB_XGEN(j)  (2304 + 64 * (j))
#define XB_TOP      3328
#define XB_TOPGEN   3392
#define XCD_BAR_WORDS 3456
#define XB_SPIN_CAP (1u << 18)

__device__ __forceinline__ unsigned xb_ld(unsigned* p)              { return __hip_atomic_load(p, __ATOMIC_RELAXED, __HIP_MEMORY_SCOPE_AGENT); }
__device__ __forceinline__ unsigned xb_add(unsigned* p, unsigned v) { return __hip_atomic_fetch_add(p, v, __ATOMIC_RELAXED, __HIP_MEMORY_SCOPE_AGENT); }
__device__ __forceinline__ unsigned xb_xcc_id() { return (unsigned)__builtin_amdgcn_s_getreg((3 << 11) | 20) & 0xFu; }
#define XB_SPIN(cond, bar) do { unsigned _sp = 0; while (cond) { __builtin_amdgcn_s_sleep(4); \
    if ((++_sp & 255u) == 0u) { if (xb_ld(&(bar)[XB_TMO])) break; if (_sp > XB_SPIN_CAP) { atomicAdd(&(bar)[XB_TMO], 1u); break; } } } } while (0)

struct XcdBarrier {
    unsigned* bar; unsigned x;
    volatile LAS unsigned* st;
};

__device__ __forceinline__ XcdBarrier xcd_barrier_post(unsigned* bar, volatile LAS unsigned* st) {
    XcdBarrier b; b.bar = bar; b.x = xb_xcc_id(); b.st = st;
    if (threadIdx.x == 0) (void)xb_add(&bar[XB_XCNT(b.x)], 1u);
    return b;
}
__device__ __forceinline__ void xcd_barrier_complete(unsigned* bar, unsigned x, unsigned& nloc, unsigned& nx) {
    const unsigned G = gridDim.x * gridDim.y * gridDim.z;
    unsigned sum, cnt, mine, sp = 0u;
    for (;;) {
        sum = 0u; cnt = 0u; mine = 0u;
#pragma unroll
        for (unsigned j = 0; j < 16; ++j) { const unsigned c = xb_ld(&bar[XB_XCNT(j)]); sum += c; cnt += (c > 0u) ? 1u : 0u; mine = (j == x) ? c : mine; }
        if (sum == G) break;
        __builtin_amdgcn_s_sleep(1);
        if ((++sp & 255u) == 0u) { if (xb_ld(&bar[XB_TMO])) break; if (sp > XB_SPIN_CAP) { atomicAdd(&bar[XB_TMO], 1u); break; } }
    }
    nloc = mine > 0u ? mine : 1u; nx = cnt > 0u ? cnt : 1u;
}

__device__ __forceinline__ void xcd_barrier(const XcdBarrier& b) {
    asm volatile("s_waitcnt vmcnt(0)" ::: "memory");
    __syncthreads();
    if (threadIdx.x == 0) {
        unsigned* bar = b.bar;
        __builtin_amdgcn_s_waitcnt(0);
        unsigned nloc = b.st[0], nx = b.st[1];
        if (nloc == 0u) { xcd_barrier_complete(bar, b.x, nloc, nx); b.st[0] = nloc; b.st[1] = nx; }
        const unsigned old = xb_add(&bar[XB_XSUB(b.x)], 1u);
        const unsigned gen = old / nloc;
        if (old + 1u == (gen + 1u) * nloc) {
            __builtin_amdgcn_fence(__ATOMIC_RELEASE, "agent");
            asm volatile("s_waitcnt vmcnt(0)" ::: "memory");
            const unsigned og = xb_add(&bar[XB_TOP], 1u);
            const unsigned tg = og / nx;
            if (og + 1u == (tg + 1u) * nx) xb_add(&bar[XB_TOPGEN], 1u);
            else XB_SPIN(xb_ld(&bar[XB_TOPGEN]) == tg, bar);
            __builtin_amdgcn_fence(__ATOMIC_ACQUIRE, "agent");
            xb_add(&bar[XB_XGEN(b.x)], 1u);
            asm volatile("s_waitcnt vmcnt(0)" ::: "memory");
        } else {
            XB_SPIN(xb_ld(&bar[XB_XGEN(b.x)]) == gen, bar);
            __builtin_amdgcn_fence(__ATOMIC_ACQUIRE, "agent");
            asm volatile("s_waitcnt vmcnt(0)" ::: "memory");
        }
    }
    __syncthreads();
}
#endif
#ifndef PROBE_REP
#define PROBE_REP 0
#endif
#define NWAVES 8
#ifdef EMU
#define TID ((int)threadIdx.x)
#else
DI int tid_fresh() { int t = threadIdx.x; asm volatile("" : "+v"(t)); return t; }
#define TID tid_fresh()
#endif
#define GWAVE dev_uniform((int)blockIdx.x * NWAVES + (TID >> 6))
#define NGWAVE ((int)gridDim.x * NWAVES)

struct TItem { const float* W; bf16_t* WT; int K, N, kind, k0, n0; };
DI int titem_row(const TItem& t, int n) { if (t.kind == 0) return n; if (t.kind == 1) return 2 * n; if (t.kind == 2) return 2 * n + 1;
  const int hd = n / 96, dd = n % 96; if (dd < 64) return n; const int i = dd - 64; return hd * 96 + 64 + (i < 16 ? 2 * i : 2 * (i - 16) + 1); }
DI void titem_set(TItem& t, const float* W, int K, int N, bf16_t* WT, int kind, int item) { t.W = W; t.WT = WT; t.K = K; t.N = N; t.kind = kind; const int nblk = N / 32; t.k0 = 64 * (item / nblk); t.n0 = 32 * (item % nblk); }
DI void titem_load(const TItem& t, int lane, float (&v)[32]) {
#pragma unroll
  for (int i = 0; i < 32; ++i) v[i] = t.W[(size_t)(t.k0 + 2 * i + (lane >> 5)) * t.N + t.n0 + (lane & 31)];
}
DI void titem_stage(float* scr, int lane, const float (&v)[32]) {
#pragma unroll
  for (int i = 0; i < 32; ++i) scr[(2 * i + (lane >> 5)) * 33 + (lane & 31)] = v[i];
  dev_wave_fence();
}
DI void titem_finish(const TItem& t, const float* scr, int lane) {
  const int c = lane & 7;
#pragma unroll
  for (int j = 0; j < 4; ++j) { const int n = (lane >> 3) + 8 * j; const float* s = scr + (8 * c) * 33 + n;
    u32x4 o; o.x = pk2(s[0 * 33], s[1 * 33]); o.y = pk2(s[2 * 33], s[3 * 33]); o.z = pk2(s[4 * 33], s[5 * 33]); o.w = pk2(s[6 * 33], s[7 * 33]);
    *(u32x4*)(t.WT + (size_t)titem_row(t, t.n0 + n) * t.K + t.k0 + 8 * c) = o; }
  dev_wave_fence();
}
template <class Decode> DI void transpose_items(int first, int total, int stride, Decode decode, float* scr, int lane) {
  if (first >= total) return;
  TItem cur, nxt; float v[32]; decode(first, cur); titem_load(cur, lane, v);
  for (int it = first; it < total; it += stride) {
    titem_stage(scr, lane, v);
    const bool more = it + stride < total;
    if (more) { decode(it + stride, nxt); titem_load(nxt, lane, v); }
    titem_finish(cur, scr, lane);
    cur = nxt;
  }
}

DI void phase_prologue(const Params& p, char* smem) {
  const int lane = TID & 63, wave = TID >> 6;
  float* scr = (float*)(smem + wave * 8704);
  const int gw = GWAVE, ngw = NGWAVE;
  constexpr int I_IN = (D / 64) * (2720 / 32), I_OUT = (D / 64) * (D / 32), I_G = (D / 64) * (FF / 32), I_DN = (FF / 64) * (D / 32), I_UQ = (256 / 64) * (384 / 32), I_UKV = (128 / 64) * (512 / 32);
  constexpr int NITEMS = 2 * I_IN + 2 * I_OUT + 2 * I_G + I_DN + 2 * I_UQ + 2 * I_UKV;
  auto decode = [&](int it, TItem& t) { int r = it;
    if (r < 2 * I_IN) { const int l = r / I_IN; titem_set(t, p.in(I_WIN) + (size_t)l * D * 2720, D, 2720, wsp<bf16_t>(p, WS_WIN) + (size_t)l * PW * D, 0, r % I_IN); return; } r -= 2 * I_IN;
    if (r < 2 * I_OUT) { const int l = r / I_OUT; titem_set(t, p.in(I_WOUT) + (size_t)l * D * D, D, D, wsp<bf16_t>(p, WS_WOUT) + (size_t)l * D * D, 0, r % I_OUT); return; } r -= 2 * I_OUT;
    if (r < I_G) { titem_set(t, p.in(I_FG), D, FF, wsp<bf16_t>(p, WS_WGU), 1, r); return; } r -= I_G;
    if (r < I_G) { titem_set(t, p.in(I_FU), D, FF, wsp<bf16_t>(p, WS_WGU), 2, r); return; } r -= I_G;
    if (r < I_DN) { titem_set(t, p.in(I_FD), FF, D, wsp<bf16_t>(p, WS_WDN), 0, r); return; } r -= I_DN;
    if (r < 2 * I_UQ) { const int l = r / I_UQ; titem_set(t, p.in(I_WUQ) + (size_t)l * 256 * 384, 256, 384, wsp<bf16_t>(p, WS_WUQ) + (size_t)l * 512 * 256, 3, r % I_UQ); return; } r -= 2 * I_UQ;
    { const int l = r / I_UKV; titem_set(t, p.in(I_WUKV) + (size_t)l * 128 * 512, 128, 512, wsp<bf16_t>(p, WS_WUKV) + (size_t)l * 512 * 128, 0, r % I_UKV); } };
  transpose_items(gw, NITEMS, ngw, decode, scr, lane);
  const int gt = (int)blockIdx.x * 512 + TID, ngt = (int)gridDim.x * 512;
  { constexpr int LI = 16;
    auto dec2 = [&](int it, TItem& t) { const int l = it / (3 * LI), kind = (it / LI) % 3, j = it % LI; bf16_t* WL = wsp<bf16_t>(p, WS_WLORA) + (size_t)l * 1280 * 256;
      if (kind == 0) { const int d = j >> 3; titem_set(t, p.in(I_WUP) + (size_t)(l * 2 + d) * 64 * 256, 256, 256, WL + (size_t)(d * 256) * 256, 0, j & 7); }
      else if (kind == 1) { const int d = j >> 3; titem_set(t, p.in(I_AUP) + (size_t)(l * 2 + d) * 64 * 256, 256, 256, WL + (size_t)(512 + d * 256) * 256 + 64, 0, j & 7); }
      else { titem_set(t, p.in(I_GUP) + (size_t)l * 128 * 256, 256, 256, WL + (size_t)1024 * 256 + 128, 0, j); } };
    transpose_items(gw, 2 * 3 * LI, ngw, dec2, scr, lane);
    for (int e = gt; e < 2 * 1280 * 32; e += ngt) { const int l = e / (1280 * 32), n = (e / 32) % 1280, c = e % 32, k = 8 * c;
      const bool data = n < 512 ? k < 64 : (n < 1024 ? (k >= 64 && k < 128) : k >= 128);
      if (!data) *(u32x4*)(wsp<bf16_t>(p, WS_WLORA) + ((size_t)l * 1280 + n) * 256 + k) = (u32x4){0u, 0u, 0u, 0u}; } }
  for (int e = gt; e < T * 32; e += ngt) { const int t = e / 32, i = e % 32; const float pos = (i < 16) ? (float)(t / GW) : (float)(t % GW);
    const float invf = exp2f(-(float)(i & 15) / 16.0f * 13.287712379549449f); const float ang = pos * invf;
    wsp<float>(p, WS_TABG)[2 * e] = cosf(ang); wsp<float>(p, WS_TABG)[2 * e + 1] = sinf(ang); }
  for (int e = gt; e < T * 16; e += ngt) { const int t = e / 16, i = e % 16; const float pos = (i < 8) ? (float)(t / GW) : (float)(t % GW);
    const float invf = exp2f(-(float)(i & 7) / 8.0f * 13.287712379549449f); const float ang = pos * invf;
    wsp<float>(p, WS_TABM)[2 * e] = cosf(ang); wsp<float>(p, WS_TABM)[2 * e + 1] = sinf(ang); }
  __syncthreads();
  float* sc = (float*)smem;
  float* red = (float*)(smem + (NB + 1) * D * 4);
  for (int e = TID; e < (NB + 1) * D; e += 512) { const int s = e / D, k = e % D; sc[e] = siluf_(s < NB ? p.in(I_C)[s * D + k] : p.in(I_CCTX)[k]); }
  __syncthreads();
  for (int u = (int)blockIdx.x; u < 2 * 96; u += (int)gridDim.x) {
    const int l = u / 96, jb = (u % 96) * 64, jq = TID & 15, kg = TID >> 4;
    f32x4 acc[NB + 1];
#pragma unroll
    for (int s = 0; s <= NB; ++s) acc[s] = (f32x4){0.f, 0.f, 0.f, 0.f};
    const float* W = p.in(I_MODW) + (size_t)l * D * 6144 + jb + 4 * jq + (size_t)(kg * 32) * 6144;
#pragma unroll
    for (int h0 = 0; h0 < 32; h0 += 16) { f32x4 w[16];
#pragma unroll
      for (int i = 0; i < 16; ++i) w[i] = *(const f32x4*)(W + (size_t)(h0 + i) * 6144);
#pragma unroll
      for (int i = 0; i < 16; ++i) { const int k = kg * 32 + h0 + i;
#pragma unroll
        for (int s = 0; s <= NB; ++s) acc[s] += w[i] * sc[s * D + k]; } }
#pragma unroll
    for (int s = 0; s <= NB; ++s) *(f32x4*)(red + (kg * (NB + 1) + s) * 64 + 4 * jq) = acc[s];
    __syncthreads();
    if (TID < 64 * (NB + 1)) { const int s = TID / 64, jj = TID & 63; float t = 0.f;
#pragma unroll 8
      for (int g = 0; g < 32; ++g) t += red[(g * (NB + 1) + s) * 64 + jj];
      const int jc = jb + jj; wsp<float>(p, WS_MOD)[((size_t)l * (NB + 1) + s) * 6144 + jc] = t + p.in(I_MODB)[l * 6144 + jc]; }
    __syncthreads();
  }
}

DI void moe_convert(const Params& p, char* smem) {
  const int lane = TID & 63, wave = TID >> 6; float* scr = (float*)(smem + wave * 8704);
  constexpr int I_G = (D / 64) * (FF / 32), I_DN = (FF / 64) * (D / 32);
  auto decode = [&](int it, TItem& t) { const int e = it / (2 * I_G + I_DN); int r = it % (2 * I_G + I_DN);
    if (r < I_G) { titem_set(t, p.in(I_MG) + (size_t)e * D * FF, D, FF, wsp<bf16_t>(p, A_MWGU) + (size_t)e * 2 * FF * D, 1, r); return; } r -= I_G;
    if (r < I_G) { titem_set(t, p.in(I_MU2) + (size_t)e * D * FF, D, FF, wsp<bf16_t>(p, A_MWGU) + (size_t)e * 2 * FF * D, 2, r); return; } r -= I_G;
    titem_set(t, p.in(I_MD) + (size_t)e * FF * D, FF, D, wsp<bf16_t>(p, A_MWDN) + (size_t)e * D * FF, 0, r); };
  transpose_items(GWAVE, NE * (2 * I_G + I_DN), NGWAVE, decode, scr, lane);
}

constexpr int RW_NR = 4;
DI const float* mod_ptr(const Params& p, int l, int m, int chunk) { const int s = m < TL ? m / T : NB; return wsp<float>(p, WS_MOD) + ((size_t)l * (NB + 1) + s) * 6144 + chunk * 1024; }
DI void load_row4(const float* src, int lane, f32x4 (&v)[4]) {
#pragma unroll
  for (int j = 0; j < 4; ++j) v[j] = *(const f32x4*)(src + 4 * lane + 256 * j);
}
DI void load_row4_bf(const bf16_t* src, int lane, f32x4 (&v)[4]) {
#pragma unroll
  for (int j = 0; j < 4; ++j) { const u32x2 u = *(const u32x2*)(src + 4 * lane + 256 * j); v[j] = (f32x4){bf2f(u.x & 0xffffu), bf2f(u.x >> 16), bf2f(u.y & 0xffffu), bf2f(u.y >> 16)}; }
}
DI float sumsq4(const f32x4 (&v)[4]) { float s = 0.f;
#pragma unroll
  for (int j = 0; j < 4; ++j) s += (v[j].x * v[j].x + v[j].y * v[j].y) + (v[j].z * v[j].z + v[j].w * v[j].w);
  return s; }
DI void adaln_store(const f32x4 (&v)[4], float rinv, const float* gain, const float* scale, const float* shift, bf16_t* dst, int lane) {
#pragma unroll
  for (int j = 0; j < 4; ++j) { const int c = 4 * lane + 256 * j; const f32x4 g = *(const f32x4*)(gain + c), sc = *(const f32x4*)(scale + c), sh = *(const f32x4*)(shift + c);
    const f32x4 h = v[j] * rinv * g * (sc + 1.0f) + sh; u32x2 o; o.x = pk2(h.x, h.y); o.y = pk2(h.z, h.w); *(u32x2*)(dst + c) = o; }
}
DI void phase_adaln0(const Params& p) {
  const int lane = TID & 63; const int ngw = NGWAVE; const int m0 = GWAVE;
  auto src = [&](int r) { return r < TL ? p.in(I_X) + (size_t)r * D : p.in(I_CTX) + (size_t)(r - TL) * D; };
  for (int mb = m0; mb < MT; mb += 4 * ngw) {
    f32x4 v[4][4];
#pragma unroll
    for (int q = 0; q < 4; ++q) { const int m = mb + q * ngw; if (m < MT) load_row4(src(m), lane, v[q]); }
#pragma unroll
    for (int q = 0; q < 4; ++q) { const int m = mb + q * ngw; if (m < MT) {
      const float rinv = dev_rsqrt(wave_sum(sumsq4(v[q])) * (1.0f / D) + RMS_EPS);
      adaln_store(v[q], rinv, p.in(I_NORMG) + 0 * D, mod_ptr(p, 0, m, 1), mod_ptr(p, 0, m, 0), wsp<bf16_t>(p, A_XN) + (size_t)m * D, lane); } }
  }
}

DI f32x4 ldp4(const bf16_t* row, int c) { const u32x2 u = *(const u32x2*)(row + c); return (f32x4){bf2f(u.x & 0xffffu), bf2f(u.x >> 16), bf2f(u.y & 0xffffu), bf2f(u.y >> 16)}; }
DI float tanh_fast(float x) { return 1.0f - 2.0f * dev_rcp(1.0f + __expf(2.0f * x)); }
DI void st4bf(bf16_t* dst, f32x4 v) { u32x2 o; o.x = pk2(v.x, v.y); o.y = pk2(v.z, v.w); *(u32x2*)dst = o; }
struct PrepRaw { u32x2 x[4], xp[4], xn[4], q, k, cq, ck; };
DI f32x4 up4(u32x2 u) { return (f32x4){bf2f(u.x & 0xffffu), bf2f(u.x >> 16), bf2f(u.y & 0xffffu), bf2f(u.y >> 16)}; }
DI void prep_load(const bf16_t* P, int m, int lane, PrepRaw& r) {
  const bf16_t* row = P + (size_t)m * PW; const bool lat = m < TL; const int pos = lat ? m % T : (m - TL) % C, seqlen = lat ? T : C; const bool hasp = pos > 0, hasn = pos + 1 < seqlen;
#pragma unroll
  for (int j = 0; j < 4; ++j) { const int c = 4 * lane + 256 * j; r.x[j] = *(const u32x2*)(row + c); r.xp[j] = hasp ? *(const u32x2*)(row - PW + c) : (u32x2){0u, 0u}; r.xn[j] = hasn ? *(const u32x2*)(row + PW + c) : (u32x2){0u, 0u}; }
  r.q = *(const u32x2*)(row + 1024 + 4 * lane); r.k = *(const u32x2*)(row + 1280 + 4 * lane); r.cq = *(const u32x2*)(row + 1536 + 4 * lane);
  r.ck = *(const u32x2*)(row + 1792 + 4 * (lane & 31) + (lane >= 32 ? 128 : 0));
}
DI void phase_prep(const Params& p, int l) {
  const int lane = TID & 63; const bf16_t* P = wsp<bf16_t>(p, A_P); const int ngw = NGWAVE; int m = GWAVE; if (m >= MT) return;
  PrepRaw nraw; prep_load(P, m, lane, nraw);
  for (; m < MT; m += ngw) {
    const PrepRaw raw = nraw;
    if (m + ngw < MT) prep_load(P, m + ngw, lane, nraw);
    const int b = row_batch(m), kpos = row_kpos(m); const bool lat = m < TL; const int t = lat ? m % T : 0;
    f32x4 rw[4];
#pragma unroll
    for (int j = 0; j < 4; ++j) { const int c = 4 * lane + 256 * j; const f32x4 x = up4(raw.x[j]), xp = up4(raw.xp[j]), xn = up4(raw.xn[j]);
      const f32x4 mu = *(const f32x4*)(p.in(I_MU) + l * 1024 + c); rw[j] = x + mu * ((xp + xn) * 0.5f - x); }
    const int hd = lane >> 4, dd = 4 * (lane & 15);
    { const f32x4 kkw = *(const f32x4*)(p.in(I_KK) + l * 256 + 4 * lane); f32x4 kk = rw[1] * kkw;
      const float ss = sum16((kk.x * kk.x + kk.y * kk.y) + (kk.z * kk.z + kk.w * kk.w)); kk = kk * dev_rsqrt(ss + 1e-12f);
      bf16_t* scs = wsp<bf16_t>(p, A_SCS) + ((size_t)(b * 4 + hd) * NK + kpos) * 192;
      st4bf(scs + dd, rw[0]); st4bf(scs + 64 + dd, rw[2]); st4bf(scs + 128 + dd, kk);
      st4bf(wsp<bf16_t>(p, A_KSH) + (size_t)m * 256 + 4 * lane, rw[1]);
      f32x4 a; const f32x4 x = rw[3];
      if (lane < 16) a = (f32x4){tanh_fast(x.x), tanh_fast(x.y), tanh_fast(x.z), tanh_fast(x.w)};
      else if (lane < 32) a = x;
      else a = (f32x4){sigmoidf_(x.x), sigmoidf_(x.y), sigmoidf_(x.z), sigmoidf_(x.w)};
      st4bf(wsp<bf16_t>(p, A_RWA) + (size_t)m * 256 + 4 * lane, a); }
    { f32x4 q = up4(raw.q); const float ss = sum16((q.x * q.x + q.y * q.y) + (q.z * q.z + q.w * q.w));
      q = q * (dev_rsqrt(ss * (1.0f / 64.0f) + RMS_EPS) * (0.125f * LOG2E)) * *(const f32x4*)(p.in(I_GQG) + l * 64 + dd);
      if (lat) { f32x4 o; const bool lo = (lane & 15) < 8; const int i0 = dd & 31; const float* tab = wsp<float>(p, WS_TABG) + ((size_t)t * 32 + i0) * 2;
#pragma unroll
        for (int e = 0; e < 4; ++e) { const f32x4 tv = *(const f32x4*)(tab + 4 * (e >> 1)); const float mine = q[e], oth = dev_shfl_xor(q[e], 8), cs = (e & 1) ? tv.z : tv.x, sn = (e & 1) ? tv.w : tv.y; o[e] = lo ? mine * cs - oth * sn : oth * sn + mine * cs; }
        q = o; }
      st4bf(wsp<bf16_t>(p, A_QG) + (size_t)m * 256 + 4 * lane, q);
      const f32x4 k = up4(raw.k);
      const float ssk = sum16((k.x * k.x + k.y * k.y) + (k.z * k.z + k.w * k.w));
      f32x4 kn = k * dev_rsqrt(ssk * (1.0f / 64.0f) + RMS_EPS) * *(const f32x4*)(p.in(I_GKG) + l * 64 + dd);
      if (lat) { f32x4 o; const bool lo = (lane & 15) < 8; const int i0 = dd & 31; const float* tab = wsp<float>(p, WS_TABG) + ((size_t)t * 32 + i0) * 2;
#pragma unroll
        for (int e = 0; e < 4; ++e) { const f32x4 tv = *(const f32x4*)(tab + 4 * (e >> 1)); const float mine = kn[e], oth = dev_shfl_xor(kn[e], 8), cs = (e & 1) ? tv.z : tv.x, sn = (e & 1) ? tv.w : tv.y; o[e] = lo ? mine * cs - oth * sn : oth * sn + mine * cs; }
        kn = o; }
      if (lane < 32) st4bf(wsp<bf16_t>(p, A_KG) + (size_t)m * 128 + 4 * lane, kn);
 }
    { f32x4 cq = up4(raw.cq); const float ss = wave_sum((cq.x * cq.x + cq.y * cq.y) + (cq.z * cq.z + cq.w * cq.w));
      cq = cq * dev_rsqrt(ss * (1.0f / 256.0f) + RMS_EPS) * *(const f32x4*)(p.in(I_MQG) + l * 256 + 4 * lane);
      st4bf(wsp<bf16_t>(p, A_CQN) + (size_t)m * 256 + 4 * lane, cq);
      f32x4 x = up4(raw.ck);
      if (lane >= 40) x = (f32x4){0.f, 0.f, 0.f, 0.f};
      const float s2 = wave_sum(lane < 32 ? (x.x * x.x + x.y * x.y) + (x.z * x.z + x.w * x.w) : 0.f);
      if (lane < 32) { const f32x4 o = x * dev_rsqrt(s2 * (1.0f / 128.0f) + RMS_EPS) * *(const f32x4*)(p.in(I_MKVG) + l * 128 + 4 * lane); st4bf(wsp<bf16_t>(p, A_CKVN) + (size_t)m * 128 + 4 * lane, o); }
      f32x4 oth;
#pragma unroll
      for (int e = 0; e < 4; ++e) oth[e] = dev_shfl_xor(x[e], 4);
      if (lane >= 32 && lane < 36) { const int i0 = 4 * (lane - 32); f32x4 o1 = x, o2 = oth;
        if (lat) { const float* tab = wsp<float>(p, WS_TABM) + ((size_t)t * 16 + i0) * 2;
#pragma unroll
          for (int e = 0; e < 4; ++e) { const f32x4 tv = *(const f32x4*)(tab + 4 * (e >> 1)); const float cs = (e & 1) ? tv.z : tv.x, sn = (e & 1) ? tv.w : tv.y; o1[e] = x[e] * cs - oth[e] * sn; o2[e] = x[e] * sn + oth[e] * cs; } }
        u32x4 w; w.x = pk2(o1.x, o2.x); w.y = pk2(o1.y, o2.y); w.z = pk2(o1.z, o2.z); w.w = pk2(o1.w, o2.w);
#pragma unroll
        for (int h4 = 0; h4 < 4; ++h4) *(u32x4*)(wsp<bf16_t>(p, A_KM) + (size_t)m * 384 + h4 * 96 + 64 + 2 * i0) = w; } }
  }
}

struct RoRaw { f32x4 v, y[2], g; float rho[2]; };
DI void ro_load(const Params& p, int m, int lane, RoRaw& o) {
  const int hd = lane >> 4, dd = 4 * (lane & 15); const int b = row_batch(m), kpos = row_kpos(m);
  const bf16_t* scs = wsp<bf16_t>(p, A_SCS) + ((size_t)(b * 4 + hd) * NK + kpos) * 192; o.v = ldp4(scs + 64, dd);
#pragma unroll
  for (int d = 0; d < 2; ++d) { o.y[d] = ldp4(wsp<bf16_t>(p, A_YS) + ((size_t)d * MT + m) * 256, 4 * lane);
    o.rho[d] = wsp<float>(p, A_RHO)[((size_t)d * MT + m) * 4 + hd]; }
  o.g = ldp4(wsp<bf16_t>(p, A_RWG) + (size_t)m * 256, 4 * lane);
}
DI void phase_rwkv_out(const Params& p, int l) {
  const int lane = TID & 63; const int ngw = NGWAVE; const int m0 = GWAVE; const int MR = l == 0 ? MT : TL; if (m0 >= MR) return;
  const f32x4 lg = *(const f32x4*)(p.in(I_LNG) + l * 256 + 4 * lane), lb = *(const f32x4*)(p.in(I_LNB) + l * 256 + 4 * lane);
  constexpr int RO_NR = 4;
  for (int mb = m0; mb < MR; mb += RO_NR * ngw) {
    RoRaw rr[RO_NR];
#pragma unroll
    for (int q = 0; q < RO_NR; ++q) if (mb + q * ngw < MR) ro_load(p, mb + q * ngw, lane, rr[q]);
#pragma unroll
    for (int q = 0; q < RO_NR; ++q) { const int m = mb + q * ngw; if (m >= MR) continue; const RoRaw& raw = rr[q];
    f32x4 tot = {0.f, 0.f, 0.f, 0.f};
#pragma unroll
    for (int d = 0; d < 2; ++d) {
      const f32x4 y = raw.y[d];
      const float mean = sum16((y.x + y.y) + (y.z + y.w)) * (1.0f / 64.0f); const f32x4 yc = y - mean;
      const float var = sum16((yc.x * yc.x + yc.y * yc.y) + (yc.z * yc.z + yc.w * yc.w)) * (1.0f / 64.0f);
      tot += yc * dev_rsqrt(var + GN_EPS) * lg + lb + raw.v * raw.rho[d];
    }
    st4bf(wsp<bf16_t>(p, A_Y) + (size_t)m * D + 4 * lane, tot * raw.g);
    if (m < TL) {
      const int b = m / T, tq = m % T, qb = tq / 128, rq = tq % 128, hd = lane >> 4, uu = (b * 2 + (hd >> 1)) * (T / 128) + qb;
      if (uu >= GQ_UNITS - GQ_SPLIT) { const int su = uu - (GQ_UNITS - GQ_SPLIT), w = (hd & 1) * 4 + (rq >> 5), r = rq & 31;
        const size_t i0 = (size_t)((su * 2) * 8 + w), i1 = (size_t)((su * 2 + 1) * 8 + w);
        const float* s0 = wsp<float>(p, A_GST) + i0 * 64 + 2 * r; const float* s1 = wsp<float>(p, A_GST) + i1 * 64 + 2 * r;
        const float m0_ = s0[0], l0 = s0[1], m1_ = s1[0], l1 = s1[1], mx = fmaxf(m0_, m1_), w0 = l0 * dev_exp2(m0_ - mx), w1 = l1 * dev_exp2(m1_ - mx), inv = dev_rcp(w0 + w1);
        const f32x4 o0 = ldp4(wsp<bf16_t>(p, A_GPO) + i0 * 2048 + r * 64, 4 * (lane & 15)), o1 = ldp4(wsp<bf16_t>(p, A_GPO) + i1 * 2048 + r * 64, 4 * (lane & 15));
        st4bf(wsp<bf16_t>(p, A_Y) + (size_t)m * D + 256 + 4 * lane, (o0 * w0 + o1 * w1) * inv); } }
    }
  }
}

constexpr int PMX_LCNT = D * NE * 4  , PMX_RBUF = PMX_LCNT + 64, PMX_MAXR = 32;
template <int NR> DI void post_mixer_rows(const Params& p, int l, char* smem) {
  const int lane = TID & 63; const int mrows = (l == 0) ? MT : TL; const int ngw = NGWAVE; const int m0 = GWAVE;
  auto xsrc_of = [&](int r) { return (l == 0) ? (r < TL ? p.in(I_X) + (size_t)r * D : p.in(I_CTX) + (size_t)(r - TL) * D) : (const float*)(p.out + (size_t)r * D); };
  for (int mb = m0; mb < mrows; mb += NR * ngw) {
    f32x4 yv[NR][4], xv[NR][4];
#pragma unroll
    for (int q = 0; q < NR; ++q) { const int m = mb + q * ngw; if (m < mrows) {
      if (m < TL) load_row4_bf(wsp<bf16_t>(p, A_YO) + (size_t)m * D, lane, yv[q]);
      else { load_row4_bf(wsp<bf16_t>(p, A_YOS) + (size_t)(m - TL) * D, lane, yv[q]);
#pragma unroll
        for (int sl = 1; sl < OS_NS; ++sl) { f32x4 t[4]; load_row4_bf(wsp<bf16_t>(p, A_YOS) + ((size_t)sl * TC + (m - TL)) * D, lane, t);
#pragma unroll
          for (int j = 0; j < 4; ++j) yv[q][j] += t[j]; } }
      load_row4(xsrc_of(m), lane, xv[q]); } }
#pragma unroll
    for (int q = 0; q < NR; ++q) { const int m = mb + q * ngw; if (m < mrows) {
      f32x4 (&y)[4] = yv[q]; f32x4 (&x)[4] = xv[q];
      const float rinv = dev_rsqrt(wave_sum(sumsq4(y)) * (1.0f / D) + RMS_EPS);
      float* xdst = m < TL ? p.out + (size_t)m * D : wsp<float>(p, WS_XSC) + (size_t)(m - TL) * D;
      const float* g1 = p.in(I_NORMG) + (l * 4 + 1) * D; const float* gate = mod_ptr(p, l, m, 2);
#pragma unroll
      for (int j = 0; j < 4; ++j) { const int c = 4 * lane + 256 * j; x[j] = x[j] + *(const f32x4*)(gate + c) * (y[j] * rinv * *(const f32x4*)(g1 + c)); *(f32x4*)(xdst + c) = x[j]; }
      const float rinv2 = dev_rsqrt(wave_sum(sumsq4(x)) * (1.0f / D) + RMS_EPS);
      if (l == 0) { adaln_store(x, rinv2, p.in(I_NORMG) + (l * 4 + 2) * D, mod_ptr(p, l, m, 4), mod_ptr(p, l, m, 3), wsp<bf16_t>(p, A_XN) + (size_t)m * D, lane); }
      else {
        const float* g2 = p.in(I_NORMG) + (l * 4 + 2) * D; const float* sc = mod_ptr(p, l, m, 4); const float* sh = mod_ptr(p, l, m, 3);
        float lg[NE];
#pragma unroll
        for (int e = 0; e < NE; ++e) lg[e] = 0.f;
#pragma unroll
        for (int j = 0; j < 4; ++j) { const int c = 4 * lane + 256 * j; const f32x4 h = x[j] * rinv2 * *(const f32x4*)(g2 + c) * (*(const f32x4*)(sc + c) + 1.0f) + *(const f32x4*)(sh + c);
#pragma unroll
          for (int qq = 0; qq < 4; ++qq) { const float* rr = (const float*)smem + (size_t)(c + qq) * NE;
#pragma unroll
            for (int e = 0; e < NE; ++e) lg[e] += h[qq] * rr[e]; } }
#pragma unroll
        for (int e = 0; e < NE; ++e) lg[e] = wave_sum(lg[e]);
        int e0 = 0; float v0 = lg[0];
#pragma unroll
        for (int e = 1; e < NE; ++e) if (lg[e] > v0) { v0 = lg[e]; e0 = e; }
        int e1 = -1; float v1 = -3.0e38f;
#pragma unroll
        for (int e = 0; e < NE; ++e) if (e != e0 && lg[e] > v1) { v1 = lg[e]; e1 = e; }
        if (lane == 0) { int* lcnt = (int*)(smem + PMX_LCNT); int* rb = (int*)(smem + PMX_RBUF) + ((TID >> 6) * PMX_MAXR + (mb - m0) / ngw + q) * 4;
          rb[0] = e0; rb[1] = dev_lds_add(lcnt + e0, 1); rb[2] = e1; rb[3] = dev_lds_add(lcnt + e1, 1);
          float* rw = (float*)(wsp<int>(p, WS_ROUTE) + (size_t)TL * 4) + (size_t)m * 2; const float w0 = dev_rcp(1.0f + __expf(v1 - v0)); rw[0] = w0; rw[1] = 1.0f - w0; }
      } } }
  }
  if (l == 1) {
    __syncthreads();
    int* lcnt = (int*)(smem + PMX_LCNT); int* lbase = lcnt + NE;
    if (TID < NE) { const int c = lcnt[TID]; lbase[TID] = c ? (int)dev_atomic_add(wsp<unsigned>(p, WS_CTL) + CW_CNT + 64 * TID, (unsigned)c) : 0; }
    __syncthreads();
    const int nrow = m0 < mrows ? (mrows - m0 + ngw - 1) / ngw : 0;
    if (lane < nrow) { const int* rb = (const int*)(smem + PMX_RBUF) + ((TID >> 6) * PMX_MAXR + lane) * 4; int* rt = wsp<int>(p, WS_ROUTE) + (size_t)(m0 + lane * ngw) * 4;
      rt[0] = rb[0]; rt[1] = lbase[rb[0]] + rb[1]; rt[2] = rb[2]; rt[3] = lbase[rb[2]] + rb[3]; }
  }
}
DI void phase_post_mixer(const Params& p, int l, char* smem) {
  if (l == 1) { const int t0 = TID; for (int e = t0; e < D * NE / 4; e += 512) ((f32x4*)smem)[e] = ((const f32x4*)p.in(I_ROUTER))[e]; if (t0 < 2 * NE) ((int*)(smem + PMX_LCNT))[t0] = 0; __syncthreads(); }
  if (l == 0) post_mixer_rows<4>(p, l, smem); else post_mixer_rows<2>(p, l, smem);
}
DI void moe_offsets(const Params& p, int (&off)[NE + 1]) { const unsigned* cnt = wsp<unsigned>(p, WS_CTL) + CW_CNT; off[0] = 0;
#pragma unroll
  for (int e = 0; e < NE; ++e) off[e + 1] = off[e] + (int)((dev_atomic_load(cnt + 64 * e) + 255u) & ~255u); }
DI void phase_moe_gather(const Params& p, int l) {
  const int lane = TID & 63; int off[NE + 1]; moe_offsets(p, off); const int ngw = NGWAVE; const int m0 = GWAVE;
  for (int mb = m0; mb < TL; mb += RW_NR * ngw) {
    f32x4 x[RW_NR][4]; u32x4 rtv[RW_NR];
#pragma unroll
    for (int q = 0; q < RW_NR; ++q) { const int m = mb + q * ngw; if (m < TL) { load_row4(p.out + (size_t)m * D, lane, x[q]); rtv[q] = *(const u32x4*)(wsp<int>(p, WS_ROUTE) + (size_t)m * 4); } }
#pragma unroll
    for (int q = 0; q < RW_NR; ++q) { const int m = mb + q * ngw; if (m < TL) {
      const float rinv2 = dev_rsqrt(wave_sum(sumsq4(x[q])) * (1.0f / D) + RMS_EPS);
      const int e0 = (int)rtv[q].x, p0 = (int)rtv[q].y, e1 = (int)rtv[q].z, p1 = (int)rtv[q].w;
      int o0 = 0, o1 = 0;
#pragma unroll
      for (int e = 0; e < NE; ++e) { if (e == e0) o0 = off[e]; if (e == e1) o1 = off[e]; }
      adaln_store(x[q], rinv2, p.in(I_NORMG) + (l * 4 + 2) * D, mod_ptr(p, l, m, 4), mod_ptr(p, l, m, 3), wsp<bf16_t>(p, A_XG) + (size_t)(o0 + p0) * D, lane);
      adaln_store(x[q], rinv2, p.in(I_NORMG) + (l * 4 + 2) * D, mod_ptr(p, l, m, 4), mod_ptr(p, l, m, 3), wsp<bf16_t>(p, A_XG) + (size_t)(o1 + p1) * D, lane); } }
  }
}
DI void phase_post_ffn0(const Params& p) {
  const int lane = TID & 63; const int ngw = NGWAVE; const int m0 = GWAVE;
  auto xs_of = [&](int r) { return r < TL ? p.out + (size_t)r * D : wsp<float>(p, WS_XSC) + (size_t)(r - TL) * D; };
  for (int mb = m0; mb < MT; mb += RW_NR * ngw) {
    f32x4 f[RW_NR][4], x[RW_NR][4];
#pragma unroll
    for (int q = 0; q < RW_NR; ++q) { const int m = mb + q * ngw; if (m < MT) {
      if (m < TL) load_row4_bf(wsp<bf16_t>(p, A_F) + (size_t)m * D, lane, f[q]);
      else { load_row4_bf(wsp<bf16_t>(p, A_FS) + (size_t)(m - TL) * D, lane, f[q]);
#pragma unroll
        for (int sl = 1; sl < FS_NS; ++sl) { f32x4 t[4]; load_row4_bf(wsp<bf16_t>(p, A_FS) + ((size_t)sl * TC + (m - TL)) * D, lane, t);
#pragma unroll
          for (int j = 0; j < 4; ++j) f[q][j] += t[j]; } }
      load_row4(xs_of(m), lane, x[q]); } }
#pragma unroll
    for (int q = 0; q < RW_NR; ++q) { const int m = mb + q * ngw; if (m < MT) {
      const float rinv = dev_rsqrt(wave_sum(sumsq4(f[q])) * (1.0f / D) + RMS_EPS);
      float* xs = xs_of(m);
      const float* g3 = p.in(I_NORMG) + 3 * D; const float* gate = mod_ptr(p, 0, m, 5);
#pragma unroll
      for (int j = 0; j < 4; ++j) { const int c = 4 * lane + 256 * j; x[q][j] = x[q][j] + *(const f32x4*)(gate + c) * (f[q][j] * rinv * *(const f32x4*)(g3 + c)); *(f32x4*)(xs + c) = x[q][j]; }
      const float rinv2 = dev_rsqrt(wave_sum(sumsq4(x[q])) * (1.0f / D) + RMS_EPS);
      adaln_store(x[q], rinv2, p.in(I_NORMG) + 4 * D, mod_ptr(p, 1, m, 1), mod_ptr(p, 1, m, 0), wsp<bf16_t>(p, A_XN) + (size_t)m * D, lane); } }
  }
}
DI void phase_moe_combine(const Params& p, int l) {
  const int lane = TID & 63; int off[NE + 1]; moe_offsets(p, off); const bf16_t* FG = wsp<bf16_t>(p, A_XG); const int ngw = NGWAVE; const int m0 = GWAVE;
  for (int mb = m0; mb < TL; mb += RW_NR * ngw) {
    u32x2 ra[RW_NR][4], rb[RW_NR][4]; f32x4 x[RW_NR][4]; float w0[RW_NR], w1[RW_NR]; u32x4 rtv[RW_NR];
#pragma unroll
    for (int q = 0; q < RW_NR; ++q) { const int m = mb + q * ngw; if (m < TL) {
      rtv[q] = *(const u32x4*)(wsp<int>(p, WS_ROUTE) + (size_t)m * 4); const float* rw = (const float*)(wsp<int>(p, WS_ROUTE) + (size_t)TL * 4) + (size_t)m * 2; w0[q] = rw[0]; w1[q] = rw[1];
      load_row4(p.out + (size_t)m * D, lane, x[q]); } }
#pragma unroll
    for (int q = 0; q < RW_NR; ++q) { const int m = mb + q * ngw; if (m < TL) {
      const int e0 = (int)rtv[q].x, p0 = (int)rtv[q].y, e1 = (int)rtv[q].z, p1 = (int)rtv[q].w;
      int o0 = 0, o1 = 0;
#pragma unroll
      for (int e = 0; e < NE; ++e) { if (e == e0) o0 = off[e]; if (e == e1) o1 = off[e]; }
      const int s0 = o0 + p0, s1 = o1 + p1; const float* SL = wsp<float>(p, WS_MSLAB);
      auto ldrow = [&](int s, u32x2 (&r)[4]) {
        if (s < MOE_NFULL * 256) { const bf16_t* rr = FG + (size_t)s * D;
#pragma unroll
          for (int j = 0; j < 4; ++j) r[j] = *(const u32x2*)(rr + 4 * lane + 256 * j); }
        else { const float* rr = SL + (size_t)(s - MOE_NFULL * 256) * D;
#pragma unroll
          for (int j = 0; j < 4; ++j) { f32x4 t = *(const f32x4*)(rr + 4 * lane + 256 * j);
#pragma unroll
            for (int ks = 1; ks < MOE_NS; ++ks) t += *(const f32x4*)(rr + (size_t)ks * MOE_TAILROWS * D + 4 * lane + 256 * j);
            r[j].x = pk2(t.x, t.y); r[j].y = pk2(t.z, t.w); } } };
      ldrow(s0, ra[q]); ldrow(s1, rb[q]); } }
#pragma unroll
    for (int q = 0; q < RW_NR; ++q) { const int m = mb + q * ngw; if (m < TL) {
      f32x4 f[4];
#pragma unroll
      for (int j = 0; j < 4; ++j) f[j] = up4(ra[q][j]) * w0[q] + up4(rb[q][j]) * w1[q];
      const float rinv = dev_rsqrt(wave_sum(sumsq4(f)) * (1.0f / D) + RMS_EPS);
      float* xs = p.out + (size_t)m * D; const float* g3 = p.in(I_NORMG) + (l * 4 + 3) * D; const float* gate = mod_ptr(p, l, m, 5);
#pragma unroll
      for (int j = 0; j < 4; ++j) { const int c = 4 * lane + 256 * j; *(f32x4*)(xs + c) = x[q][j] + *(const f32x4*)(gate + c) * (f[j] * rinv * *(const f32x4*)(g3 + c)); } } }
  }
}

struct EpiStoreBf16 { bf16_t* O; int ld; int ncols;
  DI void store8(int urow, int row, int col, const float (&v)[8]) const { if (col >= ncols) return; u32x4 w; w.x = pk2(v[0], v[1]); w.y = pk2(v[2], v[3]); w.z = pk2(v[4], v[5]); w.w = pk2(v[6], v[7]); *(u32x4*)(O + (size_t)row * ld + col) = w; } };
struct EpiInProj { bf16_t* P; bf16_t* QKVN;
  DI void store8(int urow, int row, int col, const float (&v)[8]) const { if (col >= 2720) return; u32x4 w; w.x = pk2(v[0], v[1]); w.y = pk2(v[2], v[3]); w.z = pk2(v[4], v[5]); w.w = pk2(v[6], v[7]);
    if (col >= 1952) *(u32x4*)(QKVN + (size_t)row * 896 + (col - 1952)) = w; else if (col >= 1408 && col < 1536) *(u32x4*)(QKVN + (size_t)row * 896 + 768 + (col - 1408)) = w; else *(u32x4*)(P + (size_t)row * PW + col) = w; } };
struct EpiStoreF32 { float* O; int ld;
  DI void store8(int urow, int row, int col, const float (&v)[8]) const { float* o = O + (size_t)row * ld + col; *(f32x4*)o = (f32x4){v[0], v[1], v[2], v[3]}; *(f32x4*)(o + 4) = (f32x4){v[4], v[5], v[6], v[7]}; } };
struct EpiSwiGlu { bf16_t* O; int ld;
  DI void store8(int urow, int row, int col, const float (&v)[8]) const { u32x2 w; w.x = pk2(siluf_(v[0]) * v[1], siluf_(v[2]) * v[3]); w.y = pk2(siluf_(v[4]) * v[5], siluf_(v[6]) * v[7]); *(u32x2*)(O + (size_t)row * ld + (col >> 1)) = w; } };
struct LoraIn { u32x4 kk8, ks8; };
DI void lora_lw8(const float (&v)[8], const f32x4 wa, const f32x4 wb, f32x4& oa, f32x4& ob) {
#pragma unroll
  for (int i = 0; i < 4; ++i) { oa[i] = (-0.6065306597126334f * LOG2E) * sigmoidf_(wa[i] + v[i]); ob[i] = (-0.6065306597126334f * LOG2E) * sigmoidf_(wb[i] + v[4 + i]); } }
DI void lora_bk8(const float (&v)[8], const f32x4 (&a0v)[2], const f32x4 (&kav)[2], const LoraIn& in, u32x4& wb, u32x4& wk) { float ob[8], ok[8];
#pragma unroll
  for (int hf = 0; hf < 2; ++hf) { const f32x4 ksv = up4((u32x2){in.ks8[2 * hf], in.ks8[2 * hf + 1]}); const f32x4 kkv = up4((u32x2){in.kk8[2 * hf], in.kk8[2 * hf + 1]});
#pragma unroll
    for (int i = 0; i < 4; ++i) { const float a = sigmoidf_(a0v[hf][i] + v[4 * hf + i]); ob[4 * hf + i] = kkv[i] * a; ok[4 * hf + i] = ksv[i] * (1.0f + (a - 1.0f) * kav[hf][i]); } }
  wb.x = pk2(ob[0], ob[1]); wb.y = pk2(ob[2], ob[3]); wb.z = pk2(ob[4], ob[5]); wb.w = pk2(ob[6], ob[7]);
  wk.x = pk2(ok[0], ok[1]); wk.y = pk2(ok[2], ok[3]); wk.z = pk2(ok[4], ok[5]); wk.w = pk2(ok[6], ok[7]); }
struct EpiLora { const Params* p; int l;
  DI float* lw_dst(int blk, int b, int hd, int kpos, int dd) const { return wsp<float>(*p, A_SCD) + ((size_t)((blk * NB + b) * 4 + hd) * NK + kpos) * 192 + dd; }
  DI bf16_t* bk_dst(int d, int b, int hd, int kpos, int dd) const { return (bf16_t*)(wsp<float>(*p, A_SCD) + ((size_t)((d * NB + b) * 4 + hd) * NK + kpos) * 192 + 64) + dd; }
  DI void bk_load(int b, int hd, int kpos, int dd, int m, int cc, LoraIn& in) const { const bf16_t* kk = wsp<bf16_t>(*p, A_SCS) + ((size_t)(b * 4 + hd) * NK + kpos) * 192 + 128 + dd; const bf16_t* ks = wsp<bf16_t>(*p, A_KSH) + (size_t)m * 256 + cc;
    in.kk8 = *(const u32x4*)kk; in.ks8 = *(const u32x4*)ks; }
  DI void store8(int urow, int m, int col, const float (&v)[8]) const {
    const int blk = col >> 8, cc = col & 255, hd = cc >> 6, dd = cc & 63; const int b = row_batch(urow), kpos = row_kpos(urow) + (m - urow);
    if (blk < 2) { const float* w0 = p->in(I_W0) + (l * 2 + blk) * 256 + cc; float* dst = lw_dst(blk, b, hd, kpos, dd); f32x4 oa, ob;
      lora_lw8(v, *(const f32x4*)w0, *(const f32x4*)(w0 + 4), oa, ob); *(f32x4*)dst = oa; *(f32x4*)(dst + 4) = ob; }
    else if (blk < 4) { const int d = blk - 2; const float* a0 = p->in(I_A0) + (l * 2 + d) * 256 + cc; const float* ka = p->in(I_KA) + l * 256 + cc;
      const f32x4 a0v[2] = {*(const f32x4*)a0, *(const f32x4*)(a0 + 4)}, kav[2] = {*(const f32x4*)ka, *(const f32x4*)(ka + 4)};
      LoraIn in; bk_load(b, hd, kpos, dd, m, cc, in); u32x4 wb, wk; lora_bk8(v, a0v, kav, in, wb, wk);
      bf16_t* dst = bk_dst(d, b, hd, kpos, dd); *(u32x4*)dst = wb; *(u32x4*)(dst + 64) = wk; }
    else if (blk == 4) { u32x4 w; w.x = pk2(v[0], v[1]); w.y = pk2(v[2], v[3]); w.z = pk2(v[4], v[5]); w.w = pk2(v[6], v[7]); *(u32x4*)(wsp<bf16_t>(*p, A_RWG) + (size_t)m * 256 + cc) = w; }
  } };
struct EpiMlaQ { const Params* p;
  DI void store8(int urow, int m, int col, const float (&v0)[8]) const { if (col >= 384) return; const int dd = col % 96; float o[8], v[8];
#pragma unroll
    for (int i = 0; i < 8; ++i) { v[i] = v0[i] * (0.10206207261596575f * LOG2E); o[i] = v[i]; }
    if (dd >= 64 && m < TL) { const int i0 = (dd - 64) >> 1; const float* tab = wsp<float>(*p, WS_TABM) + ((size_t)(m % T) * 16 + i0) * 2; const f32x4 t0 = *(const f32x4*)tab, t1 = *(const f32x4*)(tab + 4);
      const float cs4[4] = {t0.x, t0.z, t1.x, t1.z}, sn4[4] = {t0.y, t0.w, t1.y, t1.w};
#pragma unroll
      for (int u = 0; u < 4; ++u) { const float cs = cs4[u], sn = sn4[u]; o[2 * u] = v[2 * u] * cs - v[2 * u + 1] * sn; o[2 * u + 1] = v[2 * u] * sn + v[2 * u + 1] * cs; } }
    u32x4 w; w.x = pk2(o[0], o[1]); w.y = pk2(o[2], o[3]); w.z = pk2(o[4], o[5]); w.w = pk2(o[6], o[7]); *(u32x4*)(wsp<bf16_t>(*p, A_QM) + (size_t)m * 384 + col) = w; } };
struct EpiMlaKV { const Params* p;
  DI void store8(int urow, int m, int col, const float (&v)[8]) const { const int hd = col >> 7, dd = col & 127; u32x4 w; w.x = pk2(v[0], v[1]); w.y = pk2(v[2], v[3]); w.z = pk2(v[4], v[5]); w.w = pk2(v[6], v[7]);
    if (dd < 64) *(u32x4*)(wsp<bf16_t>(*p, A_KM) + (size_t)m * 384 + hd * 96 + dd) = w; else *(u32x4*)(wsp<bf16_t>(*p, A_VM) + (size_t)m * 256 + hd * 64 + dd - 64) = w; } };

struct TileSrc { const bf16_t* k; const bf16_t* v; int kr; };
constexpr int ATT_VP = 144;
template <int DQ> struct AttL { static constexpr int KP = DQ * 2 + 16, KB = 64 * KP, VB = 64 * ATT_VP, BUF = KB + VB; };
constexpr int ATT_SCR = 2 * AttL<96>::BUF;
constexpr int ATT_BIAS = ATT_SCR + 8 * 256;
constexpr int ATT_LDS = ATT_BIAS + 2048;

template <int DQ, bool NAT, class TileFn>
DI void attn_unit(char* smem, const bf16_t* qptr, int qpitch, bf16_t* optr, int opitch, int ntiles, TileFn tilefn, int kpitch, int vpitch, float sc, int nat_qi, int nat_c0) {
  typedef AttL<DQ> L; constexpr int NDS = DQ / 16, KCH = DQ / 8;
  const int tid = TID, lane = tid & 63, wave = tid >> 6, r = lane & 31, h = lane >> 5;
  float* scr = (float*)(smem + ATT_SCR + wave * 256); const float* btab = (const float*)(smem + ATT_BIAS);
  bf16x8 qf[NDS];
#pragma unroll
  for (int ds = 0; ds < NDS; ++ds) qf[ds] = *(const bf16x8*)(qptr + (size_t)r * qpitch + 16 * ds + 8 * h);
  f32x16 o0, o1, lacc;
#pragma unroll
  for (int i = 0; i < 16; ++i) { o0[i] = 0.f; o1[i] = 0.f; lacc[i] = 0.f; }
  float m_run = -1.0e30f;
  const bf16x8 ones8 = {0x3f80, 0x3f80, 0x3f80, 0x3f80, 0x3f80, 0x3f80, 0x3f80, 0x3f80};
  const int kr0 = tid / KCH, kc0 = tid % KCH, kr1 = (tid + 512) / KCH, kc1 = (tid + 512) % KCH; const bool two = (DQ == 96) && (tid < 256);
  const int vr = tid >> 3, vc = tid & 7;
  u32x4 gk0, gk1 = {0, 0, 0, 0}, gv, hk0 = {0, 0, 0, 0}, hk1 = {0, 0, 0, 0}, hv = {0, 0, 0, 0};
  { const TileSrc ts = tilefn(0); gk0 = *(const u32x4*)(ts.k + (size_t)kr0 * kpitch + kc0 * 8); if (two) gk1 = *(const u32x4*)(ts.k + (size_t)kr1 * kpitch + kc1 * 8); gv = *(const u32x4*)(ts.v + (size_t)vr * vpitch + vc * 8);
    *(u32x4*)(smem + kr0 * L::KP + kc0 * 16) = gk0; if (two) *(u32x4*)(smem + kr1 * L::KP + kc1 * 16) = gk1; *(u32x4*)(smem + L::KB + vr * ATT_VP + vc * 16) = gv; }
  if (ntiles > 1) { const TileSrc ts = tilefn(1); gk0 = *(const u32x4*)(ts.k + (size_t)kr0 * kpitch + kc0 * 8); if (two) gk1 = *(const u32x4*)(ts.k + (size_t)kr1 * kpitch + kc1 * 8); gv = *(const u32x4*)(ts.v + (size_t)vr * vpitch + vc * 8); }
  __syncthreads();
  const int nat_rs = NAT ? (nat_qi - 4 < 0 ? 0 : (nat_qi - 4 > GROWS - 8 ? GROWS - 8 : nat_qi - 4)) : 0;
  const int qc = nat_c0 + r, cs = qc - 8 < 0 ? 0 : (qc - 8 > 48 ? 48 : qc - 8);
  for (int it = 0; it < ntiles; ++it) {
    const char* buf = smem + (it & 1) * L::BUF; char* nbuf = smem + ((it + 1) & 1) * L::BUF;
    const TileSrc cur = tilefn(it);
    if (it + 2 < ntiles) { const TileSrc ts = tilefn(it + 2); hk0 = *(const u32x4*)(ts.k + (size_t)kr0 * kpitch + kc0 * 8); if (two) hk1 = *(const u32x4*)(ts.k + (size_t)kr1 * kpitch + kc1 * 8); hv = *(const u32x4*)(ts.v + (size_t)vr * vpitch + vc * 8); }
    const bool active = !NAT || cur.kr < 0 || (cur.kr >= nat_rs && cur.kr < nat_rs + 8);
    if (active) {
      f32x16 s0, s1;
#pragma unroll
      for (int i = 0; i < 16; ++i) { s0[i] = 0.f; s1[i] = 0.f; }
#pragma unroll
      for (int ds = 0; ds < NDS; ++ds) { const bf16x8 a0 = *(const bf16x8*)(buf + r * L::KP + (16 * ds + 8 * h) * 2), a1 = *(const bf16x8*)(buf + (32 + r) * L::KP + (16 * ds + 8 * h) * 2);
        s0 = dev_mfma32(a0, qf[ds], s0); s1 = dev_mfma32(a1, qf[ds], s1); }
      float mx = -1.0e30f;
      if (NAT && cur.kr >= 0) {
#pragma unroll
        for (int i = 0; i < 16; ++i) { float x0 = s0[i] * sc, x1 = s1[i] * sc;
          const int k0 = crow(i, h), k1 = 32 + k0; const float* brow = btab + (cur.kr - nat_qi + 7) * 31 + 15 - qc;
          x0 = (k0 >= cs && k0 < cs + 16) ? x0 + brow[k0] * LOG2E : -1.0e30f; x1 = (k1 >= cs && k1 < cs + 16) ? x1 + brow[k1] * LOG2E : -1.0e30f;
          s0[i] = x0; s1[i] = x1; mx = fmaxf(mx, fmaxf(x0, x1)); }
      } else {
        dev_mfma_settle(s0, s1);
#pragma unroll
        for (int i = 0; i < 16; ++i) mx = dev_max3(mx, s0[i], s1[i]);
        mx *= sc;
      }
      mx = fmaxf(mx, dev_shfl_xor(mx, 32));
      const float m_new = fmaxf(m_run, mx), alpha = dev_exp2(m_run - m_new); const bool grew = m_new > m_run; m_run = m_new;
      if (NAT && cur.kr >= 0) {
#pragma unroll
        for (int i = 0; i < 16; ++i) { s0[i] = dev_exp2(s0[i] - m_new); s1[i] = dev_exp2(s1[i] - m_new); }
      } else {
#pragma unroll
        for (int i = 0; i < 16; ++i) { s0[i] = dev_exp2(s0[i] * sc - m_new); s1[i] = dev_exp2(s1[i] * sc - m_new); }
      }
      if (dev_any(grew)) {
        if (h == 0) scr[r] = alpha;
        dev_wave_fence();
#pragma unroll
        for (int g = 0; g < 4; ++g) { const f32x4 a = *(const f32x4*)(scr + 8 * g + 4 * h);
#pragma unroll
          for (int e = 0; e < 4; ++e) { o0[4 * g + e] *= a[e]; o1[4 * g + e] *= a[e]; lacc[4 * g + e] *= a[e]; } }
        dev_wave_fence();
      }
      const char* vbase = buf + L::KB + (4 * h + ((lane & 15) >> 2)) * ATT_VP + (((lane >> 4) & 1) * 16 + (lane & 3) * 4) * 2;
#pragma unroll
      for (int kvb = 0; kvb < 2; ++kvb)
#pragma unroll
        for (int s = 0; s < 2; ++s) { bf16x8 pa;
#pragma unroll
          for (int j = 0; j < 8; j += 2) { const unsigned w = kvb ? pk2(s1[8 * s + j], s1[8 * s + j + 1]) : pk2(s0[8 * s + j], s0[8 * s + j + 1]); pa[j] = (short)(w & 0xffffu); pa[j + 1] = (short)(w >> 16); }
          lacc = dev_mfma32(pa, ones8, lacc);
          const char* vb = vbase + (32 * kvb + 16 * s) * ATT_VP;
          { const s16x4 lo = dev_tr16(vb), hi = dev_tr16(vb + 8 * ATT_VP); const bf16x8 bv = {lo[0], lo[1], lo[2], lo[3], hi[0], hi[1], hi[2], hi[3]}; o0 = dev_mfma32(pa, bv, o0); }
          { const s16x4 lo = dev_tr16(vb + 64), hi = dev_tr16(vb + 8 * ATT_VP + 64); const bf16x8 bv = {lo[0], lo[1], lo[2], lo[3], hi[0], hi[1], hi[2], hi[3]}; o1 = dev_mfma32(pa, bv, o1); } }
    }
    if (it + 1 < ntiles) { *(u32x4*)(nbuf + kr0 * L::KP + kc0 * 16) = gk0; if (two) *(u32x4*)(nbuf + kr1 * L::KP + kc1 * 16) = gk1; *(u32x4*)(nbuf + L::KB + vr * ATT_VP + vc * 16) = gv; }
    __syncthreads();
    gk0 = hk0; gk1 = hk1; gv = hv;
  }
#pragma unroll
  for (int i = 0; i < 16; ++i) { const float li = dev_rcp(lacc[i]); bf16_t* orow = optr + (size_t)crow(i, h) * opitch;
    orow[r] = (bf16_t)f2bf(o0[i] * li); orow[32 + r] = (bf16_t)f2bf(o1[i] * li); }
  dev_wave_fence();
  __syncthreads();
}

DI f32x16 zero16() { f32x16 z;
#pragma unroll
  for (int i = 0; i < 16; ++i) z[i] = 0.f;
  return z; }
template <int NDS> struct A2L { static constexpr int SLOT = NDS * 2048, K = 0, V = 3 * SLOT, WS = 6 * SLOT, OST = WS + 8 * 256, BYTES = OST + 8 * 4096; };
static_assert(A2L<6>::BYTES <= 131072 - 256, "attn2 LDS map");
#ifdef EMU
typedef const char* a2_lptr;
#define A2_SBAR() do {} while (0)
#define A2_PIN(x) do {} while (0)
template <int N> DI void a2_waitbar() { __syncthreads(); }
DI bf16x8 a2_ld8(a2_lptr q) { return *(const bf16x8*)q; }
DI float a2_swapmax(float m) { return fmaxf(m, dev_shfl_xor(m, 32)); }
DI float a2_swapsum(float m) { return m + dev_shfl_xor(m, 32); }
DI float a2_sub(float a, float b) { return a - b; }
DI float a2_rcp(float x) { return 1.0f / x; }
#else
typedef LAS const char* a2_lptr;
#define A2_SBAR() __builtin_amdgcn_sched_barrier(0)
#define A2_PIN(x) asm volatile("" : "+v"(x))
template <int N> DI void a2_waitbar() { asm volatile("s_waitcnt vmcnt(%0) lgkmcnt(0)\n\ts_barrier" ::"n"(N) : "memory"); }
DI bf16x8 a2_ld8(a2_lptr q) { return *(LAS const bf16x8*)q; }
DI float a2_swapmax(float m) { auto rr = __builtin_amdgcn_permlane32_swap(__float_as_uint(m), __float_as_uint(m), false, false); return __builtin_fmaxf(__uint_as_float(rr[0]), __uint_as_float(rr[1])); }
DI float a2_swapsum(float m) { auto rr = __builtin_amdgcn_permlane32_swap(__float_as_uint(m), __float_as_uint(m), false, false); return __uint_as_float(rr[0]) + __uint_as_float(rr[1]); }
DI float a2_sub(float a, float b) { float r; asm("v_sub_f32_e32 %0, %1, %2" : "=v"(r) : "v"(a), "v"(b)); return r; }
DI float a2_rcp(float x) { return __builtin_amdgcn_rcpf(x); }
#endif
DI s16x4 a2_vtr(a2_lptr q) { return dev_tr16((const void*)q); }

template <int NDS, int THRL, bool HALF = false>
DI void attn2_unit(char* smem, const bf16_t* qptr, int qpitch, bf16_t* optr, int opitch, const bf16_t* kcol, int kpitch, const bf16_t* vcol, int vpitch, int b, int half = 0, float* stats = nullptr) {
  const int tid = TID, lane = tid & 63, r32 = lane & 31, hi = lane >> 5; const int wid = dev_uniform(tid >> 6);
  typedef A2L<NDS> L; constexpr int A2_SLOT = L::SLOT, KN = NDS == 4 ? 1 : 2;
  constexpr int NT = HALF ? NK / 128 : NK / 64; static_assert((NK / 64) % 4 == 0 && NK / 128 >= 8 && (NDS == 4 || NDS == 6), "tile count / head dim"); const int t0 = HALF ? half * NT : 0;
  auto mrow = [&](int tt) { const int t = tt + t0; return t < T / 64 ? b * T + 64 * t : TL + b * C + 64 * (t - T / 64); };
  float* wsf = (float*)(smem + L::WS) + wid * 64;
  const bf16_t* ksrc = kcol + (size_t)lane * kpitch + wid * 8;
  const bf16_t* vsrc = vcol + (size_t)(16 * (wid & 3) + (lane >> 2)) * vpitch + (wid >> 2) * 32 + (lane & 3) * 8;
  char* kdst = smem + L::K + wid * 1024; char* vdst = smem + L::V + wid * 1024;
  const bf16_t* ksrc2 = kcol + (size_t)(32 * (wid & 1) + r32) * kpitch + (8 + (wid >> 1)) * 8; char* kdst2 = smem + L::K + (8 + (wid >> 1)) * 1024 + (wid & 1) * 512;
#define DMA_K(t, slot) do { dev_glds16(ksrc + (size_t)mrow(t) * kpitch, kdst + (slot)); if (NDS == 6) { if (lane < 32) dev_glds16(ksrc2 + (size_t)mrow(t) * kpitch, kdst2 + (slot)); } } while (0)
#define DMA_V(t, slot) dev_glds16(vsrc + (size_t)mrow(t) * vpitch, vdst + (slot))
  const a2_lptr shm3 = (a2_lptr)smem; const a2_lptr kp0 = shm3 + L::K + hi * 1024 + r32 * 16; const a2_lptr vp0 = shm3 + L::V + ((lane >> 4) & 1) * 32 + (lane & 3) * 8 + (4 * hi + ((lane & 15) >> 2)) * 64;
  bf16x8 kf[2 * NDS];
  DMA_K(0, 0); DMA_V(0, 0); DMA_K(1, A2_SLOT);
  bf16x8 qr[NDS];
#pragma unroll
  for (int d0 = 0; d0 < NDS; ++d0) qr[d0] = *(const bf16x8*)(qptr + (size_t)r32 * qpitch + d0 * 16 + hi * 8);
  float mhat = 0.f, l_reg = 0.f; f32x16 o[2]; o[0] = zero16(); o[1] = zero16(); f32x16 negm = zero16(); A2_PIN(negm);
  bool resc = false;
#define RESC() do { if (resc) { dev_wave_fence(); _Pragma("unroll") for (int d_ = 0; d_ < 2; ++d_) _Pragma("unroll") for (int r = 0; r < 16; ++r) o[d_][r] *= wsf[crow(r, hi)]; } } while (0)
  f32x16 pA0, pA1, pB0, pB1;
  int sl_prev = 0, sl_cur = 0, sl_next = A2_SLOT;
#define ROT() do { sl_prev = sl_cur; sl_cur = sl_next; sl_next = (sl_next == 2 * A2_SLOT) ? 0 : sl_next + A2_SLOT; } while (0)
#define KLD2(kp, j) do { kf[2 * (j)] = a2_ld8((kp) + (j) * 2048); kf[2 * (j) + 1] = a2_ld8((kp) + (j) * 2048 + 512); } while (0)
  DMA_K(2, 2 * A2_SLOT);
  a2_waitbar<1 + 2 * KN>();
#pragma unroll
  for (int j = 0; j < NDS; ++j) KLD2(kp0, j);
  pA0 = dev_mfma32(kf[0], qr[0], negm); pA1 = dev_mfma32(kf[1], qr[0], negm);
#pragma unroll
  for (int d0 = 1; d0 < NDS; ++d0) { pA0 = dev_mfma32(kf[2 * d0], qr[d0], pA0); pA1 = dev_mfma32(kf[2 * d0 + 1], qr[d0], pA1); }
  dev_mfma_settle(pA0, pA1);
  { float a = dev_max3(pA0[0], pA0[1], pA1[0]), c = dev_max3(pA0[2], pA0[3], pA1[1]); a = dev_max3(a, pA1[2], pA1[3]);
#pragma unroll
    for (int r = 4; r < 16; r += 4) { a = dev_max3(a, pA0[r], pA0[r + 1]); c = dev_max3(c, pA0[r + 2], pA0[r + 3]); a = dev_max3(a, pA1[r], pA1[r + 1]); c = dev_max3(c, pA1[r + 2], pA1[r + 3]); }
    const float dl = a2_swapmax(fmaxf(a, c)); mhat = dl;
#pragma unroll
    for (int r = 0; r < 16; ++r) { pA0[r] = dev_exp2(a2_sub(pA0[r], dl)); pA1[r] = dev_exp2(a2_sub(pA1[r], dl)); }
#pragma unroll
    for (int r = 0; r < 16; ++r) negm[r] = -mhat;
    A2_PIN(negm); }
  a2_waitbar<0>();
  DMA_K(3, 0); DMA_V(1, A2_SLOT);
  ROT();
#pragma unroll
  for (int j = 0; j < NDS; ++j) KLD2(kp0 + sl_cur, j);
  a2_waitbar<KN + 1>();
  s16x4 vlo[8], vhi[8]; u32x4 pw0, pw1, pw2, pw3;
#define PKW(P, B) pk2(P[B], P[(B) + 1])
#define PAF(k) __builtin_bit_cast(bf16x8, pw##k)
#define VFR(i) (bf16x8){vlo[i][0], vlo[i][1], vlo[i][2], vlo[i][3], vhi[i][0], vhi[i][1], vhi[i][2], vhi[i][3]}
#define MX3(a, b, c) __builtin_fmaxf(__builtin_fmaxf((a), (b)), (c))
#define GAPA(MF, A0, A1, A2, A3, W0, W1, PW) do { MF; sacc += A0; sacc += A1; sacc += A2; sacc += A3; A2_PIN(sacc); W0; W1; A2_PIN(PW); A2_SBAR(); } while (0)
#define GAPB(MF, X, B) do { MF; X[B] = dev_exp2(X[B]); X[(B) + 1] = dev_exp2(X[(B) + 1]); X[(B) + 2] = dev_exp2(X[(B) + 2]); X[(B) + 3] = dev_exp2(X[(B) + 3]); A2_PIN(X); A2_SBAR(); } while (0)
#define VRD(i) do { vlo[i] = a2_vtr(vp_ + (((i) >> 2) * 4096 + ((i) & 3) * 1024)); vhi[i] = a2_vtr(vp_ + (((i) >> 2) * 4096 + ((i) & 3) * 1024 + 512)); } while (0)
#define KRD(G, j) do { if (G) { KLD2(kp0 + sl_next, j); A2_SBAR(); } } while (0)
#define STEP(C0, C1, P0, P1, t, GK, GV, GL) do { A2_SBAR(); \
    const a2_lptr vp_ = vp0 + sl_prev; \
    VRD(0); A2_SBAR(); float sacc = (P0[0] + P0[1]); \
    GAPA(C0 = dev_mfma32(kf[0], qr[0], negm), P0[2], P0[3], P0[4], P0[5], pw0[0] = PKW(P0, 0), pw0[1] = PKW(P0, 2), pw0); \
    VRD(4); A2_SBAR(); GAPA(C1 = dev_mfma32(kf[1], qr[0], negm), P0[6], P0[7], P0[8], P0[9], pw0[2] = PKW(P0, 4), pw0[3] = PKW(P0, 6), pw0); \
    VRD(1); A2_SBAR(); GAPA(C0 = dev_mfma32(kf[2], qr[1], C0), P0[10], P0[11], P0[12], P0[13], pw1[0] = PKW(P0, 8), pw1[1] = PKW(P0, 10), pw1); \
    VRD(5); A2_SBAR(); GAPA(C1 = dev_mfma32(kf[3], qr[1], C1), P0[14], P0[15], P1[0], P1[1], pw1[2] = PKW(P0, 12), pw1[3] = PKW(P0, 14), pw1); \
    VRD(2); A2_SBAR(); GAPA(C0 = dev_mfma32(kf[4], qr[2], C0), P1[2], P1[3], P1[4], P1[5], pw2[0] = PKW(P1, 0), pw2[1] = PKW(P1, 2), pw2); \
    VRD(6); A2_SBAR(); GAPA(C1 = dev_mfma32(kf[5], qr[2], C1), P1[6], P1[7], P1[8], P1[9], pw2[2] = PKW(P1, 4), pw2[3] = PKW(P1, 6), pw2); \
    VRD(3); A2_SBAR(); GAPA(C0 = dev_mfma32(kf[6], qr[3], C0), P1[10], P1[11], P1[12], P1[13], pw3[0] = PKW(P1, 8), pw3[1] = PKW(P1, 10), pw3); \
    VRD(7); A2_SBAR(); GAPA(C1 = dev_mfma32(kf[7], qr[3], C1), P1[14], P1[15], 0.f, 0.f, pw3[2] = PKW(P1, 12), pw3[3] = PKW(P1, 14), pw3); \
    if constexpr (NDS == 6) { C0 = dev_mfma32(kf[8], qr[4], C0); A2_SBAR(); C1 = dev_mfma32(kf[9], qr[4], C1); A2_SBAR(); C0 = dev_mfma32(kf[10], qr[5], C0); A2_SBAR(); C1 = dev_mfma32(kf[11], qr[5], C1); A2_SBAR(); } \
    l_reg += sacc; \
    if (GK) { DMA_K((t) + 3, sl_cur); } if (GV) { DMA_V((t) + 1, sl_next); } \
    { float a = MX3(C0[0], C0[1], C1[0]), c_ = MX3(C0[2], C0[3], C1[1]); a = MX3(a, C1[2], C1[3]); \
      _Pragma("unroll") for (int r = 4; r < 16; r += 4) { a = MX3(a, C0[r], C0[r + 1]); c_ = MX3(c_, C0[r + 2], C0[r + 3]); a = MX3(a, C1[r], C1[r + 1]); c_ = MX3(c_, C1[r + 2], C1[r + 3]); } \
      const float rm = a2_swapmax(__builtin_fmaxf(a, c_)); \
      resc = false; \
      if (__builtin_expect(dev_any(rm > (float)THRL), 0)) { const float dl = __builtin_fmaxf(rm, 0.f); mhat += dl; \
        _Pragma("unroll") for (int r = 0; r < 16; ++r) { C0[r] -= dl; C1[r] -= dl; } \
        _Pragma("unroll") for (int r = 0; r < 16; ++r) negm[r] = -mhat; \
        A2_PIN(negm); \
        const float f = dev_exp2(-dl); l_reg *= f; if (hi == 0) wsf[r32] = f; resc = true; } } \
    A2_SBAR(); \
    GAPB(o[0] = dev_mfma32(PAF(0), VFR(0), o[0]), C0, 0); \
    GAPB(o[1] = dev_mfma32(PAF(0), VFR(4), o[1]), C0, 4); \
    KRD(GL, 0); GAPB(o[0] = dev_mfma32(PAF(1), VFR(1), o[0]), C0, 8); \
    KRD(GL, 1); GAPB(o[1] = dev_mfma32(PAF(1), VFR(5), o[1]), C0, 12); \
    KRD(GL, 2); GAPB(o[0] = dev_mfma32(PAF(2), VFR(2), o[0]), C1, 0); \
    KRD(GL, 3); GAPB(o[1] = dev_mfma32(PAF(2), VFR(6), o[1]), C1, 4); \
    if constexpr (NDS == 6) { KRD(GL, 4); } GAPB(o[0] = dev_mfma32(PAF(3), VFR(3), o[0]), C1, 8); \
    if constexpr (NDS == 6) { KRD(GL, 5); } GAPB(o[1] = dev_mfma32(PAF(3), VFR(7), o[1]), C1, 12); \
  } while (0)
  int t = 1;
  for (; t + 5 < NT; t += 2) {
    STEP(pB0, pB1, pA0, pA1, t, true, true, true);     a2_waitbar<KN + 1>(); RESC(); ROT();
    STEP(pA0, pA1, pB0, pB1, t + 1, true, true, true); a2_waitbar<KN + 1>(); RESC(); ROT();
  }
#define ENDW(tt) do { if ((tt) + 3 < NT) { a2_waitbar<KN + 1>(); } else if ((tt) + 2 < NT) { a2_waitbar<1>(); } else { a2_waitbar<0>(); } } while (0)
  for (; t + 1 < NT; t += 2) {
    STEP(pB0, pB1, pA0, pA1, t, (t + 3 < NT), (t + 1 < NT), (t + 1 < NT));         ENDW(t);     RESC(); ROT();
    STEP(pA0, pA1, pB0, pB1, t + 1, (t + 4 < NT), (t + 2 < NT), (t + 2 < NT));     ENDW(t + 1); RESC(); ROT();
  }
  STEP(pB0, pB1, pA0, pA1, NT - 1, false, false, false); RESC();
  { float sacc = pB0[0] + pB0[1];
#pragma unroll
    for (int r = 2; r < 16; ++r) sacc += pB0[r];
#pragma unroll
    for (int r = 0; r < 16; ++r) sacc += pB1[r];
    l_reg += sacc;
    pw0 = (u32x4){PKW(pB0, 0), PKW(pB0, 2), PKW(pB0, 4), PKW(pB0, 6)}; pw1 = (u32x4){PKW(pB0, 8), PKW(pB0, 10), PKW(pB0, 12), PKW(pB0, 14)};
    pw2 = (u32x4){PKW(pB1, 0), PKW(pB1, 2), PKW(pB1, 4), PKW(pB1, 6)}; pw3 = (u32x4){PKW(pB1, 8), PKW(pB1, 10), PKW(pB1, 12), PKW(pB1, 14)};
    const a2_lptr vp_ = vp0 + sl_cur;
#pragma unroll
    for (int i = 0; i < 8; ++i) VRD(i);
    o[0] = dev_mfma32(PAF(0), VFR(0), o[0]); o[1] = dev_mfma32(PAF(0), VFR(4), o[1]); o[0] = dev_mfma32(PAF(1), VFR(1), o[0]); o[1] = dev_mfma32(PAF(1), VFR(5), o[1]);
    o[0] = dev_mfma32(PAF(2), VFR(2), o[0]); o[1] = dev_mfma32(PAF(2), VFR(6), o[1]); o[0] = dev_mfma32(PAF(3), VFR(3), o[0]); o[1] = dev_mfma32(PAF(3), VFR(7), o[1]); }
  l_reg = a2_swapsum(l_reg);
  if (hi == 0) { wsf[32 + r32] = l_reg; if (HALF) { stats[2 * r32] = mhat; stats[2 * r32 + 1] = l_reg; } }
  dev_wave_fence();
  float rli[16];
#pragma unroll
  for (int r = 0; r < 16; ++r) rli[r] = a2_rcp(wsf[32 + crow(r, hi)]);
  { bf16_t* stg = (bf16_t*)(smem + L::OST) + wid * 2048;
#pragma unroll
    for (int r = 0; r < 16; ++r) { const int orow = crow(r, hi);
#pragma unroll
      for (int d0 = 0; d0 < 2; ++d0) stg[orow * 64 + d0 * 32 + r32] = (bf16_t)f2bf_hw(o[d0][r] * rli[r]); }
    dev_wave_fence();
#pragma unroll
    for (int i = 0; i < 4; ++i) { const int row = i * 8 + (lane >> 3), ch = lane & 7; *(u32x4*)(optr + (size_t)row * opitch + ch * 8) = *(const u32x4*)(stg + row * 64 + ch * 8); } }
  dev_bar();
#undef DMA_K
#undef DMA_V
#undef RESC
#undef ROT
#undef KLD2
#undef PKW
#undef PAF
#undef VFR
#undef MX3
#undef GAPA
#undef GAPB
#undef VRD
#undef KRD
#undef STEP
#undef ENDW
}

constexpr int SC_CH = 16, SC_RING = 4, SC_CHB = SC_CH * 1536, SC_YB = SC_RING * SC_CHB;
static_assert(NK % SC_CH == 0 && NK / SC_CH >= 4 && SC_YB + 2 * SC_CH * 32 * 4 <= 131072 - 256 && ATT_LDS <= 131072 - 256, "scan LDS map");
DI int scan_kpos(int s, int d) { return s < C ? T + (d == 0 ? s : C - 1 - s) : (d == 0 ? s - C : T - 1 - (s - C)); }
constexpr int CK = 32, NCHK = NK / CK, U_PREP = 2 * NB * 4 * NCHK;
constexpr int SB_AS = 0, SB_AY = 8192, SB_GS = 12288, SB_GY = 16384, SB_VT = 18432, SB_BYTES = CK * 768;
static_assert(NK % CK == 0 && C % CK == 0 && SB_VT + 4096 <= SB_BYTES, "chunking");
constexpr int PW_REC = 896  , PW_RAW = 0, PW_KC = CK * PW_REC, PW_RT = PW_KC + 4608, PW_BT = PW_RT + 4608, PW_KT = PW_BT + 4608, PW_BHT = PW_KT + 4608, PW_KHT = PW_BHT + 5120, PW_VT = PW_KHT + 5120, PW_GC = PW_VT + 4096,
              PW_KCT = PW_GC + 256, PW_J = PW_KCT + 5120  , PW_TT = PW_J + 4 * 2560  ,
              PW_WT = PW_TT + 2560  , PW_MKJ = PW_WT + 2560  , PW_NBT = PW_MKJ + 2560, PW_X16 = PW_NBT + 2560, PW_WT8 = PW_X16 + 7680  , PW_END = PW_WT8 + 2048;
static_assert(PW_END <= 131072 - 256, "prep LDS map");
DI int chunk_kmin(int c, int d) { const int k0 = scan_kpos(c * CK, d), k1 = scan_kpos(c * CK + CK - 1, d); return k0 < k1 ? k0 : k1; }
DI bf16x8 pack8(const f32x16& x, int s) { u32x4 w;
#pragma unroll
  for (int j = 0; j < 4; ++j) w[j] = pk2(x[8 * s + 2 * j], x[8 * s + 2 * j + 1]);
  return __builtin_bit_cast(bf16x8, w); }
DI bf16x8 pack8lo(const f32x16& x, int s) { u32x4 w;
#pragma unroll
  for (int j = 0; j < 4; ++j) { const float a = x[8 * s + 2 * j], b = x[8 * s + 2 * j + 1]; w[j] = pk2(a - bf2f(f2bf_hw(a)), b - bf2f(f2bf_hw(b))); }
  return __builtin_bit_cast(bf16x8, w); }
DI bf16x8 ld2x8(const bf16_t* p0, const bf16_t* p1) { const u32x2 a = *(const u32x2*)p0, b = *(const u32x2*)p1; return __builtin_bit_cast(bf16x8, (u32x4){a.x, a.y, b.x, b.y}); }

struct PrepDesc { int sin[4], pofs[4]; };
constexpr int PREP_NP = CK * (PW_REC / 16);
static_assert(PREP_NP == 4 * 448, "prep DMA pieces");
DI void prep_desc(int tid, PrepDesc& ds) {
#pragma unroll
  for (int i = 0; i < 4; ++i) { const int idx = i * 448 + (tid - 64), sin = idx / 56, piece = idx % 56; ds.sin[i] = sin; ds.pofs[i] = piece < 24 ? piece * 16 : (piece - 24) * 16 + (1 << 30); }
}
DI void prep_issue(const Params& p, int unit, int tid, const PrepDesc& ds, char* smem) {
  const int wave = tid >> 6; if (wave == 0) return;
  const int chain = dev_uniform(unit / NCHK), c = dev_uniform(unit % NCHK); const int d = chain / (NB * 4), b = (chain / 4) % NB, hd = chain % 4;
  const char* scs = (const char*)(wsp<bf16_t>(p, A_SCS) + (size_t)(b * 4 + hd) * NK * 192); const char* scd = (const char*)(wsp<float>(p, A_SCD) + (size_t)((d * NB + b) * 4 + hd) * NK * 192);
  const long k0 = (long)scan_kpos(c * CK, d); const int sgn = d == 0 ? 1 : -1;
#pragma unroll
  for (int i = 0; i < 4; ++i) { const bool isd = ((ds.pofs[i] >> 30) & 1) != 0; const long rec = k0 + sgn * ds.sin[i]; const char* src = (isd ? scd + rec * 768 : scs + rec * 384) + (ds.pofs[i] & 0xffff);
    dev_glds16(src, smem + PW_RAW + (i * 448 + (wave - 1) * 64) * 16); }
}
DI void prep_chunk(const Params& p, int l, int unit, int next_unit, bool first, const PrepDesc& ds, char* smem) {
  const int tid = TID, lane = tid & 63, wave = tid >> 6, r = lane & 31, h = lane >> 5; const int chain = unit / NCHK, c = unit % NCHK; const int d = chain / (NB * 4), b = (chain / 4) % NB, hd = chain % 4;
  float* scd = wsp<float>(p, A_SCD) + (size_t)((d * NB + b) * 4 + hd) * NK * 192;
  { const int wu = dev_uniform(wave); if (first) dev_vmwait<0>(); else if (wu == 3) dev_vmwait<5>(); else if (wu < 3) dev_vmwait<3>(); else dev_vmwait<2>(); }
  dev_bar();
  const char* raw = smem + PW_RAW;
  for (int rep_b = 0; rep_b < (PROBE_REP == 30 ? 2 : 1); ++rep_b)
  { const int k = tid & 63, t0 = dev_uniform(4 * (tid >> 6)); float Pm0, Pt[4]; const float rkk = p.in(I_RK)[l * 256 + hd * 64 + k];
    const float* lw = (const float*)(raw + 384 + k * 4);
    float l4[4];
#pragma unroll
    for (int q = 0; q < 4; ++q) l4[q] = lw[(t0 + q) * (PW_REC / 4)];
    float* wt = (float*)(smem + PW_WT8);
    wt[wave * 64 + k] = (l4[0] + l4[1]) + (l4[2] + l4[3]);
    dev_bar();
    float base = 0.f, P = 0.f;
#pragma unroll
    for (int w = 0; w < 8; ++w) { const float x = wt[w * 64 + k]; P += x; base += (w < wave) ? x : 0.f; }
    Pm0 = base; Pt[0] = base + l4[0]; Pt[1] = Pt[0] + l4[1]; Pt[2] = Pt[1] + l4[2]; Pt[3] = Pt[2] + l4[3];
    const float gc = dev_exp2(P); float em = dev_exp2(Pm0);
    float bh4[4], kh4[4], vv4[4], kc4[4];
#pragma unroll
    for (int q = 0; q < 4; ++q) { const int t = t0 + q; const bf16_t* rec = (const bf16_t*)(raw + t * PW_REC) + k;
      const float rr = bf2f(rec[0]), vv = bf2f(rec[64]), kk = bf2f(rec[128]), bb = bf2f(rec[320]), kd = bf2f(rec[384]);
      const float et = dev_exp2(Pt[q]), ei = dev_exp2(-Pt[q]), ec = gc * ei;
      ((bf16_t*)(smem + PW_KC))[t * 72 + k] = (bf16_t)f2bf_hw(kk * em); ((bf16_t*)(smem + PW_RT))[t * 72 + k] = (bf16_t)f2bf_hw(rr * et);
      ((bf16_t*)(smem + PW_BT))[t * 72 + k] = (bf16_t)f2bf_hw(bb * ei); ((bf16_t*)(smem + PW_KT))[t * 72 + k] = (bf16_t)f2bf_hw(kd * ei);
      bh4[q] = bb * ec; kh4[q] = kd * ec; vv4[q] = vv; kc4[q] = kk * em;
      const float rho = wave_sum(rr * kd * rkk);
      if (lane == 0) wsp<float>(p, A_RHO)[((size_t)d * MT + kpos_row(b, scan_kpos(c * CK + t, d))) * 4 + hd] = rho;
      em = et; }
    { u32x2 w; w.x = pk2(bh4[0], bh4[1]); w.y = pk2(bh4[2], bh4[3]); *(u32x2*)((bf16_t*)(smem + PW_BHT) + k * 40 + t0) = w;
      w.x = pk2(kh4[0], kh4[1]); w.y = pk2(kh4[2], kh4[3]); *(u32x2*)((bf16_t*)(smem + PW_KHT) + k * 40 + t0) = w;
      w.x = pk2(vv4[0], vv4[1]); w.y = pk2(vv4[2], vv4[3]); *(u32x2*)((bf16_t*)(smem + PW_VT) + k * 32 + t0) = w;
      w.x = pk2(kc4[0], kc4[1]); w.y = pk2(kc4[2], kc4[3]); *(u32x2*)((bf16_t*)(smem + PW_KCT) + k * 40 + t0) = w; }
    if (t0 == 0) ((float*)(smem + PW_GC))[k] = gc; }
  dev_bar();
  if (next_unit < U_PREP) prep_issue(p, next_unit, tid, ds, smem);
  f32x16 nk = zero16();
  auto mm64 = [&](const bf16_t* X, const bf16_t* Y) { f32x16 acc = zero16();
#pragma unroll
    for (int s = 0; s < 4; ++s) acc = dev_mfma32(*(const bf16x8*)(X + r * 72 + 16 * s + 8 * h), *(const bf16x8*)(Y + r * 72 + 16 * s + 8 * h), acc);
    return acc; };
  auto wr_rows = [&](int off, const f32x16& a) { bf16_t* dst = (bf16_t*)(smem + off) + r * 40;
#pragma unroll
    for (int g = 0; g < 4; ++g) { u32x2 w; w.x = pk2(a[4 * g], a[4 * g + 1]); w.y = pk2(a[4 * g + 2], a[4 * g + 3]); *(u32x2*)(dst + 8 * g + 4 * h) = w; } };
  auto aform = [&](int off, int s) { const bf16_t* q = (const bf16_t*)(smem + off) + r * 40 + 16 * s + 4 * h; return ld2x8(q, q + 8); };
  const bf16_t *KC = (const bf16_t*)(smem + PW_KC), *RT = (const bf16_t*)(smem + PW_RT), *BT = (const bf16_t*)(smem + PW_BT), *KT = (const bf16_t*)(smem + PW_KT);
  if (wave == 0) {
    f32x16 M = mm64(BT, KC), MT = mm64(KC, BT);
#pragma unroll
    for (int i = 0; i < 16; ++i) { M[i] = crow(i, h) < r ? M[i] : 0.f; MT[i] = crow(i, h) > r ? MT[i] : 0.f; }
    wr_rows(PW_J, MT);
    wr_rows(PW_TT, M);
    f32x16 Pk = M, PkT = MT, R;
#pragma unroll
    for (int i = 0; i < 16; ++i) R[i] = (crow(i, h) == r ? 1.f : 0.f) - M[i];
#pragma unroll
    for (int lev = 1; lev < 5; ++lev) { dev_wave_fence();
      f32x16 N = zero16(), NT = zero16(), Q = zero16();
#pragma unroll
      for (int s = 0; s < 2; ++s) { N = dev_mfma32(aform(PW_J + (lev - 1) * 2560, s), pack8(Pk, s), N); NT = dev_mfma32(aform(PW_TT, s), pack8(PkT, s), NT);
        if (lev > 1) Q = dev_mfma32(aform(PW_J + (lev - 1) * 2560, s), pack8(R, s), Q); }
      if (lev > 1) {
#pragma unroll
        for (int i = 0; i < 16; ++i) R[i] += Q[i]; }
      Pk = N; PkT = NT; dev_wave_fence();
      wr_rows(PW_J + (lev & 3) * 2560, PkT); if (lev < 4) wr_rows(PW_TT, Pk); }
    { dev_wave_fence(); f32x16 Q = zero16();
#pragma unroll
      for (int s = 0; s < 2; ++s) Q = dev_mfma32(aform(PW_J, s), pack8(R, s), Q);
#pragma unroll
      for (int i = 0; i < 16; ++i) R[i] += Q[i]; }
    wr_rows(PW_WT, R);
  } else if (wave == 1) { f32x16 MkT = mm64(KC, KT);
#pragma unroll
    for (int i = 0; i < 16; ++i) MkT[i] = crow(i, h) > r ? MkT[i] : 0.f;
    wr_rows(PW_MKJ, MkT);
  } else if (wave == 2) { f32x16 Nb = mm64(BT, RT);
#pragma unroll
    for (int i = 0; i < 16; ++i) Nb[i] = crow(i, h) <= r ? Nb[i] : 0.f;
    wr_rows(PW_NBT, Nb);
  } else if (wave == 3) { nk = mm64(KT, RT);
#pragma unroll
    for (int i = 0; i < 16; ++i) nk[i] = crow(i, h) <= r ? nk[i] : 0.f; }
  dev_bar();
  if (wave < 3) { f32x16 Q = zero16(); const bf16_t* WT = (const bf16_t*)(smem + PW_WT) + r * 40; const bf16_t* Bsrc = wave < 2 ? (const bf16_t*)(smem + PW_KCT) + (32 * wave + r) * 40 : (const bf16_t*)(smem + PW_MKJ) + r * 40;
#pragma unroll
    for (int s = 0; s < 2; ++s) Q = dev_mfma32(*(const bf16x8*)(WT + 16 * s + 8 * h), *(const bf16x8*)(Bsrc + 16 * s + 8 * h), Q);
    wr_rows(PW_X16 + (wave < 2 ? 32 * wave : 64) * 80, Q); }
  dev_bar();
  { char* dst = (char*)(scd + (size_t)chunk_kmin(c, d) * 192); const bf16_t* X16 = (const bf16_t*)(smem + PW_X16); const bf16_t* BHT = (const bf16_t*)(smem + PW_BHT); const bf16_t* NBT = (const bf16_t*)(smem + PW_NBT);
    if (wave < 4) { const int sb = wave & 1, kb = wave >> 1;
      f32x16 z = zero16();
#pragma unroll
      for (int s = 0; s < 2; ++s) z = dev_mfma32(*(const bf16x8*)(X16 + (32 * sb + r) * 40 + 16 * s + 8 * h), *(const bf16x8*)(BHT + (32 * kb + r) * 40 + 16 * s + 8 * h), z);
      const float gc = ((const float*)(smem + PW_GC))[32 * kb + r];
#pragma unroll
      for (int i = 0; i < 16; ++i) z[i] = ((32 * sb + crow(i, h)) == (32 * kb + r) ? gc : 0.f) - z[i];
#pragma unroll
      for (int s = 0; s < 2; ++s) *(bf16x8*)(dst + SB_AS + (((kb * 2 + sb) * 2 + s) * 64 + lane) * 16) = pack8(z, s); }
    else if (wave < 6) { const int sb = wave - 4;
      f32x16 z = zero16();
#pragma unroll
      for (int s = 0; s < 2; ++s) z = dev_mfma32(*(const bf16x8*)(X16 + (32 * sb + r) * 40 + 16 * s + 8 * h), *(const bf16x8*)(NBT + r * 40 + 16 * s + 8 * h), z);
      const bf16_t* rt = (const bf16_t*)(smem + PW_RT) + r * 72 + 32 * sb;
#pragma unroll
      for (int g = 0; g < 4; ++g) { const f32x4 rv = ldp4(rt, 8 * g + 4 * h);
#pragma unroll
        for (int e = 0; e < 4; ++e) z[4 * g + e] = rv[e] - z[4 * g + e]; }
#pragma unroll
      for (int s = 0; s < 2; ++s) *(bf16x8*)(dst + SB_AY + ((sb * 2 + s) * 64 + lane) * 16) = pack8(z, s); }
    else { const int kb = wave - 6;
      f32x16 z = zero16();
#pragma unroll
      for (int s = 0; s < 2; ++s) z = dev_mfma32(*(const bf16x8*)(X16 + (64 + r) * 40 + 16 * s + 8 * h), *(const bf16x8*)(BHT + (32 * kb + r) * 40 + 16 * s + 8 * h), z);
      const bf16_t* kh = (const bf16_t*)(smem + PW_KHT) + (32 * kb + r) * 40;
#pragma unroll
      for (int g = 0; g < 4; ++g) { const f32x4 kv = ldp4(kh, 8 * g + 4 * h);
#pragma unroll
        for (int e = 0; e < 4; ++e) z[4 * g + e] = kv[e] - z[4 * g + e]; }
#pragma unroll
      for (int s = 0; s < 2; ++s) *(bf16x8*)(dst + SB_GS + ((kb * 2 + s) * 64 + lane) * 16) = pack8(z, s); }
    if (wave == 3) {
      f32x16 z = zero16();
#pragma unroll
      for (int s = 0; s < 2; ++s) z = dev_mfma32(*(const bf16x8*)(X16 + (64 + r) * 40 + 16 * s + 8 * h), *(const bf16x8*)(NBT + r * 40 + 16 * s + 8 * h), z);
#pragma unroll
      for (int i = 0; i < 16; ++i) z[i] = nk[i] - z[i];
#pragma unroll
      for (int s = 0; s < 2; ++s) *(bf16x8*)(dst + SB_GY + (s * 64 + lane) * 16) = pack8(z, s); }
    if (tid < 256) *(u32x4*)(dst + SB_VT + tid * 16) = *(const u32x4*)(smem + PW_VT + tid * 16); }
  dev_bar();
}
DI void phase_scan_prep(const Params& p, int l, char* smem) { const int G = (int)gridDim.x; int u = (int)blockIdx.x; if (u >= U_PREP) return; PrepDesc ds; prep_desc(TID, ds); prep_issue(p, u, TID, ds, smem);
  for (bool first = true; u < U_PREP; u += G, first = false) prep_chunk(p, l, u, u + G, first, ds, smem);
  dev_vmwait<0>(); dev_bar(); }

constexpr int SQ_RING = 4, SQ_YB = SQ_RING * SB_BYTES;
static_assert(SQ_YB + 2 * CK * 64 * 4 <= 131072 - 256, "scan LDS map");
DI void scan_chain(const Params& p, int chain, char* smem) {
  const int tid = TID, lane = tid & 63, wave = tid >> 6, r = lane & 31, h = lane >> 5; const int d = chain / (NB * 4), b = (chain / 4) % NB, hd = chain % 4;
  const char* scd = (const char*)(wsp<float>(p, A_SCD) + (size_t)((d * NB + b) * 4 + hd) * NK * 192);
  bf16_t* ys = wsp<bf16_t>(p, A_YS) + (size_t)d * MT * 256 + hd * 64; const int sgn = d == 0 ? 1 : -1;
  const int th = tid - 128;
  auto issue = [&](int c) { const char* src = scd + (size_t)dev_uniform(chunk_kmin(c, d)) * 768 + th * 16; char* dst = smem + (c % SQ_RING) * SB_BYTES + (wave - 2) * 1024;
#pragma unroll
    for (int i = 0; i < 4; ++i) dev_glds16(src + i * 6144, dst + i * 6144); };
  auto store_y = [&](int c) { const int m0 = dev_uniform(kpos_row(b, scan_kpos(c * CK, d)));
#pragma unroll
    for (int i = 0; i < 6; ++i) { const int e = (i * 384 + th) & (CK * 64 - 1), st = e >> 6, row = e & 63;
      ys[(size_t)(m0 + sgn * st) * 256 + row] = (bf16_t)f2bf_hw(((const float*)(smem + SQ_YB))[((c & 1) * CK + st) * 64 + row]); } };
  if (wave >= 2) { issue(0); issue(1); issue(2); }
  f32x16 T0 = zero16(), T1 = zero16();
  for (int c = 0; c < NCHK; ++c) {
    if (wave >= 2) { if (c + 2 < NCHK) dev_vmwait<8>(); else dev_vmwait<0>(); }
    dev_bar();
    if (wave < 2) { const int vb = wave; const char* blk = smem + (c % SQ_RING) * SB_BYTES; const bf16_t* vt = (const bf16_t*)(blk + SB_VT) + (32 * vb + r) * 32;
      f32x16 N0 = zero16(), N1 = zero16(), Yt = zero16();
#pragma unroll
      for (int s = 0; s < 2; ++s) { const bf16x8 vf = ld2x8(vt + 16 * s + 4 * h, vt + 16 * s + 8 + 4 * h);
        N0 = dev_mfma32(*(const bf16x8*)(blk + SB_GS + ((0 * 2 + s) * 64 + lane) * 16), vf, N0); N1 = dev_mfma32(*(const bf16x8*)(blk + SB_GS + ((1 * 2 + s) * 64 + lane) * 16), vf, N1);
        Yt = dev_mfma32(*(const bf16x8*)(blk + SB_GY + (s * 64 + lane) * 16), vf, Yt); }
#pragma unroll
      for (int sb = 0; sb < 2; ++sb)
#pragma unroll
        for (int s = 0; s < 2; ++s) { const bf16x8 bh = pack8(sb ? T1 : T0, s), bl = pack8lo(sb ? T1 : T0, s);
          const bf16x8 a0 = *(const bf16x8*)(blk + SB_AS + (((0 * 2 + sb) * 2 + s) * 64 + lane) * 16), a1 = *(const bf16x8*)(blk + SB_AS + (((1 * 2 + sb) * 2 + s) * 64 + lane) * 16), ay = *(const bf16x8*)(blk + SB_AY + ((sb * 2 + s) * 64 + lane) * 16);
          N0 = dev_mfma32(a0, bh, N0); N0 = dev_mfma32(a0, bl, N0); N1 = dev_mfma32(a1, bh, N1); N1 = dev_mfma32(a1, bl, N1); Yt = dev_mfma32(ay, bh, Yt); }
      T0 = N0; T1 = N1;
      float* yb = (float*)(smem + SQ_YB) + (c & 1) * CK * 64;
#pragma unroll
      for (int i = 0; i < 16; ++i) yb[crow(i, h) * 64 + 32 * vb + r] = Yt[i]; }
    if (wave >= 2) { if (c > 0) store_y(c - 1); if (c + 3 < NCHK) issue(c + 3); }
  }
  dev_bar();
  if (wave >= 2) store_y(NCHK - 1);
  dev_vmwait<0>();
  dev_bar();
}

constexpr int U_SCAN = 2 * NB * 4, U_MLA = NB * 4 * (T / 256), U_GQA = GQ_UNITS + GQ_SPLIT  , U_NAT = NB * 4 * (GROWS / 4);
constexpr int U_CGQA = NB * 2 * (C / 128), U_CMLA = NB * 4 * (C / 256), U_CNAT = NB * 4 * (C / 256);
DI void phase_mixer(const Params& p, int l, char* smem, int mode = 0, int qsel = 0) {
  const int tid = TID, wave = tid >> 6; int* qslot = (int*)(smem + 131072 - 256);
  const int total = U_SCAN + U_MLA + U_GQA + U_NAT + (l == 0 ? U_CGQA + U_CMLA + U_CNAT : 0);
  const bf16_t *QG = wsp<bf16_t>(p, A_QG), *KG = wsp<bf16_t>(p, A_KG), *QKVN = wsp<bf16_t>(p, A_QKVN), *KM = wsp<bf16_t>(p, A_KM), *QM = wsp<bf16_t>(p, A_QM), *VM = wsp<bf16_t>(p, A_VM); bf16_t* Y = wsp<bf16_t>(p, A_Y);
  const float SC64 = 0.125f * LOG2E, SC96 = 0.10206207261596575f * LOG2E;
  for (;;) {
    if (tid == 0) *qslot = (int)dev_atomic_add(wsp<unsigned>(p, WS_CTL) + CW_QUEUE + 64 * (l + 2 * qsel), 1u);
    __syncthreads();
    int u = *qslot;
    __syncthreads();
    if (u >= total) break;
    if (mode == 1 && u >= U_SCAN) continue;
    if (mode == 2 && u < U_SCAN) continue;
    if (u < U_SCAN) { scan_chain(p, u, smem); continue; } u -= U_SCAN;
    if (u < U_MLA) { const int qb = u % (T / 256), hd = (u / (T / 256)) % 4, b = u / (4 * (T / 256)); const int m0 = b * T + qb * 256 + wave * 32;
      attn2_unit<6, 8>(smem, QM + (size_t)m0 * 384 + hd * 96, 384, Y + (size_t)m0 * D + 512 + hd * 64, D, KM + hd * 96, 384, VM + hd * 64, 256, b); continue; } u -= U_MLA;
    if (u < U_GQA) { const int half = u >= GQ_UNITS - GQ_SPLIT ? (u - (GQ_UNITS - GQ_SPLIT)) & 1 : -1, su = (u - (GQ_UNITS - GQ_SPLIT)) >> 1; const int uu = half < 0 ? u : GQ_UNITS - GQ_SPLIT + su;
      const int qb = uu % (T / 128), g = (uu / (T / 128)) % 2, b = uu / (2 * (T / 128)); const int hd = 2 * g + (wave >> 2), m0 = b * T + qb * 128 + (wave & 3) * 32;
      if (half < 0) attn2_unit<4, 8>(smem, QG + (size_t)m0 * 256 + hd * 64, 256, Y + (size_t)m0 * D + 256 + hd * 64, D, KG + g * 64, 128, QKVN + 768 + g * 64, 896, b);
      else attn2_unit<4, 8, true>(smem, QG + (size_t)m0 * 256 + hd * 64, 256, wsp<bf16_t>(p, A_GPO) + (size_t)((su * 2 + half) * 8 + wave) * 2048, 64, KG + g * 64, 128, QKVN + 768 + g * 64, 896, b, half,
                            wsp<float>(p, A_GST) + (size_t)((su * 2 + half) * 8 + wave) * 64);
      continue; } u -= U_GQA;
    if (u < U_NAT) { const int rb = u % (GROWS / 4), hd = (u / (GROWS / 4)) % 4, b = u / (4 * (GROWS / 4)); const int qi = 4 * rb + (wave >> 1), c0 = 32 * (wave & 1), m0 = b * T + 64 * qi + c0;
      auto clampr = [](int i) { return i - 4 < 0 ? 0 : (i - 4 > GROWS - 8 ? GROWS - 8 : i - 4); };
      const int kr_lo = clampr(4 * rb), kr_hi = clampr(4 * rb + 3) + 7, nwin = kr_hi - kr_lo + 1;
      for (int e = tid; e < 15 * 31; e += 512) ((float*)(smem + ATT_BIAS))[e] = p.in(I_NATB)[((size_t)(l * 4 + hd) * 15) * 31 + e];
      __syncthreads();
      auto tf = [&](int i) { if (i < nwin) { const int m = b * T + 64 * (kr_lo + i); return TileSrc{QKVN + (size_t)m * 896 + 256 + hd * 64, QKVN + (size_t)m * 896 + 512 + hd * 64, kr_lo + i}; }
        const int m = TL + b * C + 64 * (i - nwin); return TileSrc{QKVN + (size_t)m * 896 + 256 + hd * 64, QKVN + (size_t)m * 896 + 512 + hd * 64, -1}; };
      attn_unit<64, true>(smem, QKVN + (size_t)m0 * 896 + hd * 64, 896, Y + (size_t)m0 * D + 768 + hd * 64, D, nwin + C / 64, tf, 896, 896, SC64, qi, c0); continue; } u -= U_NAT;
    if (u < U_CGQA) { const int qb = u % (C / 128), g = (u / (C / 128)) % 2, b = u / (2 * (C / 128)); const int hd = 2 * g + (wave >> 2), m0 = TL + b * C + qb * 128 + (wave & 3) * 32;
      auto tf = [&](int i) { const int m = TL + b * C + 64 * i; return TileSrc{KG + (size_t)m * 128 + g * 64, QKVN + (size_t)m * 896 + 768 + g * 64, -1}; };
      attn_unit<64, false>(smem, QG + (size_t)m0 * 256 + hd * 64, 256, Y + (size_t)m0 * D + 256 + hd * 64, D, C / 64, tf, 128, 896, 1.0f, 0, 0); continue; } u -= U_CGQA;
    if (u < U_CMLA) { const int qb = u % (C / 256), hd = (u / (C / 256)) % 4, b = u / (4 * (C / 256)); const int m0 = TL + b * C + qb * 256 + wave * 32;
      auto tf = [&](int i) { const int m = TL + b * C + 64 * i; return TileSrc{KM + (size_t)m * 384 + hd * 96, VM + (size_t)m * 256 + hd * 64, -1}; };
      attn_unit<96, false>(smem, QM + (size_t)m0 * 384 + hd * 96, 384, Y + (size_t)m0 * D + 512 + hd * 64, D, C / 64, tf, 384, 256, 1.0f, 0, 0); continue; } u -= U_CMLA;
    { const int qb = u % (C / 256), hd = (u / (C / 256)) % 4, b = u / (4 * (C / 256)); const int m0 = TL + b * C + qb * 256 + wave * 32;
      auto tf = [&](int i) { const int m = TL + b * C + 64 * i; return TileSrc{QKVN + (size_t)m * 896 + 256 + hd * 64, QKVN + (size_t)m * 896 + 512 + hd * 64, -1}; };
      attn_unit<64, false>(smem, QKVN + (size_t)m0 * 896 + hd * 64, 896, Y + (size_t)m0 * D + 768 + hd * 64, D, C / 64, tf, 896, 896, SC64, 0, 0); }
  }
}
#ifndef EMU
template <class F> struct EpiFn {
  static constexpr bool PERM = true, AFTER_DRAIN = false; F f;
  __device__ __forceinline__ void operator()(const pg8::f32x4 (&acc)[2][2][4][2], const pg8::Unit& u, int wr, int wc, int fr, int fq) const {
    int fr_ = fr, fq_ = fq; asm volatile("" : "+v"(fr_), "+v"(fq_));
    const int row0 = u.pm * 256 + wr * 64 + fr_, col0 = u.pc * 256 + wc * 32 + 8 * fq_;
#pragma unroll
    for (int ai = 0; ai < 2; ++ai)
#pragma unroll
      for (int m = 0; m < 4; ++m)
#pragma unroll
        for (int bj = 0; bj < 2; ++bj) { const pg8::f32x4 a = acc[ai][bj][m][0], b = acc[ai][bj][m][1]; const float v[8] = {a[0], a[1], a[2], a[3], b[0], b[1], b[2], b[3]};
          f.store8(u.pm * 256, row0 + ai * 128 + m * 16, col0 + bj * 128, v); __builtin_amdgcn_sched_barrier(0); }
  }
};
struct EpiLoraFn {
  static constexpr bool PERM = true, AFTER_DRAIN = false; EpiLora f;
  __device__ __forceinline__ void operator()(const pg8::f32x4 (&acc)[2][2][4][2], const pg8::Unit& u, int wr, int wc, int fr, int fq) const {
    int fr_ = fr, fq_ = fq; asm volatile("" : "+v"(fr_), "+v"(fq_));
    const int urow = u.pm * 256, row0 = urow + wr * 64 + fr_, cc0 = wc * 32 + 8 * fq_; const int blk = __builtin_amdgcn_readfirstlane(u.pc);
    const int b = row_batch(urow), kpos0 = row_kpos(urow) + (row0 - urow); const Params& p = *f.p; const int l = f.l;
#define LORA_V8(ai, m, bj) const pg8::f32x4 a_ = acc[ai][bj][m][0], b_ = acc[ai][bj][m][1]; const float v[8] = {a_[0], a_[1], a_[2], a_[3], b_[0], b_[1], b_[2], b_[3]}
    if (blk < 2) { f32x4 wv[2][2];
#pragma unroll
      for (int bj = 0; bj < 2; ++bj) { const float* w0 = p.in(I_W0) + (l * 2 + blk) * 256 + cc0 + bj * 128; wv[bj][0] = *(const f32x4*)w0; wv[bj][1] = *(const f32x4*)(w0 + 4); }
#pragma unroll
      for (int ai = 0; ai < 2; ++ai)
#pragma unroll
        for (int m = 0; m < 4; ++m)
#pragma unroll
          for (int bj = 0; bj < 2; ++bj) { LORA_V8(ai, m, bj); const int cc = cc0 + bj * 128; f32x4 oa, ob; lora_lw8(v, wv[bj][0], wv[bj][1], oa, ob);
            float* dst = f.lw_dst(blk, b, cc >> 6, kpos0 + ai * 128 + m * 16, cc & 63); *(f32x4*)dst = oa; *(f32x4*)(dst + 4) = ob; __builtin_amdgcn_sched_barrier(0); }
    } else if (blk < 4) { const int d = blk - 2; f32x4 a0v[2][2], kav[2][2];
#pragma unroll
      for (int bj = 0; bj < 2; ++bj) { const float* a0 = p.in(I_A0) + (l * 2 + d) * 256 + cc0 + bj * 128; const float* ka = p.in(I_KA) + l * 256 + cc0 + bj * 128;
        a0v[bj][0] = *(const f32x4*)a0; a0v[bj][1] = *(const f32x4*)(a0 + 4); kav[bj][0] = *(const f32x4*)ka; kav[bj][1] = *(const f32x4*)(ka + 4); }
#pragma unroll
      for (int ai = 0; ai < 2; ++ai)
#pragma unroll
        for (int mh = 0; mh < 2; ++mh) { LoraIn in[2][2];
#pragma unroll
          for (int mm = 0; mm < 2; ++mm)
#pragma unroll
            for (int bj = 0; bj < 2; ++bj) { const int cc = cc0 + bj * 128, ro = ai * 128 + (2 * mh + mm) * 16; f.bk_load(b, cc >> 6, kpos0 + ro, cc & 63, row0 + ro, cc, in[mm][bj]); }
          __builtin_amdgcn_sched_barrier(0);
#pragma unroll
          for (int mm = 0; mm < 2; ++mm)
#pragma unroll
            for (int bj = 0; bj < 2; ++bj) { const int m = 2 * mh + mm; LORA_V8(ai, m, bj); const int cc = cc0 + bj * 128, ro = ai * 128 + m * 16; u32x4 wb, wk; lora_bk8(v, a0v[bj], kav[bj], in[mm][bj], wb, wk);
              bf16_t* dst = f.bk_dst(d, b, cc >> 6, kpos0 + ro, cc & 63); *(u32x4*)dst = wb; *(u32x4*)(dst + 64) = wk; }
          __builtin_amdgcn_sched_barrier(0); }
    } else {
#pragma unroll
      for (int ai = 0; ai < 2; ++ai)
#pragma unroll
        for (int m = 0; m < 4; ++m)
#pragma unroll
          for (int bj = 0; bj < 2; ++bj) { const pg8::f32x4 a = acc[ai][bj][m][0], b2 = acc[ai][bj][m][1]; u32x4 w; w.x = pk2(a[0], a[1]); w.y = pk2(a[2], a[3]); w.z = pk2(b2[0], b2[1]); w.w = pk2(b2[2], b2[3]);
            *(u32x4*)(wsp<bf16_t>(p, A_RWG) + (size_t)(row0 + ai * 128 + m * 16) * 256 + cc0 + bj * 128) = w; __builtin_amdgcn_sched_barrier(0); }
    }
#undef LORA_V8
  }
};
struct InProjRoute { bf16_t* P; bf16_t* QKVN;
  __device__ __forceinline__ bool route(int cbase, bf16_t*& base, int& pitch) const { if (cbase >= 2720) return false;
    if (cbase >= 1952) { base = QKVN + (cbase - 1952); pitch = 896; } else if (cbase >= 1408 && cbase < 1536) { base = QKVN + 768 + (cbase - 1408); pitch = 896; } else { base = P + cbase; pitch = PW; } return true; } };
struct PlainRoute { bf16_t* O; int ld;
  __device__ __forceinline__ bool route(int cbase, bf16_t*& base, int& pitch) const { base = O + cbase; pitch = ld; return true; } };
template <class R> struct EpiRouteFn {
  static constexpr bool PERM = true, AFTER_DRAIN = false; R r;
  __device__ __forceinline__ void operator()(const pg8::f32x4 (&acc)[2][2][4][2], const pg8::Unit& u, int wr, int wc, int fr, int fq) const {
    int fr_ = fr, fq_ = fq; asm volatile("" : "+v"(fr_), "+v"(fq_));
    const int row0 = u.pm * 256 + wr * 64 + fr_;
#pragma unroll
    for (int bj = 0; bj < 2; ++bj) { const int cbase = __builtin_amdgcn_readfirstlane(u.pc * 256 + wc * 32 + bj * 128); bf16_t* base; int pitch; if (!r.route(cbase, base, pitch)) continue;
      char* lanep = (char*)(base + (size_t)row0 * pitch + 8 * fq_); const size_t rstep = (size_t)pitch * 32;
#pragma unroll
      for (int ai = 0; ai < 2; ++ai)
#pragma unroll
        for (int m = 0; m < 4; ++m) { const pg8::f32x4 a = acc[ai][bj][m][0], b = acc[ai][bj][m][1]; u32x4 w; w.x = pk2(a[0], a[1]); w.y = pk2(a[2], a[3]); w.z = pk2(b[0], b[1]); w.w = pk2(b[2], b[3]);
          *(u32x4*)(lanep + (size_t)(ai * 8 + m) * rstep) = w; __builtin_amdgcn_sched_barrier(0); } }
  }
};
struct EpiSwiGluFn {
  static constexpr bool PERM = true, AFTER_DRAIN = false; bf16_t* O; int ld;
  __device__ __forceinline__ void operator()(const pg8::f32x4 (&acc)[2][2][4][2], const pg8::Unit& u, int wr, int wc, int fr, int fq) const {
    int fr_ = fr, fq_ = fq; asm volatile("" : "+v"(fr_), "+v"(fq_));
    const int row0 = u.pm * 256 + wr * 64 + fr_; const size_t rstep = (size_t)ld * 32;
#pragma unroll
    for (int bj = 0; bj < 2; ++bj) { const int cbase = __builtin_amdgcn_readfirstlane(u.pc * 256 + wc * 32 + bj * 128); char* lanep = (char*)(O + (size_t)row0 * ld + (cbase >> 1) + 4 * fq_);
#pragma unroll
      for (int ai = 0; ai < 2; ++ai)
#pragma unroll
        for (int m = 0; m < 4; ++m) { const pg8::f32x4 a = acc[ai][bj][m][0], b = acc[ai][bj][m][1]; u32x2 w; w.x = pk2(siluf_(a[0]) * a[1], siluf_(a[2]) * a[3]); w.y = pk2(siluf_(b[0]) * b[1], siluf_(b[2]) * b[3]);
          *(u32x2*)(lanep + (size_t)(ai * 8 + m) * rstep) = w; __builtin_amdgcn_sched_barrier(0); } }
  }
};
struct LoraOrder : pg8::StaticOrder {
  __device__ __forceinline__ bool next(int i, pg8::Unit& u) const { if (!pg8::StaticOrder::next(i, u)) return false; u.ko = (u.pn == 4) ? 128 : 0; return true; }
};
struct SliceOrder {
  int nM, nN, nS, sliceK, G, c;
  __device__ __forceinline__ bool next(int i, pg8::Unit& u) const {
    const long L = (long)i * G + c; if (L >= (long)nM * nN * nS) return false;
    const int ks = (int)(L % nS), t = (int)(L / nS); u.pn = t % nN; u.pm = t / nN; u.pc = u.pn; u.ks = ks; u.ko = ks * sliceK; return true;
  }
  __device__ __forceinline__ void a_ready(const pg8::Unit&) const {}
  __device__ __forceinline__ void done(const pg8::Unit&) const {}
};
struct EpiSlab {
  static constexpr bool PERM = true, AFTER_DRAIN = false; float* O; int ld; size_t slab;
  __device__ __forceinline__ void operator()(const pg8::f32x4 (&acc)[2][2][4][2], const pg8::Unit& u, int wr, int wc, int fr, int fq) const {
    int fr_ = fr, fq_ = fq; asm volatile("" : "+v"(fr_), "+v"(fq_));
    const int row0 = u.pm * 256 + wr * 64 + fr_, col0 = u.pc * 256 + wc * 32 + 8 * fq_; float* base = O + (size_t)u.ks * slab;
#pragma unroll
    for (int ai = 0; ai < 2; ++ai)
#pragma unroll
      for (int m = 0; m < 4; ++m)
#pragma unroll
        for (int bj = 0; bj < 2; ++bj) { float* o = base + (size_t)(row0 + ai * 128 + m * 16) * ld + col0 + bj * 128; *(pg8::f32x4*)o = acc[ai][bj][m][0]; *(pg8::f32x4*)(o + 4) = acc[ai][bj][m][1]; __builtin_amdgcn_sched_barrier(0); }
  }
};
struct EpiSlabBf16 {
  static constexpr bool PERM = true, AFTER_DRAIN = false; bf16_t* O; int ld; size_t slab;
  __device__ __forceinline__ void operator()(const pg8::f32x4 (&acc)[2][2][4][2], const pg8::Unit& u, int wr, int wc, int fr, int fq) const {
    int fr_ = fr, fq_ = fq; asm volatile("" : "+v"(fr_), "+v"(fq_));
    const int row0 = u.pm * 256 + wr * 64 + fr_, col0 = u.pc * 256 + wc * 32 + 8 * fq_; bf16_t* base = O + (size_t)u.ks * slab;
#pragma unroll
    for (int ai = 0; ai < 2; ++ai)
#pragma unroll
      for (int m = 0; m < 4; ++m)
#pragma unroll
        for (int bj = 0; bj < 2; ++bj) { const pg8::f32x4 a = acc[ai][bj][m][0], b = acc[ai][bj][m][1]; u32x4 w; w.x = pk2(a[0], a[1]); w.y = pk2(a[2], a[3]); w.z = pk2(b[0], b[1]); w.w = pk2(b[2], b[3]);
          *(u32x4*)(base + (size_t)(row0 + ai * 128 + m * 16) * ld + col0 + bj * 128) = w; __builtin_amdgcn_sched_barrier(0); }
  }
};
struct GroupedOrder {
  int off[NE + 1]; int nN, G, c; int lim = 1 << 20;
  __device__ __forceinline__ bool next(int i, pg8::Unit& u) const {
    const long L = (long)i * G + c; int ntile = off[NE] >> 8; ntile = ntile < lim ? ntile : lim; if (L >= (long)ntile * nN) return false;
    const int pm = (int)(L / nN), pl = (int)(L % nN); int e = 0;
#pragma unroll
    for (int k = 1; k < NE; ++k) e += (pm * 256 >= off[k]) ? 1 : 0;
    u.pm = pm; u.pc = pl; u.pn = e * nN + pl; u.ko = 0; u.ks = 0; return true;
  }
  __device__ __forceinline__ void a_ready(const pg8::Unit&) const {}
  __device__ __forceinline__ void done(const pg8::Unit&) const {}
};

struct GroupedSliceOrder {
  int off[NE + 1]; int nN, G, c, t0, nS, sliceK;
  __device__ __forceinline__ bool next(int i, pg8::Unit& u) const {
    const int L = i * G + c; const int ntile = off[NE] >> 8; if (ntile <= t0 || L >= (ntile - t0) * nN * nS) return false;
    const int ks = L % nS, t = L / nS, pl = t % nN, pm = t0 + t / nN; int e = 0;
#pragma unroll
    for (int k = 1; k < NE; ++k) e += (pm * 256 >= off[k]) ? 1 : 0;
    u.pm = pm; u.pc = pl; u.pn = e * nN + pl; u.ks = ks; u.ko = ks * sliceK; return true;
  }
  __device__ __forceinline__ void a_ready(const pg8::Unit&) const {}
  __device__ __forceinline__ void done(const pg8::Unit&) const {}
};
#ifdef NO_GEMM
#define GEMM_PHASE(...) do {} while (0)
#else
#define GEMM_PHASE(...) pg8::gemm_phase<__VA_ARGS__>
#define GEMM_TWICE(...) do { __VA_ARGS__; if (PROBE_REP == 4) { __VA_ARGS__; } } while (0)
#define GEMM_TWICE_ID(id, ...) do { __VA_ARGS__; if (PROBE_REP == 4 || PROBE_REP == (id)) { __VA_ARGS__; } } while (0)
#endif
#ifdef NO_MIX
#define MIX_PHASE(...) do {} while (0)
#else
#define MIX_PHASE(...) phase_mixer(__VA_ARGS__)
#endif
#ifdef NO_ROW
#define ROW(x) do {} while (0)
#else
#define ROW(x) x
#endif
constexpr int LDS_BYTES = 147456, MISC_OFF = 131072 + 320;
#ifndef PROBE_REP
#define PROBE_REP 0
#endif
#ifndef MK_CUTS
#define MK_CUTS 0
#endif
constexpr int N_PHASES = 26;

#define IN(k) (lo <= (k) && (k) < hi)
#define SEAM(k) do { if (IN(k) && IN((k) + 1)) { xcd_barrier(bar); if (PROBE_REP == 8) xcd_barrier(bar); } } while (0)
template <int L> __device__ __forceinline__ void run_layer(const Params& p, char* smem, PG8_LAS unsigned char* glds, const XcdBarrier& bar, int lo, int hi, int G, int cb) {
  constexpr int l = L; constexpr int pb = 2 + 12 * l;
    if (IN(pb + 0)) { pg8::Gemm g{(const pg8::bf16_t*)(p.ws + A_XN), (const pg8::bf16_t*)(p.ws + WS_WIN) + (size_t)l * PW * D, MT, PW, D}; pg8::StaticOrder S; S.init(MT, PW, G, cb);
      EpiRouteFn<InProjRoute> E{{wsp<bf16_t>(p, A_P), wsp<bf16_t>(p, A_QKVN)}}; GEMM_TWICE_ID(10, GEMM_PHASE(EpiRouteFn<InProjRoute>, pg8::StaticOrder, true, true)(glds, g, S, E)); } SEAM(pb + 0);
    if (IN(pb + 1)) { ROW(phase_prep(p, l)); if (PROBE_REP == 7) phase_prep(p, l); } SEAM(pb + 1);
    if (IN(pb + 2)) {
      { pg8::Gemm g{(const pg8::bf16_t*)(p.ws + A_RWA), (const pg8::bf16_t*)(p.ws + WS_WLORA) + (size_t)l * 1280 * 256, MT, 1280, 128, 256}; LoraOrder S; S.init(MT, 1280, G, cb);
        EpiLoraFn E{{&p, l}}; GEMM_TWICE_ID(17, GEMM_PHASE(EpiLoraFn, LoraOrder, true, true)(glds, g, S, E)); }
      { pg8::Gemm g{(const pg8::bf16_t*)(p.ws + A_CQN), (const pg8::bf16_t*)(p.ws + WS_WUQ) + (size_t)l * 512 * 256, MT, 512, 256}; pg8::StaticOrder S; S.init(MT, 512, G, (cb + 168) % G);
        EpiFn<EpiMlaQ> E{{&p}}; GEMM_TWICE_ID(18, GEMM_PHASE(EpiFn<EpiMlaQ>, pg8::StaticOrder, true, true)(glds, g, S, E)); }
      { pg8::Gemm g{(const pg8::bf16_t*)(p.ws + A_CKVN), (const pg8::bf16_t*)(p.ws + WS_WUKV) + (size_t)l * 512 * 128, MT, 512, 128}; pg8::StaticOrder S; S.init(MT, 512, G, (cb + 32) % G);
        EpiFn<EpiMlaKV> E{{&p}}; GEMM_TWICE_ID(19, GEMM_PHASE(EpiFn<EpiMlaKV>, pg8::StaticOrder, true, true)(glds, g, S, E)); }
    } SEAM(pb + 2);
    if (IN(pb + 3)) { ROW(phase_scan_prep(p, l, smem)); } SEAM(pb + 3);
    if (IN(pb + 4)) { MIX_PHASE(p, l, smem);
      if (PROBE_REP >= 1 && PROBE_REP <= 3) { xcd_barrier(bar); phase_mixer(p, l, smem, PROBE_REP - 1, 1); } } SEAM(pb + 4);
    if (IN(pb + 5)) { ROW(phase_rwkv_out(p, l)); if (PROBE_REP == 7) phase_rwkv_out(p, l); } SEAM(pb + 5);
    if (IN(pb + 6)) {
      { pg8::Gemm g{(const pg8::bf16_t*)(p.ws + A_Y), (const pg8::bf16_t*)(p.ws + WS_WOUT) + (size_t)l * D * D, TL, D, D}; pg8::StaticOrder S; S.init(TL, D, G, cb);
        EpiRouteFn<PlainRoute> E{{wsp<bf16_t>(p, A_YO), D}}; GEMM_TWICE_ID(12, GEMM_PHASE(EpiRouteFn<PlainRoute>, pg8::StaticOrder, true, true)(glds, g, S, E)); }
      if constexpr (l == 0) { pg8::Gemm g{(const pg8::bf16_t*)(p.ws + A_Y) + (size_t)TL * D, (const pg8::bf16_t*)(p.ws + WS_WOUT) + (size_t)l * D * D, TC, D, 256, D}; SliceOrder S{TC / 256, D / 256, OS_NS, 256, G, (cb + 128) % G};
        EpiSlabBf16 E{wsp<bf16_t>(p, A_YOS), D, (size_t)TC * D}; GEMM_PHASE(EpiSlabBf16, SliceOrder, true, true)(glds, g, S, E); }
      if constexpr (l == 1) { ROW(moe_convert(p, smem)); if (PROBE_REP == 6) { __syncthreads(); moe_convert(p, smem); } } } SEAM(pb + 6);
    if (IN(pb + 7)) { ROW(phase_post_mixer(p, l, smem)); } SEAM(pb + 7);
    if constexpr (l == 0) {
      if (IN(pb + 8)) { pg8::Gemm g{(const pg8::bf16_t*)(p.ws + A_XN), (const pg8::bf16_t*)(p.ws + WS_WGU), MT, 2 * FF, D}; pg8::StaticOrder S; S.init(MT, 2 * FF, G, cb);
        EpiSwiGluFn E{wsp<bf16_t>(p, A_ACT), FF}; GEMM_TWICE_ID(13, GEMM_PHASE(EpiSwiGluFn, pg8::StaticOrder, true, true)(glds, g, S, E)); } SEAM(pb + 8);
      if (IN(pb + 9)) {
        { pg8::Gemm g{(const pg8::bf16_t*)(p.ws + A_ACT), (const pg8::bf16_t*)(p.ws + WS_WDN), TL, D, FF}; pg8::StaticOrder S; S.init(TL, D, G, cb);
          EpiRouteFn<PlainRoute> E{{wsp<bf16_t>(p, A_F), D}}; GEMM_TWICE_ID(14, GEMM_PHASE(EpiRouteFn<PlainRoute>, pg8::StaticOrder, true, true)(glds, g, S, E)); }
        { pg8::Gemm g{(const pg8::bf16_t*)(p.ws + A_ACT) + (size_t)TL * FF, (const pg8::bf16_t*)(p.ws + WS_WDN), TC, D, 256, FF}; SliceOrder S{TC / 256, D / 256, FS_NS, 256, G, (cb + 64) % G};
          EpiSlabBf16 E{wsp<bf16_t>(p, A_FS), D, (size_t)TC * D}; GEMM_PHASE(EpiSlabBf16, SliceOrder, true, true)(glds, g, S, E); } } SEAM(pb + 9);
      if (IN(pb + 10)) { ROW(phase_post_ffn0(p)); } SEAM(pb + 10);
    } else {
      if (IN(pb + 8)) { ROW(phase_moe_gather(p, l)); if (PROBE_REP == 21) phase_moe_gather(p, l); } SEAM(pb + 8);
      if (IN(pb + 9)) { GroupedOrder S; moe_offsets(p, S.off); S.nN = 2 * FF / 256; S.G = G; S.c = cb;
        pg8::Gemm g{(const pg8::bf16_t*)(p.ws + A_XG), (const pg8::bf16_t*)(p.ws + A_MWGU), XG_ROWS, NE * 2 * FF, D};
        EpiSwiGluFn E{wsp<bf16_t>(p, A_ACTG), FF}; GEMM_TWICE_ID(15, GEMM_PHASE(EpiSwiGluFn, GroupedOrder, true, true)(glds, g, S, E)); } SEAM(pb + 9);
      if (IN(pb + 10)) {
        { GroupedOrder S; moe_offsets(p, S.off); S.nN = D / 256; S.G = G; S.c = cb; S.lim = MOE_NFULL;
          pg8::Gemm g{(const pg8::bf16_t*)(p.ws + A_ACTG), (const pg8::bf16_t*)(p.ws + A_MWDN), XG_ROWS, NE * D, FF};
          EpiRouteFn<PlainRoute> E{{wsp<bf16_t>(p, A_XG), D}}; GEMM_TWICE_ID(16, GEMM_PHASE(EpiRouteFn<PlainRoute>, GroupedOrder, true, true)(glds, g, S, E)); }
        { GroupedSliceOrder S; moe_offsets(p, S.off); S.nN = D / 256; S.G = G; S.c = cb; S.t0 = MOE_NFULL; S.nS = MOE_NS; S.sliceK = MOE_SK;
          pg8::Gemm g{(const pg8::bf16_t*)(p.ws + A_ACTG), (const pg8::bf16_t*)(p.ws + A_MWDN), XG_ROWS, NE * D, MOE_SK, FF};
          EpiSlab E{wsp<float>(p, WS_MSLAB) - (size_t)MOE_NFULL * 256 * D, D, (size_t)MOE_TAILROWS * D}; GEMM_PHASE(EpiSlab, GroupedSliceOrder, true, true)(glds, g, S, E); }
      } SEAM(pb + 10);
      if (IN(pb + 11)) { ROW(phase_moe_combine(p, l)); }
    }

}
struct Args { const float* in[N_IN]; float* out; unsigned char* ws; int ph_lo, ph_hi; };
static_assert(sizeof(Args) == (N_IN + 2) * 8 + 8, "no padding holes in the argument struct");
constexpr int INTAB_OFF = 131072 + 1024;

__global__ void __launch_bounds__(512, 2) fwd_kernel(Args args) {
  extern __shared__ __attribute__((aligned(16))) unsigned char lds[];
  char* smem = (char*)lds;
  const int tid = threadIdx.x;
  Params p; p.in_ = (LAS cfptr_t*)((LAS unsigned char*)lds + INTAB_OFF); p.out = args.out; p.ws = args.ws;
  for (int u = tid; u < (LDS_BYTES - 131072) / 4; u += 512) ((LAS unsigned*)((LAS unsigned char*)lds + 131072))[u] = 0u;
  if (tid < N_IN) p.in_[tid] = args.in[tid];
  __syncthreads();
  unsigned* ctl = (unsigned*)(p.ws + WS_CTL);
  XcdBarrier bar; bar.bar = ctl + CW_BAR; bar.x = 0; bar.st = nullptr;
  const int lo = args.ph_lo, hi = args.ph_hi;
  if (hi - lo > 1) bar = xcd_barrier_post(ctl + CW_BAR, (volatile LAS unsigned*)((LAS unsigned char*)lds + MISC_OFF) + 8);
  const int G = gridDim.x, cb = blockIdx.x;
  PG8_LAS unsigned char* glds = (PG8_LAS unsigned char*)lds;

  if (IN(0)) { ROW(phase_prologue(p, smem)); if (PROBE_REP == 5) { __syncthreads(); phase_prologue(p, smem); } } SEAM(0);
  if (IN(1)) { ROW(phase_adaln0(p)); if (PROBE_REP == 20) phase_adaln0(p); } SEAM(1);
  run_layer<0>(p, smem, glds, bar, lo, hi, G, cb);
  run_layer<1>(p, smem, glds, bar, lo, hi, G, cb);
#undef IN
#undef SEAM
}

extern "C" void kernel_launch(void* const* d_in, const int* in_sizes, int n_in, void* d_out, int out_size, void* d_ws, size_t ws_size, hipStream_t stream) {
  static int grid = 0;
  if (grid == 0) {
    if (n_in != N_IN || in_sizes[I_X] != TL * D || out_size != TL * D || ws_size < WS_NEED) { fprintf(stderr, "kernel_launch: unexpected shapes / workspace (%zu needed, %zu given)\n", (size_t)WS_NEED, ws_size); grid = -1; return; }
    int dev = 0, cus = 0, per_cu = 0;
    if (hipGetDevice(&dev) != hipSuccess || hipDeviceGetAttribute(&cus, hipDeviceAttributeMultiprocessorCount, dev) != hipSuccess) { grid = -1; return; }
    if (hipFuncSetAttribute((const void*)fwd_kernel, hipFuncAttributeMaxDynamicSharedMemorySize, LDS_BYTES) != hipSuccess) { grid = -1; return; }
    if (hipOccupancyMaxActiveBlocksPerMultiprocessor(&per_cu, (const void*)fwd_kernel, 512, LDS_BYTES) != hipSuccess || per_cu < 1) { fprintf(stderr, "kernel_launch: occupancy query says %d\n", per_cu); }
    (void)hipGetLastError();
    grid = cus;
  }
  if (grid < 0) return;
  if (hipMemsetAsync((char*)d_ws + WS_CTL, 0, CTL_BYTES, stream) != hipSuccess) return;
  Args a{};
  for (int i = 0; i < N_IN; ++i) a.in[i] = (const float*)d_in[i];
  a.out = (float*)d_out; a.ws = (unsigned char*)d_ws;
#if MK_CUTS
  for (int ph = 0; ph < N_PHASES; ++ph) { if (ph == 13) continue; a.ph_lo = ph; a.ph_hi = ph + 1; hipLaunchKernelGGL(fwd_kernel, dim3(grid), dim3(512), LDS_BYTES, stream, a); }
#else
  a.ph_lo = 0; a.ph_hi = N_PHASES; hipLaunchKernelGGL(fwd_kernel, dim3(grid), dim3(512), LDS_BYTES, stream, a);
#endif
}
#endif
```

```cpp
#ifndef EMU
#include <hip/hip_runtime.h>
#include <cstdio>
#include <cstdint>
#endif

#ifndef CFG_B
#define CFG_B 4
#define CFG_T 4096
#define CFG_C 256
#endif
constexpr int NB = CFG_B, T = CFG_T, C = CFG_C, NK = T + C, D = 1024;
constexpr int TL = NB * T, TC = NB * C, MT = TL + TC;
constexpr int GW = 64, GROWS = T / GW;
constexpr int PW = 2816, FF = 2816, NE = 8;
constexpr int XG_ROWS = 2 * TL + NE * 256;
constexpr int XG_TILES = XG_ROWS / 256;
constexpr float RMS_EPS = 1e-6f, GN_EPS = 64e-5f, LOG2E = 1.4426950408889634f;
static_assert(T % 256 == 0 && C % 256 == 0 && GROWS >= 8, "shape assumptions");

enum { I_X = 0, I_C, I_CTX, I_CCTX, I_MODW, I_MODB, I_NORMG, I_WIN, I_WOUT, I_MU, I_W0, I_WUP, I_A0, I_AUP, I_GUP, I_KK, I_KA, I_RK, I_LNG, I_LNB,
       I_GQG, I_GKG, I_MQG, I_WUQ, I_MKVG, I_WUKV, I_NATB, I_FG, I_FU, I_FD, I_ROUTER, I_MG, I_MU2, I_MD, N_IN };

constexpr size_t al256(size_t x) { return (x + 255) & ~(size_t)255; }
constexpr size_t WS_CTL = 0, CTL_BYTES = 1u << 20;
constexpr size_t WS_MOD = WS_CTL + CTL_BYTES;
constexpr size_t WS_TABG = WS_MOD + al256((size_t)2 * (NB + 1) * 6144 * 4);
constexpr size_t WS_TABM = WS_TABG + al256((size_t)T * 64 * 4);
constexpr size_t WS_WIN = WS_TABM + al256((size_t)T * 32 * 4);
constexpr size_t WS_WOUT = WS_WIN + (size_t)2 * PW * D * 2;
constexpr size_t WS_WGU = WS_WOUT + (size_t)2 * D * D * 2;
constexpr size_t WS_WDN = WS_WGU + (size_t)2 * FF * D * 2;
constexpr size_t WS_WUQ = WS_WDN + (size_t)D * FF * 2;
constexpr size_t WS_WUKV = WS_WUQ + (size_t)2 * 512 * 256 * 2;
constexpr size_t WS_WLORA = WS_WUKV + (size_t)2 * 512 * 128 * 2;
constexpr size_t WS_XSC = WS_WLORA + (size_t)2 * 1280 * 256 * 2;
constexpr size_t WS_ROUTE = WS_XSC + (size_t)TC * D * 4;
constexpr size_t WS_ARENA = al256(WS_ROUTE + (size_t)TL * 24);
constexpr size_t A_XN = WS_ARENA;
constexpr size_t A_RWA = A_XN, A_CQN = A_RWA + (size_t)MT * 256 * 2, A_CKVN = A_CQN + (size_t)MT * 256 * 2;
constexpr size_t A_Y = A_XN;
constexpr size_t A_P = A_XN + (size_t)MT * D * 2;
constexpr size_t A_SCD = A_P;
constexpr size_t A_YO = A_P;
constexpr size_t SCD_BYTES = (size_t)2 * NB * 4 * NK * 192 * 4, P_BYTES = (size_t)MT * PW * 2;
constexpr size_t A_SCS = A_P + (SCD_BYTES > P_BYTES ? SCD_BYTES : P_BYTES);
constexpr size_t A_KSH = A_SCS + (size_t)NB * 4 * NK * 192 * 4;
constexpr size_t A_RHO = A_KSH;
constexpr size_t A_QG = A_KSH + (size_t)MT * 256 * 4;
constexpr size_t A_KG = A_QG + (size_t)MT * 256 * 2;
constexpr size_t A_QKVN = A_KG + (size_t)MT * 128 * 2;
constexpr size_t A_KM = A_QKVN + (size_t)MT * 896 * 2;
constexpr size_t A_QM = A_KM + (size_t)MT * 384 * 2;
constexpr size_t A_VM = A_QM + (size_t)MT * 384 * 2;
constexpr size_t A_RWG = A_VM + (size_t)MT * 256 * 2;
constexpr size_t A_YS = A_RWG + (size_t)MT * 256 * 4;
constexpr int GQ_UNITS = NB * 2 * (T / 128), GQ_SPLIT = GQ_UNITS / 4;
constexpr size_t A_GPO = A_YS + (size_t)2 * MT * 256 * 4;
constexpr size_t A_GST = A_GPO + (size_t)GQ_SPLIT * 2 * 8 * 32 * 64 * 2;
constexpr size_t A_MIX_END = A_GST + (size_t)GQ_SPLIT * 2 * 8 * 32 * 2 * 4;
constexpr int OS_NS = 4, FS_NS = 11;
constexpr size_t A_YOS = A_YO + (size_t)MT * D * 4;
constexpr size_t A_ACT = A_YO + (size_t)MT * D * 4;
constexpr size_t A_F = A_ACT + (size_t)MT * FF * 2;
constexpr size_t A_FS = A_F + (size_t)MT * D * 4;
constexpr size_t A_FFN_END = A_FS + (size_t)FS_NS * TC * D * 4;
static_assert(OS_NS * 256 == D && FS_NS * 256 == FF, "slices of 256");
constexpr size_t A_XG = WS_ARENA;
constexpr size_t A_ACTG = A_XG + (size_t)XG_ROWS * D * 2;
constexpr size_t A_MWGU = A_ACTG + (size_t)XG_ROWS * FF * 2;
constexpr size_t A_MWDN = A_MWGU + (size_t)NE * 2 * FF * D * 2;
constexpr size_t A_MOE_END = A_MWDN + (size_t)NE * D * FF * 2;
static_assert(A_MWGU >= A_YO + (size_t)MT * D * 4, "MoE weights are converted while Y (A_XN) and YO are live");
constexpr int MOE_NFULL = 2 * TL / 256, MOE_NS = 2, MOE_SK = FF / MOE_NS, MOE_TAILROWS = NE * 256;
constexpr size_t WS_MSLAB = WS_WGU;
static_assert((size_t)MOE_NS * MOE_TAILROWS * D * 4 <= (size_t)2 * FF * D * 2 + (size_t)D * FF * 2 && MOE_SK % 128 == 0 && (2 * TL) % 256 == 0, "MoE tail slabs");
constexpr size_t cmax(size_t a, size_t b) { return a > b ? a : b; }
constexpr size_t WS_NEED = cmax(cmax(A_MIX_END, A_FFN_END), A_MOE_END);

constexpr int CW_TMO = 0, CW_BAR = 4096, CW_QUEUE = 16384  , CW_CNT = 16384 + 1024  ;

typedef unsigned short bf16_t;
typedef short bf16x8 __attribute__((ext_vector_type(8)));
typedef short s16x4 __attribute__((ext_vector_type(4)));
typedef float f32x4 __attribute__((ext_vector_type(4)));
typedef float f32x16 __attribute__((ext_vector_type(16)));
typedef unsigned u32x4 __attribute__((ext_vector_type(4)));
typedef unsigned u32x2 __attribute__((ext_vector_type(2)));
#define DI __device__ __forceinline__

DI unsigned f2bf(float f) { unsigned u = __builtin_bit_cast(unsigned, f); return (u + 0x7fffu + ((u >> 16) & 1u)) >> 16; }
DI float bf2f(unsigned h) { return __builtin_bit_cast(float, h << 16); }
#ifdef EMU
DI unsigned pk2(float lo, float hi) { return f2bf(lo) | (f2bf(hi) << 16); }
#else
typedef float f32x2_t __attribute__((ext_vector_type(2))); typedef __bf16 bf16x2_t __attribute__((ext_vector_type(2)));
DI unsigned pk2(float lo, float hi) { const f32x2_t v = {lo, hi}; return __builtin_bit_cast(unsigned, __builtin_convertvector(v, bf16x2_t)); }
#endif
DI unsigned f2bf_hw(float f) { return pk2(f, 0.f) & 0xffffu; }
DI int crow(int r, int hi) { return (r & 3) + 8 * (r >> 2) + 4 * hi; }

#ifdef EMU
DI float dev_shfl_xor(float v, int m) { uint64_t d = __builtin_bit_cast(unsigned, v); emu_exchange_begin(&d, 1); int lane = (int)threadIdx.x & 63; float r = __builtin_bit_cast(float, (unsigned)emu_slot(lane ^ m)[0]); emu_exchange_end(); return r; }
DI f32x16 dev_mfma32(bf16x8 a, bf16x8 b, f32x16 c) {
  uint64_t d[4]; memcpy(d, &a, 16); memcpy(d + 2, &b, 16); emu_exchange_begin(d, 4);
  int lane = (int)threadIdx.x & 63, r = lane & 31, h = lane >> 5; f32x16 o;
  for (int i = 0; i < 16; ++i) { int row = crow(i, h); float s = c[i];
    for (int hh = 0; hh < 2; ++hh) { const short* A = (const short*)emu_slot(row + 32 * hh); const short* B = (const short*)(emu_slot(r + 32 * hh) + 2);
      for (int j = 0; j < 8; ++j) s += bf2f((unsigned short)A[j]) * bf2f((unsigned short)B[j]); }
    o[i] = s; }
  emu_exchange_end(); return o; }
DI s16x4 dev_tr16(const void* p) { uint64_t d = (uint64_t)p; emu_exchange_begin(&d, 1); int lane = (int)threadIdx.x & 63, G = lane >> 4, i16 = lane & 15; s16x4 o;
  for (int e = 0; e < 4; ++e) o[e] = ((const short*)emu_slot(16 * G + 4 * e + (i16 >> 2))[0])[i16 & 3];
  emu_exchange_end(); return o; }
DI void dev_wave_fence() { emu_wave_sync(); }
DI int dev_uniform(int x) { return x; }
DI float dev_max3(float a, float b, float c) { return fmaxf(fmaxf(a, b), c); }
DI void dev_mfma_settle(f32x16&, f32x16&) {}
DI bool dev_any(bool pr) { uint64_t d = pr ? 1 : 0; emu_exchange_begin(&d, 1); bool r = false; for (int i = 0; i < 64; ++i) r = r || (emu_slot(i)[0] != 0); emu_exchange_end(); return r; }
template <int CTRL> DI float dev_dpp(float v) { uint64_t d = __builtin_bit_cast(unsigned, v); emu_exchange_begin(&d, 1); int lane = (int)threadIdx.x & 63, src;
  if (CTRL == 0xB1) src = lane ^ 1; else if (CTRL == 0x4E) src = lane ^ 2; else if (CTRL == 0x141) src = (lane & ~7) | (7 - (lane & 7)); else src = (lane & ~15) | (15 - (lane & 15));
  float r = __builtin_bit_cast(float, (unsigned)emu_slot(src)[0]); emu_exchange_end(); return r; }
DI void dev_glds16(const void* g, char* lds_wave_base) { memcpy(lds_wave_base + ((int)threadIdx.x & 63) * 16, g, 16); }
template <int N> DI void dev_vmwait() {}
DI void dev_bar() { __syncthreads(); }
DI float dev_exp2(float x) { return exp2f(x); }
DI float dev_rsqrt(float x) { return 1.0f / sqrtf(x); }
DI float dev_rcp(float x) { return 1.0f / x; }
DI unsigned dev_atomic_add(unsigned* p, unsigned v) { return __atomic_fetch_add(p, v, __ATOMIC_RELAXED); }
DI unsigned dev_atomic_load(const unsigned* p) { return __atomic_load_n(p, __ATOMIC_RELAXED); }
DI int dev_lds_add(int* p, int v) { const int o = *p; *p = o + v; return o; }
#else
#define LAS __attribute__((address_space(3)))
#define GAS __attribute__((address_space(1)))
DI float dev_shfl_xor(float v, int m) { return __shfl_xor(v, m); }
DI f32x16 dev_mfma32(bf16x8 a, bf16x8 b, f32x16 c) { return __builtin_amdgcn_mfma_f32_32x32x16_bf16(a, b, c, 0, 0, 0); }
typedef short v4i16_t __attribute__((ext_vector_type(4)));
DI s16x4 dev_tr16(const void* p) { return __builtin_bit_cast(s16x4, __builtin_amdgcn_ds_read_tr16_b64_v4i16((LAS v4i16_t*)p)); }
DI void dev_wave_fence() { asm volatile("s_waitcnt lgkmcnt(0)" ::: "memory"); }
DI int dev_uniform(int x) { return __builtin_amdgcn_readfirstlane(x); }
DI void dev_mfma_settle(f32x16& a, f32x16& b) { asm volatile("s_nop 15\n\ts_nop 7" : "+v"(a), "+v"(b)); }
DI float dev_max3(float a, float b, float c) { float r; asm("v_max3_f32 %0, %1, %2, %3" : "=v"(r) : "v"(a), "v"(b), "v"(c)); return r; }
DI bool dev_any(bool pr) { return __any(pr) != 0; }
template <int CTRL> DI float dev_dpp(float v) { return __builtin_bit_cast(float, __builtin_amdgcn_update_dpp(0, __builtin_bit_cast(int, v), CTRL, 0xf, 0xf, true)); }
DI void dev_glds16(const void* g, char* lds_wave_base) {
  unsigned keep; const unsigned dst = (unsigned)__builtin_amdgcn_readfirstlane((int)(unsigned)(uintptr_t)lds_wave_base);
  asm volatile("s_mov_b32 %0, m0\n\ts_mov_b32 m0, %2\n\ts_nop 0\n\tglobal_load_lds_dwordx4 %1, off\n\ts_mov_b32 m0, %0" : "=&s"(keep) : "v"(g), "s"(dst) : "memory"); }
template <int N> DI void dev_vmwait() { asm volatile("s_waitcnt vmcnt(%0)" ::"n"(N) : "memory"); }
DI void dev_bar() { asm volatile("s_waitcnt lgkmcnt(0)" ::: "memory"); __builtin_amdgcn_s_barrier(); asm volatile("" ::: "memory"); }
DI float dev_exp2(float x) { return __builtin_amdgcn_exp2f(x); }
DI float dev_rsqrt(float x) { return __builtin_amdgcn_rsqf(x); }
DI float dev_rcp(float x) { return __builtin_amdgcn_rcpf(x); }
DI unsigned dev_atomic_add(unsigned* p, unsigned v) { return __hip_atomic_fetch_add(p, v, __ATOMIC_RELAXED, __HIP_MEMORY_SCOPE_AGENT); }
DI unsigned dev_atomic_load(const unsigned* p) { return __hip_atomic_load(p, __ATOMIC_RELAXED, __HIP_MEMORY_SCOPE_AGENT); }
DI int dev_lds_add(int* p, int v) { return __hip_atomic_fetch_add(p, v, __ATOMIC_RELAXED, __HIP_MEMORY_SCOPE_WORKGROUP); }
#endif

DI float sum16(float v) {
  v += dev_dpp<0xB1>(v); v += dev_dpp<0x4E>(v); v += dev_dpp<0x141>(v); v += dev_dpp<0x140>(v);
  return v;
}
#ifdef EMU
DI float dev_swapsum16(float v) { return v + dev_shfl_xor(v, 16); }
DI float dev_swapsum32(float v) { return v + dev_shfl_xor(v, 32); }
#else
DI float dev_swapsum16(float v) { auto rr = __builtin_amdgcn_permlane16_swap(__float_as_uint(v), __float_as_uint(v), false, false); return __uint_as_float(rr[0]) + __uint_as_float(rr[1]); }
DI float dev_swapsum32(float v) { auto rr = __builtin_amdgcn_permlane32_swap(__float_as_uint(v), __float_as_uint(v), false, false); return __uint_as_float(rr[0]) + __uint_as_float(rr[1]); }
#endif
DI float wave_sum(float v) { v = sum16(v); v = dev_swapsum16(v); v = dev_swapsum32(v); return v; }
DI float sum8(float v) {
  v += dev_dpp<0xB1>(v); v += dev_dpp<0x4E>(v); v += dev_dpp<0x141>(v);
  return v;
}
DI float sigmoidf_(float x) { return dev_rcp(1.0f + __expf(-x)); }
DI float siluf_(float x) { return x * dev_rcp(1.0f + __expf(-x)); }
DI float softplusf_(float x) { return x > 20.f ? x : log1pf(__expf(x)); }

typedef const float* cfptr_t;
#ifdef EMU
struct Params { cfptr_t in_[N_IN]; float* out; unsigned char* ws; DI cfptr_t in(int i) const { return in_[i]; } };
#else
struct Params { LAS cfptr_t* in_; float* out; unsigned char* ws;
  DI cfptr_t in(int i) const { const unsigned long long v = (unsigned long long)in_[i]; const unsigned lo = __builtin_amdgcn_readfirstlane((unsigned)v), hi = __builtin_amdgcn_readfirstlane((unsigned)(v >> 32));
    return (cfptr_t)(((unsigned long long)hi << 32) | lo); } };
#endif
template <class Tp> DI Tp* wsp(const Params& p, size_t off) { return (Tp*)(p.ws + off); }

DI int row_batch(int m) { return m < TL ? m / T : (m - TL) / C; }
DI int row_kpos(int m) { return m < TL ? m % T : T + (m - TL) % C; }
DI int kpos_row(int b, int kpos) { return kpos < T ? b * T + kpos : TL + b * C + (kpos - T); }
#ifndef EMU
namespace pg8 {
#define PG8_LAS __attribute__((address_space(3)))
typedef unsigned short bf16_t;
typedef short bf16x8 __attribute__((ext_vector_type(8)));
typedef float f32x4 __attribute__((ext_vector_type(4)));
typedef unsigned u32x4 __attribute__((ext_vector_type(4)));
constexpr int BM = 256, BK = 64, HALF = 128, HTB = HALF * BK * 2  , STAGE_BYTES = 8 * HTB, NXCD = 8, WGM = 8;

__host__ __device__ __forceinline__ int lds_byte(int r, int c) { const int st = (r >> 4) * 2 + (c >> 5), rr = r & 15, cc = c & 31, ob = rr * 64 + cc * 2; return st * 1024 + (ob ^ (((ob >> 9) & 1) << 5)); }
__host__ __device__ __forceinline__ void stage_rc(int b, int& R, int& C) { const int st = b / 1024, sb = b % 1024, swz = sb ^ (((sb >> 9) & 1) << 5); R = (st >> 1) * 16 + swz / 64; C = (st & 1) * 32 + (swz % 64) / 2; }
__host__ __device__ __forceinline__ int perm32(int rho) { const int n = rho >> 4, i = rho & 15; return 8 * (i >> 2) + 4 * n + (i & 3); }

struct Unit { int pm, pn, pc, ko, ks; };
struct Gemm { const bf16_t* A; const bf16_t* Bt; int M, N, K; int ld = 0; };

struct StaticOrder {
    int nM, nN, nwg, G, c;
    __host__ __device__ void init(int M, int N, int G_, int c_) { nM = M / BM; nN = N / BM; nwg = nM * nN; G = G_; c = c_; }
    __host__ __device__ bool next(int i, Unit& u) const {
        const long L = (long)i * G + c; if (L >= nwg) return false;
        int wgid = (int)L; { const int q = nwg / NXCD, r = nwg % NXCD, xcd = wgid % NXCD, off = wgid / NXCD; wgid = (xcd < r ? xcd * (q + 1) : r * (q + 1) + (xcd - r) * q) + off; }
        const int nig = WGM * nN, gid = wgid / nig, fm = gid * WGM, gsz = (nM - fm) < WGM ? (nM - fm) : WGM;
        u.pm = fm + ((wgid % nig) % gsz); u.pn = (wgid % nig) / gsz; u.pc = u.pn; u.ko = 0; u.ks = 0; return true;
    }
    __device__ __forceinline__ void a_ready(const Unit&) const {}
    __device__ __forceinline__ void done(const Unit&) const {}
};

template <class Epi, class Sched, bool ALIGN_EPI = false, bool SP2 = false>
__device__ __forceinline__ void gemm_phase(PG8_LAS unsigned char* lds, const Gemm g, const Sched& S, const Epi& E) {
    int tid_ = threadIdx.x; asm volatile("" : "+v"(tid_));
    const int tid = tid_, wid = __builtin_amdgcn_readfirstlane(tid >> 6), lane = tid & 63, wr = wid >> 2, wc = wid & 3, fr = lane & 15, fq = lane >> 4;
    const int K = g.K, nt = K / BK, LD = g.ld ? g.ld : g.K;
    unsigned voffA[2], voffB[2];
#pragma unroll
    for (int i = 0; i < 2; ++i) { int R, C; stage_rc(tid * 16 + i * 8192, R, C); const int Rb = Epi::PERM ? ((R & ~31) + perm32(R & 31)) : R;
        voffA[i] = (unsigned)(R * LD + C) * 2u; voffB[i] = (unsigned)(Rb * LD + C) * 2u; }
    const size_t kstep = (size_t)(BK * 2);
    const size_t hstep = (size_t)HALF * LD * 2;
    const size_t tstep = 2 * hstep;
    const unsigned ldsw = (unsigned)wid * 1024u;
    const int aoff = lds_byte(wr * 64 + fr, fq * 8), boff = lds_byte(wc * 32 + fr, fq * 8);
#define PG8_SA(b, h) (((b) * 2 + (h)) * HTB)
#define PG8_SB(b, h) ((4 + (b) * 2 + (h)) * HTB)
#define PG8_STAGE(bufoff, gbase, voff) do { _Pragma("unroll") for (int _i = 0; _i < 2; ++_i) \
        __builtin_amdgcn_global_load_lds((const unsigned*)((const char*)(gbase) + (voff)[_i]), (PG8_LAS unsigned*)(lds + (bufoff) + ldsw + _i * 8192), 16, 0, 0); } while (0)
#define PG8_LDA(dst, b, h) do { _Pragma("unroll") for (int m = 0; m < 4; ++m) _Pragma("unroll") for (int k = 0; k < 2; ++k) dst[m][k] = *(const PG8_LAS bf16x8*)(lds + PG8_SA(b, h) + aoff + m * 2048 + k * 1024); } while (0)
#define PG8_LDB(dst, b, h) do { _Pragma("unroll") for (int n = 0; n < 2; ++n) _Pragma("unroll") for (int k = 0; k < 2; ++k) dst[n][k] = *(const PG8_LAS bf16x8*)(lds + PG8_SB(b, h) + boff + n * 2048 + k * 1024); } while (0)
#define PG8_MMA(ai, bj, At, Bt) do { __builtin_amdgcn_s_setprio(1); _Pragma("unroll") for (int m = 0; m < 4; ++m) _Pragma("unroll") for (int n = 0; n < 2; ++n) _Pragma("unroll") for (int k = 0; k < 2; ++k) \
        acc[ai][bj][m][n] = __builtin_amdgcn_mfma_f32_16x16x32_bf16(Bt[n][k], At[m][k], acc[ai][bj][m][n], 0, 0, 0); __builtin_amdgcn_s_setprio(0); } while (0)
#define PG8_WAIT_V(n) asm volatile("s_waitcnt vmcnt(" #n ")" ::: "memory")
#define PG8_WAIT_L(n) asm volatile("s_waitcnt lgkmcnt(" #n ")" ::: "memory")
#define PG8_BAR __builtin_amdgcn_s_barrier()
#define PG8_SCHED __builtin_amdgcn_sched_barrier(0)
    Unit cur, nxt; int ui = 0;
    if (!S.next(0, cur)) return;
    f32x4 acc[2][2][4][2];
#pragma unroll
    for (int a = 0; a < 2; ++a)
#pragma unroll
        for (int b = 0; b < 2; ++b)
#pragma unroll
            for (int m = 0; m < 4; ++m)
#pragma unroll
                for (int n = 0; n < 2; ++n) acc[a][b][m][n] = (f32x4){0.f, 0.f, 0.f, 0.f};
    bf16x8 At[4][2], B0[2][2], B1[2][2];
    const char* cA = (const char*)g.A + (size_t)cur.pm * tstep + (size_t)cur.ko * 2; const char* cB = (const char*)g.Bt + (size_t)cur.pn * tstep + (size_t)cur.ko * 2;
    S.a_ready(cur);
    if constexpr (SP2) {
        PG8_STAGE(PG8_SB(0, 0), cB, voffB); PG8_STAGE(PG8_SB(0, 1), cB + hstep, voffB); PG8_STAGE(PG8_SA(0, 0), cA, voffA); PG8_STAGE(PG8_SA(0, 1), cA + hstep, voffA);
        if (wr == 1) PG8_BAR;
        PG8_WAIT_V(2); PG8_BAR;
        PG8_STAGE(PG8_SB(1, 0), cB + kstep, voffB); PG8_STAGE(PG8_SA(1, 0), cA + kstep, voffA); PG8_STAGE(PG8_SB(1, 1), cB + hstep + kstep, voffB);
        PG8_WAIT_V(6); PG8_BAR;
    } else {
        PG8_STAGE(PG8_SB(0, 0), cB, voffB); PG8_STAGE(PG8_SA(0, 0), cA, voffA); PG8_STAGE(PG8_SB(0, 1), cB + hstep, voffB); PG8_STAGE(PG8_SA(0, 1), cA + hstep, voffA);
        if (wr == 1) PG8_BAR;
        PG8_WAIT_V(4); PG8_BAR;
        PG8_STAGE(PG8_SB(1, 0), cB + kstep, voffB); PG8_STAGE(PG8_SA(1, 0), cA + kstep, voffA); PG8_STAGE(PG8_SB(1, 1), cB + hstep + kstep, voffB);
        PG8_WAIT_V(6); PG8_BAR;
    }
    for (;;) {
        const bool has_next = S.next(ui + 1, nxt);
        const char* nA = has_next ? (const char*)g.A + (size_t)nxt.pm * tstep + (size_t)nxt.ko * 2 : cA; const char* nB = has_next ? (const char*)g.Bt + (size_t)nxt.pn * tstep + (size_t)nxt.ko * 2 : cB;
        for (int t = 0; t < nt; t += 2) {
            const bool last = (t == nt - 2);
            const char* a1 = cA + (size_t)(t + 1) * kstep;
            const char* a2 = last ? nA : cA + (size_t)(t + 2) * kstep; const char* b2 = last ? nB : cB + (size_t)(t + 2) * kstep;
            const char* a3 = a2 + kstep; const char* b3 = b2 + kstep;
            if (last && has_next) S.a_ready(nxt);
            if constexpr (SP2) {
            PG8_LDB(B0, 0, 0); PG8_LDB(B1, 0, 1); PG8_SCHED; PG8_LDA(At, 0, 0); PG8_STAGE(PG8_SA(1, 1), a1 + hstep, voffA);
            PG8_WAIT_V(8); PG8_WAIT_L(0); PG8_BAR; PG8_MMA(0, 0, At, B0); PG8_MMA(0, 1, At, B1); PG8_BAR; PG8_SCHED;
            PG8_LDA(At, 0, 1); PG8_STAGE(PG8_SB(0, 0), b2, voffB); PG8_STAGE(PG8_SB(0, 1), b2 + hstep, voffB); PG8_STAGE(PG8_SA(0, 0), a2, voffA);
            PG8_WAIT_V(8); PG8_WAIT_L(0); PG8_BAR; PG8_MMA(1, 0, At, B0); PG8_MMA(1, 1, At, B1); PG8_BAR; PG8_SCHED;
            PG8_LDB(B0, 1, 0); PG8_LDB(B1, 1, 1); PG8_SCHED; PG8_LDA(At, 1, 0); PG8_STAGE(PG8_SA(0, 1), a2 + hstep, voffA);
            PG8_WAIT_V(8); PG8_WAIT_L(0); PG8_BAR; PG8_MMA(0, 0, At, B0); PG8_MMA(0, 1, At, B1); PG8_BAR; PG8_SCHED;
            PG8_LDA(At, 1, 1); PG8_STAGE(PG8_SB(1, 0), b3, voffB); PG8_STAGE(PG8_SB(1, 1), b3 + hstep, voffB); PG8_STAGE(PG8_SA(1, 0), a3, voffA);
            PG8_WAIT_V(8); PG8_WAIT_L(0); PG8_BAR; PG8_MMA(1, 0, At, B0); PG8_MMA(1, 1, At, B1); PG8_BAR; PG8_SCHED;
            } else {
            PG8_LDB(B0, 0, 0); PG8_SCHED; PG8_LDA(At, 0, 0); PG8_STAGE(PG8_SA(1, 1), a1 + hstep, voffA);
            PG8_WAIT_L(8); PG8_BAR; PG8_WAIT_L(0); PG8_MMA(0, 0, At, B0); PG8_BAR; PG8_SCHED;
            PG8_LDB(B1, 0, 1); PG8_STAGE(PG8_SB(0, 0), b2, voffB);
            PG8_BAR; PG8_WAIT_L(0); PG8_MMA(0, 1, At, B1); PG8_BAR;
            PG8_LDA(At, 0, 1); PG8_STAGE(PG8_SA(0, 0), a2, voffA);
            PG8_BAR; PG8_WAIT_L(0); PG8_MMA(1, 0, At, B0); PG8_BAR; PG8_SCHED;
            PG8_STAGE(PG8_SB(0, 1), b2 + hstep, voffB);
            PG8_WAIT_V(6); PG8_BAR; PG8_MMA(1, 1, At, B1); PG8_BAR;
            PG8_LDB(B0, 1, 0); PG8_SCHED; PG8_LDA(At, 1, 0); PG8_STAGE(PG8_SA(0, 1), a2 + hstep, voffA);
            PG8_WAIT_L(8); PG8_BAR; PG8_WAIT_L(0); PG8_MMA(0, 0, At, B0); PG8_BAR; PG8_SCHED;
            PG8_LDB(B1, 1, 1); PG8_STAGE(PG8_SB(1, 0), b3, voffB);
            PG8_BAR; PG8_WAIT_L(0); PG8_MMA(0, 1, At, B1); PG8_BAR;
            PG8_LDA(At, 1, 1); PG8_STAGE(PG8_SA(1, 0), a3, voffA);
            PG8_BAR; PG8_WAIT_L(0); PG8_MMA(1, 0, At, B0); PG8_BAR; PG8_SCHED;
            PG8_STAGE(PG8_SB(1, 1), b3 + hstep, voffB);
            PG8_WAIT_V(6); PG8_BAR; PG8_MMA(1, 1, At, B1); PG8_BAR;
            }
        }
        if constexpr (ALIGN_EPI) { if (wr == 0) PG8_BAR; }
        if constexpr (!Epi::AFTER_DRAIN) { E(acc, cur, wr, wc, fr, fq); S.done(cur); }
        if (!has_next) break;
#pragma unroll
        for (int a = 0; a < 2; ++a)
#pragma unroll
            for (int b = 0; b < 2; ++b)
#pragma unroll
                for (int m = 0; m < 4; ++m)
#pragma unroll
                    for (int n = 0; n < 2; ++n) acc[a][b][m][n] = (f32x4){0.f, 0.f, 0.f, 0.f};
        cur = nxt; cA = nA; cB = nB; ++ui;
        if constexpr (ALIGN_EPI) { if (wr == 1) PG8_BAR; }
    }
    PG8_WAIT_V(0);
    if constexpr (!ALIGN_EPI) { if (wr == 0) PG8_BAR; }
    PG8_BAR;
    if constexpr (Epi::AFTER_DRAIN) { E.fused(acc, cur, wr, wc, fr, fq, lds, wid, lane); S.done(cur); }
#undef PG8_SA
#undef PG8_SB
#undef PG8_STAGE
#undef PG8_LDA
#undef PG8_LDB
#undef PG8_MMA
#undef PG8_WAIT_V
#undef PG8_WAIT_L
#undef PG8_BAR
#undef PG8_SCHED
}
}
#define XB_TMO      128
#define XB_XCNT(j)  (256  + 64 * (j))
#define XB_XSUB(j)  (1280 + 64 * (j))
#define XB_XGEN(j)  (2304 + 64 * (j))
#define XB_TOP      3328
#define XB_TOPGEN   3392
#define XCD_BAR_WORDS 3456
#define XB_SPIN_CAP (1u << 18)

__device__ __forceinline__ unsigned xb_ld(unsigned* p)              { return __hip_atomic_load(p, __ATOMIC_RELAXED, __HIP_MEMORY_SCOPE_AGENT); }
__device__ __forceinline__ unsigned xb_add(unsigned* p, unsigned v) { return __hip_atomic_fetch_add(p, v, __ATOMIC_RELAXED, __HIP_MEMORY_SCOPE_AGENT); }
__device__ __forceinline__ unsigned xb_xcc_id() { return (unsigned)__builtin_amdgcn_s_getreg((3 << 11) | 20) & 0xFu; }
#define XB_SPIN(cond, bar) do { unsigned _sp = 0; while (cond) { __builtin_amdgcn_s_sleep(1); \
    if ((++_sp & 255u) == 0u) { if (xb_ld(&(bar)[XB_TMO])) break; if (_sp > XB_SPIN_CAP) { atomicAdd(&(bar)[XB_TMO], 1u); break; } } } } while (0)

struct XcdBarrier {
    unsigned* bar; unsigned x;
    volatile LAS unsigned* st;
};

__device__ __forceinline__ XcdBarrier xcd_barrier_post(unsigned* bar, volatile LAS unsigned* st) {
    XcdBarrier b; b.bar = bar; b.x = xb_xcc_id(); b.st = st;
    if (threadIdx.x == 0) (void)xb_add(&bar[XB_XCNT(b.x)], 1u);
    return b;
}
__device__ __forceinline__ void xcd_barrier_complete(unsigned* bar, unsigned x, unsigned& nloc, unsigned& nx) {
    const unsigned G = gridDim.x * gridDim.y * gridDim.z;
    unsigned sum, cnt, mine, sp = 0u;
    for (;;) {
        sum = 0u; cnt = 0u; mine = 0u;
#pragma unroll
        for (unsigned j = 0; j < 16; ++j) { const unsigned c = xb_ld(&bar[XB_XCNT(j)]); sum += c; cnt += (c > 0u) ? 1u : 0u; mine = (j == x) ? c : mine; }
        if (sum == G) break;
        __builtin_amdgcn_s_sleep(1);
        if ((++sp & 255u) == 0u) { if (xb_ld(&bar[XB_TMO])) break; if (sp > XB_SPIN_CAP) { atomicAdd(&bar[XB_TMO], 1u); break; } }
    }
    nloc = mine > 0u ? mine : 1u; nx = cnt > 0u ? cnt : 1u;
}

__device__ __forceinline__ void xcd_barrier(const XcdBarrier& b) {
    asm volatile("s_waitcnt vmcnt(0)" ::: "memory");
    __syncthreads();
    if (threadIdx.x == 0) {
        unsigned* bar = b.bar;
        __builtin_amdgcn_s_waitcnt(0);
        unsigned nloc = b.st[0], nx = b.st[1];
        if (nloc == 0u) { xcd_barrier_complete(bar, b.x, nloc, nx); b.st[0] = nloc; b.st[1] = nx; }
        const unsigned old = xb_add(&bar[XB_XSUB(b.x)], 1u);
        const unsigned gen = old / nloc;
        if (old + 1u == (gen + 1u) * nloc) {
            __builtin_amdgcn_fence(__ATOMIC_RELEASE, "agent");
            asm volatile("s_waitcnt vmcnt(0)" ::: "memory");
            const unsigned og = xb_add(&bar[XB_TOP], 1u);
            const unsigned tg = og / nx;
            if (og + 1u == (tg + 1u) * nx) xb_add(&bar[XB_TOPGEN], 1u);
            else XB_SPIN(xb_ld(&bar[XB_TOPGEN]) == tg, bar);
            __builtin_amdgcn_fence(__ATOMIC_ACQUIRE, "agent");
            xb_add(&bar[XB_XGEN(b.x)], 1u);
            asm volatile("s_waitcnt vmcnt(0)" ::: "memory");
        } else {
            XB_SPIN(xb_ld(&bar[XB_XGEN(b.x)]) == gen, bar);
            __builtin_amdgcn_fence(__ATOMIC_ACQUIRE, "agent");
            asm volatile("s_waitcnt vmcnt(0)" ::: "memory");
        }
    }
    __syncthreads();
}
#endif
#ifndef PROBE_REP
#define PROBE_REP 0
#endif
#define NWAVES 8
#ifdef EMU
#define TID ((int)threadIdx.x)
#else
DI int tid_fresh() { int t = threadIdx.x; asm volatile("" : "+v"(t)); return t; }
#define TID tid_fresh()
#endif
#define GWAVE dev_uniform((int)blockIdx.x * NWAVES + (TID >> 6))
#define NGWAVE ((int)gridDim.x * NWAVES)

struct TItem { const float* W; bf16_t* WT; int K, N, kind, k0, n0; };
DI int titem_row(const TItem& t, int n) { if (t.kind == 0) return n; if (t.kind == 1) return 2 * n; if (t.kind == 2) return 2 * n + 1;
  const int hd = n / 96, dd = n % 96; if (dd < 64) return n; const int i = dd - 64; return hd * 96 + 64 + (i < 16 ? 2 * i : 2 * (i - 16) + 1); }
DI void titem_set(TItem& t, const float* W, int K, int N, bf16_t* WT, int kind, int item) { t.W = W; t.WT = WT; t.K = K; t.N = N; t.kind = kind; const int nblk = N / 32; t.k0 = 64 * (item / nblk); t.n0 = 32 * (item % nblk); }
DI void titem_load(const TItem& t, int lane, float (&v)[32]) {
#pragma unroll
  for (int i = 0; i < 32; ++i) v[i] = t.W[(size_t)(t.k0 + 2 * i + (lane >> 5)) * t.N + t.n0 + (lane & 31)];
}
DI void titem_stage(float* scr, int lane, const float (&v)[32]) {
#pragma unroll
  for (int i = 0; i < 32; ++i) scr[(2 * i + (lane >> 5)) * 33 + (lane & 31)] = v[i];
  dev_wave_fence();
}
DI void titem_finish(const TItem& t, const float* scr, int lane) {
  const int c = lane & 7;
#pragma unroll
  for (int j = 0; j < 4; ++j) { const int n = (lane >> 3) + 8 * j; const float* s = scr + (8 * c) * 33 + n;
    u32x4 o; o.x = pk2(s[0 * 33], s[1 * 33]); o.y = pk2(s[2 * 33], s[3 * 33]); o.z = pk2(s[4 * 33], s[5 * 33]); o.w = pk2(s[6 * 33], s[7 * 33]);
    *(u32x4*)(t.WT + (size_t)titem_row(t, t.n0 + n) * t.K + t.k0 + 8 * c) = o; }
  dev_wave_fence();
}
template <class Decode> DI void transpose_items(int first, int total, int stride, Decode decode, float* scr, int lane) {
  if (first >= total) return;
  TItem cur, nxt; float v[32]; decode(first, cur); titem_load(cur, lane, v);
  for (int it = first; it < total; it += stride) {
    titem_stage(scr, lane, v);
    const bool more = it + stride < total;
    if (more) { decode(it + stride, nxt); titem_load(nxt, lane, v); }
    titem_finish(cur, scr, lane);
    cur = nxt;
  }
}

DI void phase_prologue(const Params& p, char* smem) {
  const int lane = TID & 63, wave = TID >> 6;
  float* scr = (float*)(smem + wave * 8704);
  const int gw = GWAVE, ngw = NGWAVE;
  constexpr int I_IN = (D / 64) * (2720 / 32), I_OUT = (D / 64) * (D / 32), I_G = (D / 64) * (FF / 32), I_DN = (FF / 64) * (D / 32), I_UQ = (256 / 64) * (384 / 32), I_UKV = (128 / 64) * (512 / 32);
  constexpr int NITEMS = 2 * I_IN + 2 * I_OUT + 2 * I_G + I_DN + 2 * I_UQ + 2 * I_UKV;
  auto decode = [&](int it, TItem& t) { int r = it;
    if (r < 2 * I_IN) { const int l = r / I_IN; titem_set(t, p.in(I_WIN) + (size_t)l * D * 2720, D, 2720, wsp<bf16_t>(p, WS_WIN) + (size_t)l * PW * D, 0, r % I_IN); return; } r -= 2 * I_IN;
    if (r < 2 * I_OUT) { const int l = r / I_OUT; titem_set(t, p.in(I_WOUT) + (size_t)l * D * D, D, D, wsp<bf16_t>(p, WS_WOUT) + (size_t)l * D * D, 0, r % I_OUT); return; } r -= 2 * I_OUT;
    if (r < I_G) { titem_set(t, p.in(I_FG), D, FF, wsp<bf16_t>(p, WS_WGU), 1, r); return; } r -= I_G;
    if (r < I_G) { titem_set(t, p.in(I_FU), D, FF, wsp<bf16_t>(p, WS_WGU), 2, r); return; } r -= I_G;
    if (r < I_DN) { titem_set(t, p.in(I_FD), FF, D, wsp<bf16_t>(p, WS_WDN), 0, r); return; } r -= I_DN;
    if (r < 2 * I_UQ) { const int l = r / I_UQ; titem_set(t, p.in(I_WUQ) + (size_t)l * 256 * 384, 256, 384, wsp<bf16_t>(p, WS_WUQ) + (size_t)l * 512 * 256, 3, r % I_UQ); return; } r -= 2 * I_UQ;
    { const int l = r / I_UKV; titem_set(t, p.in(I_WUKV) + (size_t)l * 128 * 512, 128, 512, wsp<bf16_t>(p, WS_WUKV) + (size_t)l * 512 * 128, 0, r % I_UKV); } };
  transpose_items(gw, NITEMS, ngw, decode, scr, lane);
  const int gt = (int)blockIdx.x * 512 + TID, ngt = (int)gridDim.x * 512;
  { constexpr int LI = 16;
    auto dec2 = [&](int it, TItem& t) { const int l = it / (3 * LI), kind = (it / LI) % 3, j = it % LI; bf16_t* WL = wsp<bf16_t>(p, WS_WLORA) + (size_t)l * 1280 * 256;
      if (kind == 0) { const int d = j >> 3; titem_set(t, p.in(I_WUP) + (size_t)(l * 2 + d) * 64 * 256, 256, 256, WL + (size_t)(d * 256) * 256, 0, j & 7); }
      else if (kind == 1) { const int d = j >> 3; titem_set(t, p.in(I_AUP) + (size_t)(l * 2 + d) * 64 * 256, 256, 256, WL + (size_t)(512 + d * 256) * 256 + 64, 0, j & 7); }
      else { titem_set(t, p.in(I_GUP) + (size_t)l * 128 * 256, 256, 256, WL + (size_t)1024 * 256 + 128, 0, j); } };
    transpose_items(gw, 2 * 3 * LI, ngw, dec2, scr, lane);
    for (int e = gt; e < 2 * 1280 * 32; e += ngt) { const int l = e / (1280 * 32), n = (e / 32) % 1280, c = e % 32, k = 8 * c;
      const bool data = n < 512 ? k < 64 : (n < 1024 ? (k >= 64 && k < 128) : k >= 128);
      if (!data) *(u32x4*)(wsp<bf16_t>(p, WS_WLORA) + ((size_t)l * 1280 + n) * 256 + k) = (u32x4){0u, 0u, 0u, 0u}; } }
  for (int e = gt; e < T * 32; e += ngt) { const int t = e / 32, i = e % 32; const float pos = (i < 16) ? (float)(t / GW) : (float)(t % GW);
    const float invf = exp2f(-(float)(i & 15) / 16.0f * 13.287712379549449f); const float ang = pos * invf;
    wsp<float>(p, WS_TABG)[2 * e] = cosf(ang); wsp<float>(p, WS_TABG)[2 * e + 1] = sinf(ang); }
  for (int e = gt; e < T * 16; e += ngt) { const int t = e / 16, i = e % 16; const float pos = (i < 8) ? (float)(t / GW) : (float)(t % GW);
    const float invf = exp2f(-(float)(i & 7) / 8.0f * 13.287712379549449f); const float ang = pos * invf;
    wsp<float>(p, WS_TABM)[2 * e] = cosf(ang); wsp<float>(p, WS_TABM)[2 * e + 1] = sinf(ang); }
  __syncthreads();
  float* sc = (float*)smem;
  float* red = (float*)(smem + (NB + 1) * D * 4);
  for (int e = TID; e < (NB + 1) * D; e += 512) { const int s = e / D, k = e % D; sc[e] = siluf_(s < NB ? p.in(I_C)[s * D + k] : p.in(I_CCTX)[k]); }
  __syncthreads();
  for (int u = (int)blockIdx.x; u < 2 * 96; u += (int)gridDim.x) {
    const int l = u / 96, jb = (u % 96) * 64, jq = TID & 15, kg = TID >> 4;
    f32x4 acc[NB + 1];
#pragma unroll
    for (int s = 0; s <= NB; ++s) acc[s] = (f32x4){0.f, 0.f, 0.f, 0.f};
    const float* W = p.in(I_MODW) + (size_t)l * D * 6144 + jb + 4 * jq + (size_t)(kg * 32) * 6144;
#pragma unroll
    for (int h0 = 0; h0 < 32; h0 += 16) { f32x4 w[16];
#pragma unroll
      for (int i = 0; i < 16; ++i) w[i] = *(const f32x4*)(W + (size_t)(h0 + i) * 6144);
#pragma unroll
      for (int i = 0; i < 16; ++i) { const int k = kg * 32 + h0 + i;
#pragma unroll
        for (int s = 0; s <= NB; ++s) acc[s] += w[i] * sc[s * D + k]; } }
#pragma unroll
    for (int s = 0; s <= NB; ++s) *(f32x4*)(red + (kg * (NB + 1) + s) * 64 + 4 * jq) = acc[s];
    __syncthreads();
    if (TID < 64 * (NB + 1)) { const int s = TID / 64, jj = TID & 63; float t = 0.f;
#pragma unroll 8
      for (int g = 0; g < 32; ++g) t += red[(g * (NB + 1) + s) * 64 + jj];
      const int jc = jb + jj; wsp<float>(p, WS_MOD)[((size_t)l * (NB + 1) + s) * 6144 + jc] = t + p.in(I_MODB)[l * 6144 + jc]; }
    __syncthreads();
  }
}

DI void moe_convert(const Params& p, char* smem) {
  const int lane = TID & 63, wave = TID >> 6; float* scr = (float*)(smem + wave * 8704);
  constexpr int I_G = (D / 64) * (FF / 32), I_DN = (FF / 64) * (D / 32);
  auto decode = [&](int it, TItem& t) { const int e = it / (2 * I_G + I_DN); int r = it % (2 * I_G + I_DN);
    if (r < I_G) { titem_set(t, p.in(I_MG) + (size_t)e * D * FF, D, FF, wsp<bf16_t>(p, A_MWGU) + (size_t)e * 2 * FF * D, 1, r); return; } r -= I_G;
    if (r < I_G) { titem_set(t, p.in(I_MU2) + (size_t)e * D * FF, D, FF, wsp<bf16_t>(p, A_MWGU) + (size_t)e * 2 * FF * D, 2, r); return; } r -= I_G;
    titem_set(t, p.in(I_MD) + (size_t)e * FF * D, FF, D, wsp<bf16_t>(p, A_MWDN) + (size_t)e * D * FF, 0, r); };
  transpose_items(GWAVE, NE * (2 * I_G + I_DN), NGWAVE, decode, scr, lane);
}

constexpr int RW_NR = 4;
DI const float* mod_ptr(const Params& p, int l, int m, int chunk) { const int s = m < TL ? m / T : NB; return wsp<float>(p, WS_MOD) + ((size_t)l * (NB + 1) + s) * 6144 + chunk * 1024; }
DI void load_row4(const float* src, int lane, f32x4 (&v)[4]) {
#pragma unroll
  for (int j = 0; j < 4; ++j) v[j] = *(const f32x4*)(src + 4 * lane + 256 * j);
}
DI void load_row4_bf(const bf16_t* src, int lane, f32x4 (&v)[4]) {
#pragma unroll
  for (int j = 0; j < 4; ++j) { const u32x2 u = *(const u32x2*)(src + 4 * lane + 256 * j); v[j] = (f32x4){bf2f(u.x & 0xffffu), bf2f(u.x >> 16), bf2f(u.y & 0xffffu), bf2f(u.y >> 16)}; }
}
DI float sumsq4(const f32x4 (&v)[4]) { float s = 0.f;
#pragma unroll
  for (int j = 0; j < 4; ++j) s += (v[j].x * v[j].x + v[j].y * v[j].y) + (v[j].z * v[j].z + v[j].w * v[j].w);
  return s; }
DI void adaln_store(const f32x4 (&v)[4], float rinv, const float* gain, const float* scale, const float* shift, bf16_t* dst, int lane) {
#pragma unroll
  for (int j = 0; j < 4; ++j) { const int c = 4 * lane + 256 * j; const f32x4 g = *(const f32x4*)(gain + c), sc = *(const f32x4*)(scale + c), sh = *(const f32x4*)(shift + c);
    const f32x4 h = v[j] * rinv * g * (sc + 1.0f) + sh; u32x2 o; o.x = pk2(h.x, h.y); o.y = pk2(h.z, h.w); *(u32x2*)(dst + c) = o; }
}
DI void phase_adaln0(const Params& p) {
  const int lane = TID & 63; const int ngw = NGWAVE; const int m0 = GWAVE;
  auto src = [&](int r) { return r < TL ? p.in(I_X) + (size_t)r * D : p.in(I_CTX) + (size_t)(r - TL) * D; };
  for (int mb = m0; mb < MT; mb += 4 * ngw) {
    f32x4 v[4][4];
#pragma unroll
    for (int q = 0; q < 4; ++q) { const int m = mb + q * ngw; if (m < MT) load_row4(src(m), lane, v[q]); }
#pragma unroll
    for (int q = 0; q < 4; ++q) { const int m = mb + q * ngw; if (m < MT) {
      const float rinv = dev_rsqrt(wave_sum(sumsq4(v[q])) * (1.0f / D) + RMS_EPS);
      adaln_store(v[q], rinv, p.in(I_NORMG) + 0 * D, mod_ptr(p, 0, m, 1), mod_ptr(p, 0, m, 0), wsp<bf16_t>(p, A_XN) + (size_t)m * D, lane); } }
  }
}

DI f32x4 ldp4(const bf16_t* row, int c) { const u32x2 u = *(const u32x2*)(row + c); return (f32x4){bf2f(u.x & 0xffffu), bf2f(u.x >> 16), bf2f(u.y & 0xffffu), bf2f(u.y >> 16)}; }
DI float tanh_fast(float x) { return 1.0f - 2.0f * dev_rcp(1.0f + __expf(2.0f * x)); }
DI void st4bf(bf16_t* dst, f32x4 v) { u32x2 o; o.x = pk2(v.x, v.y); o.y = pk2(v.z, v.w); *(u32x2*)dst = o; }
struct PrepRaw { u32x2 x[4], xp[4], xn[4], q, k, cq, ck; };
DI f32x4 up4(u32x2 u) { return (f32x4){bf2f(u.x & 0xffffu), bf2f(u.x >> 16), bf2f(u.y & 0xffffu), bf2f(u.y >> 16)}; }
DI void prep_load(const bf16_t* P, int m, int lane, PrepRaw& r) {
  const bf16_t* row = P + (size_t)m * PW; const bool lat = m < TL; const int pos = lat ? m % T : (m - TL) % C, seqlen = lat ? T : C; const bool hasp = pos > 0, hasn = pos + 1 < seqlen;
#pragma unroll
  for (int j = 0; j < 4; ++j) { const int c = 4 * lane + 256 * j; r.x[j] = *(const u32x2*)(row + c); r.xp[j] = hasp ? *(const u32x2*)(row - PW + c) : (u32x2){0u, 0u}; r.xn[j] = hasn ? *(const u32x2*)(row + PW + c) : (u32x2){0u, 0u}; }
  r.q = *(const u32x2*)(row + 1024 + 4 * lane); r.k = *(const u32x2*)(row + 1280 + 4 * lane); r.cq = *(const u32x2*)(row + 1536 + 4 * lane);
  r.ck = *(const u32x2*)(row + 1792 + 4 * (lane & 31) + (lane >= 32 ? 128 : 0));
}
DI void phase_prep(const Params& p, int l) {
  const int lane = TID & 63; const bf16_t* P = wsp<bf16_t>(p, A_P); const int ngw = NGWAVE; int m = GWAVE; if (m >= MT) return;
  PrepRaw nraw; prep_load(P, m, lane, nraw);
  for (; m < MT; m += ngw) {
    const PrepRaw raw = nraw;
    if (m + ngw < MT) prep_load(P, m + ngw, lane, nraw);
    const int b = row_batch(m), kpos = row_kpos(m); const bool lat = m < TL; const int t = lat ? m % T : 0;
    f32x4 rw[4];
#pragma unroll
    for (int j = 0; j < 4; ++j) { const int c = 4 * lane + 256 * j; const f32x4 x = up4(raw.x[j]), xp = up4(raw.xp[j]), xn = up4(raw.xn[j]);
      const f32x4 mu = *(const f32x4*)(p.in(I_MU) + l * 1024 + c); rw[j] = x + mu * ((xp + xn) * 0.5f - x); }
    const int hd = lane >> 4, dd = 4 * (lane & 15);
    { const f32x4 kkw = *(const f32x4*)(p.in(I_KK) + l * 256 + 4 * lane); f32x4 kk = rw[1] * kkw;
      const float ss = sum16((kk.x * kk.x + kk.y * kk.y) + (kk.z * kk.z + kk.w * kk.w)); kk = kk * dev_rsqrt(ss + 1e-12f);
      bf16_t* scs = wsp<bf16_t>(p, A_SCS) + ((size_t)(b * 4 + hd) * NK + kpos) * 192;
      st4bf(scs + dd, rw[0]); st4bf(scs + 64 + dd, rw[2]); st4bf(scs + 128 + dd, kk);
      st4bf(wsp<bf16_t>(p, A_KSH) + (size_t)m * 256 + 4 * lane, rw[1]);
      f32x4 a; const f32x4 x = rw[3];
      if (lane < 16) a = (f32x4){tanh_fast(x.x), tanh_fast(x.y), tanh_fast(x.z), tanh_fast(x.w)};
      else if (lane < 32) a = x;
      else a = (f32x4){sigmoidf_(x.x), sigmoidf_(x.y), sigmoidf_(x.z), sigmoidf_(x.w)};
      st4bf(wsp<bf16_t>(p, A_RWA) + (size_t)m * 256 + 4 * lane, a); }
    { f32x4 q = up4(raw.q); const float ss = sum16((q.x * q.x + q.y * q.y) + (q.z * q.z + q.w * q.w));
      q = q * (dev_rsqrt(ss * (1.0f / 64.0f) + RMS_EPS) * (0.125f * LOG2E)) * *(const f32x4*)(p.in(I_GQG) + l * 64 + dd);
      if (lat) { f32x4 o; const bool lo = (lane & 15) < 8; const int i0 = dd & 31; const float* tab = wsp<float>(p, WS_TABG) + ((size_t)t * 32 + i0) * 2;
#pragma unroll
        for (int e = 0; e < 4; ++e) { const f32x4 tv = *(const f32x4*)(tab + 4 * (e >> 1)); const float mine = q[e], oth = dev_shfl_xor(q[e], 8), cs = (e & 1) ? tv.z : tv.x, sn = (e & 1) ? tv.w : tv.y; o[e] = lo ? mine * cs - oth * sn : oth * sn + mine * cs; }
        q = o; }
      st4bf(wsp<bf16_t>(p, A_QG) + (size_t)m * 256 + 4 * lane, q);
      const f32x4 k = up4(raw.k);
      const float ssk = sum16((k.x * k.x + k.y * k.y) + (k.z * k.z + k.w * k.w));
      f32x4 kn = k * dev_rsqrt(ssk * (1.0f / 64.0f) + RMS_EPS) * *(const f32x4*)(p.in(I_GKG) + l * 64 + dd);
      if (lat) { f32x4 o; const bool lo = (lane & 15) < 8; const int i0 = dd & 31; const float* tab = wsp<float>(p, WS_TABG) + ((size_t)t * 32 + i0) * 2;
#pragma unroll
        for (int e = 0; e < 4; ++e) { const f32x4 tv = *(const f32x4*)(tab + 4 * (e >> 1)); const float mine = kn[e], oth = dev_shfl_xor(kn[e], 8), cs = (e & 1) ? tv.z : tv.x, sn = (e & 1) ? tv.w : tv.y; o[e] = lo ? mine * cs - oth * sn : oth * sn + mine * cs; }
        kn = o; }
      if (lane < 32) st4bf(wsp<bf16_t>(p, A_KG) + (size_t)m * 128 + 4 * lane, kn);
 }
    { f32x4 cq = up4(raw.cq); const float ss = wave_sum((cq.x * cq.x + cq.y * cq.y) + (cq.z * cq.z + cq.w * cq.w));
      cq = cq * dev_rsqrt(ss * (1.0f / 256.0f) + RMS_EPS) * *(const f32x4*)(p.in(I_MQG) + l * 256 + 4 * lane);
      st4bf(wsp<bf16_t>(p, A_CQN) + (size_t)m * 256 + 4 * lane, cq);
      f32x4 x = up4(raw.ck);
      if (lane >= 40) x = (f32x4){0.f, 0.f, 0.f, 0.f};
      const float s2 = wave_sum(lane < 32 ? (x.x * x.x + x.y * x.y) + (x.z * x.z + x.w * x.w) : 0.f);
      if (lane < 32) { const f32x4 o = x * dev_rsqrt(s2 * (1.0f / 128.0f) + RMS_EPS) * *(const f32x4*)(p.in(I_MKVG) + l * 128 + 4 * lane); st4bf(wsp<bf16_t>(p, A_CKVN) + (size_t)m * 128 + 4 * lane, o); }
      f32x4 oth;
#pragma unroll
      for (int e = 0; e < 4; ++e) oth[e] = dev_shfl_xor(x[e], 4);
      if (lane >= 32 && lane < 36) { const int i0 = 4 * (lane - 32); f32x4 o1 = x, o2 = oth;
        if (lat) { const float* tab = wsp<float>(p, WS_TABM) + ((size_t)t * 16 + i0) * 2;
#pragma unroll
          for (int e = 0; e < 4; ++e) { const f32x4 tv = *(const f32x4*)(tab + 4 * (e >> 1)); const float cs = (e & 1) ? tv.z : tv.x, sn = (e & 1) ? tv.w : tv.y; o1[e] = x[e] * cs - oth[e] * sn; o2[e] = x[e] * sn + oth[e] * cs; } }
        u32x4 w; w.x = pk2(o1.x, o2.x); w.y = pk2(o1.y, o2.y); w.z = pk2(o1.z, o2.z); w.w = pk2(o1.w, o2.w);
#pragma unroll
        for (int h4 = 0; h4 < 4; ++h4) *(u32x4*)(wsp<bf16_t>(p, A_KM) + (size_t)m * 384 + h4 * 96 + 64 + 2 * i0) = w; } }
  }
}

struct RoRaw { f32x4 v, y[2], g; float rho[2]; };
DI void ro_load(const Params& p, int m, int lane, RoRaw& o) {
  const int hd = lane >> 4, dd = 4 * (lane & 15); const int b = row_batch(m), kpos = row_kpos(m);
  const bf16_t* scs = wsp<bf16_t>(p, A_SCS) + ((size_t)(b * 4 + hd) * NK + kpos) * 192; o.v = ldp4(scs + 64, dd);
#pragma unroll
  for (int d = 0; d < 2; ++d) { o.y[d] = ldp4(wsp<bf16_t>(p, A_YS) + ((size_t)d * MT + m) * 256, 4 * lane);
    o.rho[d] = wsp<float>(p, A_RHO)[((size_t)d * MT + m) * 4 + hd]; }
  o.g = ldp4(wsp<bf16_t>(p, A_RWG) + (size_t)m * 256, 4 * lane);
}
DI void phase_rwkv_out(const Params& p, int l) {
  const int lane = TID & 63; const int ngw = NGWAVE; const int m0 = GWAVE; const int MR = l == 0 ? MT : TL; if (m0 >= MR) return;
  const f32x4 lg = *(const f32x4*)(p.in(I_LNG) + l * 256 + 4 * lane), lb = *(const f32x4*)(p.in(I_LNB) + l * 256 + 4 * lane);
  constexpr int RO_NR = 4;
  for (int mb = m0; mb < MR; mb += RO_NR * ngw) {
    RoRaw rr[RO_NR];
#pragma unroll
    for (int q = 0; q < RO_NR; ++q) if (mb + q * ngw < MR) ro_load(p, mb + q * ngw, lane, rr[q]);
#pragma unroll
    for (int q = 0; q < RO_NR; ++q) { const int m = mb + q * ngw; if (m >= MR) continue; const RoRaw& raw = rr[q];
    f32x4 tot = {0.f, 0.f, 0.f, 0.f};
#pragma unroll
    for (int d = 0; d < 2; ++d) {
      const f32x4 y = raw.y[d];
      const float mean = sum16((y.x + y.y) + (y.z + y.w)) * (1.0f / 64.0f); const f32x4 yc = y - mean;
      const float var = sum16((yc.x * yc.x + yc.y * yc.y) + (yc.z * yc.z + yc.w * yc.w)) * (1.0f / 64.0f);
      tot += yc * dev_rsqrt(var + GN_EPS) * lg + lb + raw.v * raw.rho[d];
    }
    st4bf(wsp<bf16_t>(p, A_Y) + (size_t)m * D + 4 * lane, tot * raw.g);
    if (m < TL) {
      const int b = m / T, tq = m % T, qb = tq / 128, rq = tq % 128, hd = lane >> 4, uu = (b * 2 + (hd >> 1)) * (T / 128) + qb;
      if (uu >= GQ_UNITS - GQ_SPLIT) { const int su = uu - (GQ_UNITS - GQ_SPLIT), w = (hd & 1) * 4 + (rq >> 5), r = rq & 31;
        const size_t i0 = (size_t)((su * 2) * 8 + w), i1 = (size_t)((su * 2 + 1) * 8 + w);
        const float* s0 = wsp<float>(p, A_GST) + i0 * 64 + 2 * r; const float* s1 = wsp<float>(p, A_GST) + i1 * 64 + 2 * r;
        const float m0_ = s0[0], l0 = s0[1], m1_ = s1[0], l1 = s1[1], mx = fmaxf(m0_, m1_), w0 = l0 * dev_exp2(m0_ - mx), w1 = l1 * dev_exp2(m1_ - mx), inv = dev_rcp(w0 + w1);
        const f32x4 o0 = ldp4(wsp<bf16_t>(p, A_GPO) + i0 * 2048 + r * 64, 4 * (lane & 15)), o1 = ldp4(wsp<bf16_t>(p, A_GPO) + i1 * 2048 + r * 64, 4 * (lane & 15));
        st4bf(wsp<bf16_t>(p, A_Y) + (size_t)m * D + 256 + 4 * lane, (o0 * w0 + o1 * w1) * inv); } }
    }
  }
}

constexpr int PMX_LCNT = D * NE * 4  , PMX_RBUF = PMX_LCNT + 64, PMX_MAXR = 32;
template <int NR> DI void post_mixer_rows(const Params& p, int l, char* smem) {
  const int lane = TID & 63; const int mrows = (l == 0) ? MT : TL; const int ngw = NGWAVE; const int m0 = GWAVE;
  auto xsrc_of = [&](int r) { return (l == 0) ? (r < TL ? p.in(I_X) + (size_t)r * D : p.in(I_CTX) + (size_t)(r - TL) * D) : (const float*)(p.out + (size_t)r * D); };
  for (int mb = m0; mb < mrows; mb += NR * ngw) {
    f32x4 yv[NR][4], xv[NR][4];
#pragma unroll
    for (int q = 0; q < NR; ++q) { const int m = mb + q * ngw; if (m < mrows) {
      if (m < TL) load_row4_bf(wsp<bf16_t>(p, A_YO) + (size_t)m * D, lane, yv[q]);
      else { load_row4_bf(wsp<bf16_t>(p, A_YOS) + (size_t)(m - TL) * D, lane, yv[q]);
#pragma unroll
        for (int sl = 1; sl < OS_NS; ++sl) { f32x4 t[4]; load_row4_bf(wsp<bf16_t>(p, A_YOS) + ((size_t)sl * TC + (m - TL)) * D, lane, t);
#pragma unroll
          for (int j = 0; j < 4; ++j) yv[q][j] += t[j]; } }
      load_row4(xsrc_of(m), lane, xv[q]); } }
#pragma unroll
    for (int q = 0; q < NR; ++q) { const int m = mb + q * ngw; if (m < mrows) {
      f32x4 (&y)[4] = yv[q]; f32x4 (&x)[4] = xv[q];
      const float rinv = dev_rsqrt(wave_sum(sumsq4(y)) * (1.0f / D) + RMS_EPS);
      float* xdst = m < TL ? p.out + (size_t)m * D : wsp<float>(p, WS_XSC) + (size_t)(m - TL) * D;
      const float* g1 = p.in(I_NORMG) + (l * 4 + 1) * D; const float* gate = mod_ptr(p, l, m, 2);
#pragma unroll
      for (int j = 0; j < 4; ++j) { const int c = 4 * lane + 256 * j; x[j] = x[j] + *(const f32x4*)(gate + c) * (y[j] * rinv * *(const f32x4*)(g1 + c)); *(f32x4*)(xdst + c) = x[j]; }
      const float rinv2 = dev_rsqrt(wave_sum(sumsq4(x)) * (1.0f / D) + RMS_EPS);
      if (l == 0) { adaln_store(x, rinv2, p.in(I_NORMG) + (l * 4 + 2) * D, mod_ptr(p, l, m, 4), mod_ptr(p, l, m, 3), wsp<bf16_t>(p, A_XN) + (size_t)m * D, lane); }
      else {
        const float* g2 = p.in(I_NORMG) + (l * 4 + 2) * D; const float* sc = mod_ptr(p, l, m, 4); const float* sh = mod_ptr(p, l, m, 3);
        float lg[NE];
#pragma unroll
        for (int e = 0; e < NE; ++e) lg[e] = 0.f;
#pragma unroll
        for (int j = 0; j < 4; ++j) { const int c = 4 * lane + 256 * j; const f32x4 h = x[j] * rinv2 * *(const f32x4*)(g2 + c) * (*(const f32x4*)(sc + c) + 1.0f) + *(const f32x4*)(sh + c);
#pragma unroll
          for (int qq = 0; qq < 4; ++qq) { const float* rr = (const float*)smem + (size_t)(c + qq) * NE;
#pragma unroll
            for (int e = 0; e < NE; ++e) lg[e] += h[qq] * rr[e]; } }
#pragma unroll
        for (int e = 0; e < NE; ++e) lg[e] = wave_sum(lg[e]);
        int e0 = 0; float v0 = lg[0];
#pragma unroll
        for (int e = 1; e < NE; ++e) if (lg[e] > v0) { v0 = lg[e]; e0 = e; }
        int e1 = -1; float v1 = -3.0e38f;
#pragma unroll
        for (int e = 0; e < NE; ++e) if (e != e0 && lg[e] > v1) { v1 = lg[e]; e1 = e; }
        if (lane == 0) { int* lcnt = (int*)(smem + PMX_LCNT); int* rb = (int*)(smem + PMX_RBUF) + ((TID >> 6) * PMX_MAXR + (mb - m0) / ngw + q) * 4;
          rb[0] = e0; rb[1] = dev_lds_add(lcnt + e0, 1); rb[2] = e1; rb[3] = dev_lds_add(lcnt + e1, 1);
          float* rw = (float*)(wsp<int>(p, WS_ROUTE) + (size_t)TL * 4) + (size_t)m * 2; const float w0 = dev_rcp(1.0f + __expf(v1 - v0)); rw[0] = w0; rw[1] = 1.0f - w0; }
      } } }
  }
  if (l == 1) {
    __syncthreads();
    int* lcnt = (int*)(smem + PMX_LCNT); int* lbase = lcnt + NE;
    if (TID < NE) { const int c = lcnt[TID]; lbase[TID] = c ? (int)dev_atomic_add(wsp<unsigned>(p, WS_CTL) + CW_CNT + 64 * TID, (unsigned)c) : 0; }
    __syncthreads();
    const int nrow = m0 < mrows ? (mrows - m0 + ngw - 1) / ngw : 0;
    if (lane < nrow) { const int* rb = (const int*)(smem + PMX_RBUF) + ((TID >> 6) * PMX_MAXR + lane) * 4; int* rt = wsp<int>(p, WS_ROUTE) + (size_t)(m0 + lane * ngw) * 4;
      rt[0] = rb[0]; rt[1] = lbase[rb[0]] + rb[1]; rt[2] = rb[2]; rt[3] = lbase[rb[2]] + rb[3]; }
  }
}
DI void phase_post_mixer(const Params& p, int l, char* smem) {
  if (l == 1) { const int t0 = TID; for (int e = t0; e < D * NE / 4; e += 512) ((f32x4*)smem)[e] = ((const f32x4*)p.in(I_ROUTER))[e]; if (t0 < 2 * NE) ((int*)(smem + PMX_LCNT))[t0] = 0; __syncthreads(); }
  if (l == 0) post_mixer_rows<4>(p, l, smem); else post_mixer_rows<2>(p, l, smem);
}
DI void moe_offsets(const Params& p, int (&off)[NE + 1]) { const unsigned* cnt = wsp<unsigned>(p, WS_CTL) + CW_CNT; off[0] = 0;
#pragma unroll
  for (int e = 0; e < NE; ++e) off[e + 1] = off[e] + (int)((dev_atomic_load(cnt + 64 * e) + 255u) & ~255u); }
constexpr int GA_NR = 8;
DI void phase_moe_gather(const Params& p, int l) {
  const int lane = TID & 63; int off[NE + 1]; moe_offsets(p, off); const int ngw = NGWAVE; const int m0 = GWAVE;
  for (int mb = m0; mb < TL; mb += GA_NR * ngw) {
    f32x4 x[GA_NR][4]; u32x4 rtv[GA_NR];
#pragma unroll
    for (int q = 0; q < GA_NR; ++q) { const int m = mb + q * ngw; if (m < TL) { load_row4(p.out + (size_t)m * D, lane, x[q]); rtv[q] = *(const u32x4*)(wsp<int>(p, WS_ROUTE) + (size_t)m * 4); } }
#pragma unroll
    for (int q = 0; q < GA_NR; ++q) { const int m = mb + q * ngw; if (m < TL) {
      const float rinv2 = dev_rsqrt(wave_sum(sumsq4(x[q])) * (1.0f / D) + RMS_EPS);
      const int e0 = (int)rtv[q].x, p0 = (int)rtv[q].y, e1 = (int)rtv[q].z, p1 = (int)rtv[q].w;
      int o0 = 0, o1 = 0;
#pragma unroll
      for (int e = 0; e < NE; ++e) { if (e == e0) o0 = off[e]; if (e == e1) o1 = off[e]; }
      adaln_store(x[q], rinv2, p.in(I_NORMG) + (l * 4 + 2) * D, mod_ptr(p, l, m, 4), mod_ptr(p, l, m, 3), wsp<bf16_t>(p, A_XG) + (size_t)(o0 + p0) * D, lane);
      adaln_store(x[q], rinv2, p.in(I_NORMG) + (l * 4 + 2) * D, mod_ptr(p, l, m, 4), mod_ptr(p, l, m, 3), wsp<bf16_t>(p, A_XG) + (size_t)(o1 + p1) * D, lane); } }
  }
}
DI void phase_post_ffn0(const Params& p) {
  const int lane = TID & 63; const int ngw = NGWAVE; const int m0 = GWAVE;
  auto xs_of = [&](int r) { return r < TL ? p.out + (size_t)r * D : wsp<float>(p, WS_XSC) + (size_t)(r - TL) * D; };
  for (int mb = m0; mb < MT; mb += RW_NR * ngw) {
    f32x4 f[RW_NR][4], x[RW_NR][4];
#pragma unroll
    for (int q = 0; q < RW_NR; ++q) { const int m = mb + q * ngw; if (m < MT) {
      if (m < TL) load_row4_bf(wsp<bf16_t>(p, A_F) + (size_t)m * D, lane, f[q]);
      else { load_row4_bf(wsp<bf16_t>(p, A_FS) + (size_t)(m - TL) * D, lane, f[q]);
#pragma unroll
        for (int sl = 1; sl < FS_NS; ++sl) { f32x4 t[4]; load_row4_bf(wsp<bf16_t>(p, A_FS) + ((size_t)sl * TC + (m - TL)) * D, lane, t);
#pragma unroll
          for (int j = 0; j < 4; ++j) f[q][j] += t[j]; } }
      load_row4(xs_of(m), lane, x[q]); } }
#pragma unroll
    for (int q = 0; q < RW_NR; ++q) { const int m = mb + q * ngw; if (m < MT) {
      const float rinv = dev_rsqrt(wave_sum(sumsq4(f[q])) * (1.0f / D) + RMS_EPS);
      float* xs = xs_of(m);
      const float* g3 = p.in(I_NORMG) + 3 * D; const float* gate = mod_ptr(p, 0, m, 5);
#pragma unroll
      for (int j = 0; j < 4; ++j) { const int c = 4 * lane + 256 * j; x[q][j] = x[q][j] + *(const f32x4*)(gate + c) * (f[q][j] * rinv * *(const f32x4*)(g3 + c)); *(f32x4*)(xs + c) = x[q][j]; }
      const float rinv2 = dev_rsqrt(wave_sum(sumsq4(x[q])) * (1.0f / D) + RMS_EPS);
      adaln_store(x[q], rinv2, p.in(I_NORMG) + 4 * D, mod_ptr(p, 1, m, 1), mod_ptr(p, 1, m, 0), wsp<bf16_t>(p, A_XN) + (size_t)m * D, lane); } }
  }
}
DI void phase_moe_combine(const Params& p, int l) {
  const int lane = TID & 63; int off[NE + 1]; moe_offsets(p, off); const bf16_t* FG = wsp<bf16_t>(p, A_XG); const int ngw = NGWAVE; const int m0 = GWAVE;
  for (int mb = m0; mb < TL; mb += RW_NR * ngw) {
    u32x2 ra[RW_NR][4], rb[RW_NR][4]; f32x4 x[RW_NR][4]; float w0[RW_NR], w1[RW_NR]; u32x4 rtv[RW_NR];
#pragma unroll
    for (int q = 0; q < RW_NR; ++q) { const int m = mb + q * ngw; if (m < TL) {
      rtv[q] = *(const u32x4*)(wsp<int>(p, WS_ROUTE) + (size_t)m * 4); const float* rw = (const float*)(wsp<int>(p, WS_ROUTE) + (size_t)TL * 4) + (size_t)m * 2; w0[q] = rw[0]; w1[q] = rw[1];
      load_row4(p.out + (size_t)m * D, lane, x[q]); } }
#pragma unroll
    for (int q = 0; q < RW_NR; ++q) { const int m = mb + q * ngw; if (m < TL) {
      const int e0 = (int)rtv[q].x, p0 = (int)rtv[q].y, e1 = (int)rtv[q].z, p1 = (int)rtv[q].w;
      int o0 = 0, o1 = 0;
#pragma unroll
      for (int e = 0; e < NE; ++e) { if (e == e0) o0 = off[e]; if (e == e1) o1 = off[e]; }
      const int s0 = o0 + p0, s1 = o1 + p1; const float* SL = wsp<float>(p, WS_MSLAB);
      auto ldrow = [&](int s, u32x2 (&r)[4]) {
        if (s < MOE_NFULL * 256) { const bf16_t* rr = FG + (size_t)s * D;
#pragma unroll
          for (int j = 0; j < 4; ++j) r[j] = *(const u32x2*)(rr + 4 * lane + 256 * j); }
        else { const float* rr = SL + (size_t)(s - MOE_NFULL * 256) * D;
#pragma unroll
          for (int j = 0; j < 4; ++j) { f32x4 t = *(const f32x4*)(rr + 4 * lane + 256 * j);
#pragma unroll
            for (int ks = 1; ks < MOE_NS; ++ks) t += *(const f32x4*)(rr + (size_t)ks * MOE_TAILROWS * D + 4 * lane + 256 * j);
            r[j].x = pk2(t.x, t.y); r[j].y = pk2(t.z, t.w); } } };
      ldrow(s0, ra[q]); ldrow(s1, rb[q]); } }
#pragma unroll
    for (int q = 0; q < RW_NR; ++q) { const int m = mb + q * ngw; if (m < TL) {
      f32x4 f[4];
#pragma unroll
      for (int j = 0; j < 4; ++j) f[j] = up4(ra[q][j]) * w0[q] + up4(rb[q][j]) * w1[q];
      const float rinv = dev_rsqrt(wave_sum(sumsq4(f)) * (1.0f / D) + RMS_EPS);
      float* xs = p.out + (size_t)m * D; const float* g3 = p.in(I_NORMG) + (l * 4 + 3) * D; const float* gate = mod_ptr(p, l, m, 5);
#pragma unroll
      for (int j = 0; j < 4; ++j) { const int c = 4 * lane + 256 * j; *(f32x4*)(xs + c) = x[q][j] + *(const f32x4*)(gate + c) * (f[j] * rinv * *(const f32x4*)(g3 + c)); } } }
  }
}

struct EpiStoreBf16 { bf16_t* O; int ld; int ncols;
  DI void store8(int urow, int row, int col, const float (&v)[8]) const { if (col >= ncols) return; u32x4 w; w.x = pk2(v[0], v[1]); w.y = pk2(v[2], v[3]); w.z = pk2(v[4], v[5]); w.w = pk2(v[6], v[7]); *(u32x4*)(O + (size_t)row * ld + col) = w; } };
struct EpiInProj { bf16_t* P; bf16_t* QKVN;
  DI void store8(int urow, int row, int col, const float (&v)[8]) const { if (col >= 2720) return; u32x4 w; w.x = pk2(v[0], v[1]); w.y = pk2(v[2], v[3]); w.z = pk2(v[4], v[5]); w.w = pk2(v[6], v[7]);
    if (col >= 1952) *(u32x4*)(QKVN + (size_t)row * 896 + (col - 1952)) = w; else if (col >= 1408 && col < 1536) *(u32x4*)(QKVN + (size_t)row * 896 + 768 + (col - 1408)) = w; else *(u32x4*)(P + (size_t)row * PW + col) = w; } };
struct EpiStoreF32 { float* O; int ld;
  DI void store8(int urow, int row, int col, const float (&v)[8]) const { float* o = O + (size_t)row * ld + col; *(f32x4*)o = (f32x4){v[0], v[1], v[2], v[3]}; *(f32x4*)(o + 4) = (f32x4){v[4], v[5], v[6], v[7]}; } };
struct EpiSwiGlu { bf16_t* O; int ld;
  DI void store8(int urow, int row, int col, const float (&v)[8]) const { u32x2 w; w.x = pk2(siluf_(v[0]) * v[1], siluf_(v[2]) * v[3]); w.y = pk2(siluf_(v[4]) * v[5], siluf_(v[6]) * v[7]); *(u32x2*)(O + (size_t)row * ld + (col >> 1)) = w; } };
struct LoraIn { u32x4 kk8, ks8; };
DI void lora_lw8(const float (&v)[8], const f32x4 wa, const f32x4 wb, f32x4& oa, f32x4& ob) {
#pragma unroll
  for (int i = 0; i < 4; ++i) { oa[i] = (-0.6065306597126334f * LOG2E) * sigmoidf_(wa[i] + v[i]); ob[i] = (-0.6065306597126334f * LOG2E) * sigmoidf_(wb[i] + v[4 + i]); } }
DI void lora_bk8(const float (&v)[8], const f32x4 (&a0v)[2], const f32x4 (&kav)[2], const LoraIn& in, u32x4& wb, u32x4& wk) { float ob[8], ok[8];
#pragma unroll
  for (int hf = 0; hf < 2; ++hf) { const f32x4 ksv = up4((u32x2){in.ks8[2 * hf], in.ks8[2 * hf + 1]}); const f32x4 kkv = up4((u32x2){in.kk8[2 * hf], in.kk8[2 * hf + 1]});
#pragma unroll
    for (int i = 0; i < 4; ++i) { const float a = sigmoidf_(a0v[hf][i] + v[4 * hf + i]); ob[4 * hf + i] = kkv[i] * a; ok[4 * hf + i] = ksv[i] * (1.0f + (a - 1.0f) * kav[hf][i]); } }
  wb.x = pk2(ob[0], ob[1]); wb.y = pk2(ob[2], ob[3]); wb.z = pk2(ob[4], ob[5]); wb.w = pk2(ob[6], ob[7]);
  wk.x = pk2(ok[0], ok[1]); wk.y = pk2(ok[2], ok[3]); wk.z = pk2(ok[4], ok[5]); wk.w = pk2(ok[6], ok[7]); }
struct EpiLora { const Params* p; int l;
  DI float* lw_dst(int blk, int b, int hd, int kpos, int dd) const { return wsp<float>(*p, A_SCD) + ((size_t)((blk * NB + b) * 4 + hd) * NK + kpos) * 192 + dd; }
  DI bf16_t* bk_dst(int d, int b, int hd, int kpos, int dd) const { return (bf16_t*)(wsp<float>(*p, A_SCD) + ((size_t)((d * NB + b) * 4 + hd) * NK + kpos) * 192 + 64) + dd; }
  DI void bk_load(int b, int hd, int kpos, int dd, int m, int cc, LoraIn& in) const { const bf16_t* kk = wsp<bf16_t>(*p, A_SCS) + ((size_t)(b * 4 + hd) * NK + kpos) * 192 + 128 + dd; const bf16_t* ks = wsp<bf16_t>(*p, A_KSH) + (size_t)m * 256 + cc;
    in.kk8 = *(const u32x4*)kk; in.ks8 = *(const u32x4*)ks; }
  DI void store8(int urow, int m, int col, const float (&v)[8]) const {
    const int blk = col >> 8, cc = col & 255, hd = cc >> 6, dd = cc & 63; const int b = row_batch(urow), kpos = row_kpos(urow) + (m - urow);
    if (blk < 2) { const float* w0 = p->in(I_W0) + (l * 2 + blk) * 256 + cc; float* dst = lw_dst(blk, b, hd, kpos, dd); f32x4 oa, ob;
      lora_lw8(v, *(const f32x4*)w0, *(const f32x4*)(w0 + 4), oa, ob); *(f32x4*)dst = oa; *(f32x4*)(dst + 4) = ob; }
    else if (blk < 4) { const int d = blk - 2; const float* a0 = p->in(I_A0) + (l * 2 + d) * 256 + cc; const float* ka = p->in(I_KA) + l * 256 + cc;
      const f32x4 a0v[2] = {*(const f32x4*)a0, *(const f32x4*)(a0 + 4)}, kav[2] = {*(const f32x4*)ka, *(const f32x4*)(ka + 4)};
      LoraIn in; bk_load(b, hd, kpos, dd, m, cc, in); u32x4 wb, wk; lora_bk8(v, a0v, kav, in, wb, wk);
      bf16_t* dst = bk_dst(d, b, hd, kpos, dd); *(u32x4*)dst = wb; *(u32x4*)(dst + 64) = wk; }
    else if (blk == 4) { u32x4 w; w.x = pk2(v[0], v[1]); w.y = pk2(v[2], v[3]); w.z = pk2(v[4], v[5]); w.w = pk2(v[6], v[7]); *(u32x4*)(wsp<bf16_t>(*p, A_RWG) + (size_t)m * 256 + cc) = w; }
  } };
struct EpiMlaQ { const Params* p;
  DI void store8(int urow, int m, int col, const float (&v0)[8]) const { if (col >= 384) return; const int dd = col % 96; float o[8], v[8];
#pragma unroll
    for (int i = 0; i < 8; ++i) { v[i] = v0[i] * (0.10206207261596575f * LOG2E); o[i] = v[i]; }
    if (dd >= 64 && m < TL) { const int i0 = (dd - 64) >> 1; const float* tab = wsp<float>(*p, WS_TABM) + ((size_t)(m % T) * 16 + i0) * 2; const f32x4 t0 = *(const f32x4*)tab, t1 = *(const f32x4*)(tab + 4);
      const float cs4[4] = {t0.x, t0.z, t1.x, t1.z}, sn4[4] = {t0.y, t0.w, t1.y, t1.w};
#pragma unroll
      for (int u = 0; u < 4; ++u) { const float cs = cs4[u], sn = sn4[u]; o[2 * u] = v[2 * u] * cs - v[2 * u + 1] * sn; o[2 * u + 1] = v[2 * u] * sn + v[2 * u + 1] * cs; } }
    u32x4 w; w.x = pk2(o[0], o[1]); w.y = pk2(o[2], o[3]); w.z = pk2(o[4], o[5]); w.w = pk2(o[6], o[7]); *(u32x4*)(wsp<bf16_t>(*p, A_QM) + (size_t)m * 384 + col) = w; } };
struct EpiMlaKV { const Params* p;
  DI void store8(int urow, int m, int col, const float (&v)[8]) const { const int hd = col >> 7, dd = col & 127; u32x4 w; w.x = pk2(v[0], v[1]); w.y = pk2(v[2], v[3]); w.z = pk2(v[4], v[5]); w.w = pk2(v[6], v[7]);
    if (dd < 64) *(u32x4*)(wsp<bf16_t>(*p, A_KM) + (size_t)m * 384 + hd * 96 + dd) = w; else *(u32x4*)(wsp<bf16_t>(*p, A_VM) + (size_t)m * 256 + hd * 64 + dd - 64) = w; } };

struct TileSrc { const bf16_t* k; const bf16_t* v; int kr; };
constexpr int ATT_VP = 144;
template <int DQ> struct AttL { static constexpr int KP = DQ * 2 + 16, KB = 64 * KP, VB = 64 * ATT_VP, BUF = KB + VB; };
constexpr int ATT_SCR = 2 * AttL<96>::BUF;
constexpr int ATT_BIAS = ATT_SCR + 8 * 256;
constexpr int ATT_LDS = ATT_BIAS + 2048;

template <int DQ, bool NAT, class TileFn>
DI void attn_unit(char* smem, const bf16_t* qptr, int qpitch, bf16_t* optr, int opitch, int ntiles, TileFn tilefn, int kpitch, int vpitch, float sc, int nat_qi, int nat_c0) {
  typedef AttL<DQ> L; constexpr int NDS = DQ / 16, KCH = DQ / 8;
  const int tid = TID, lane = tid & 63, wave = tid >> 6, r = lane & 31, h = lane >> 5;
  float* scr = (float*)(smem + ATT_SCR + wave * 256); const float* btab = (const float*)(smem + ATT_BIAS);
  bf16x8 qf[NDS];
#pragma unroll
  for (int ds = 0; ds < NDS; ++ds) qf[ds] = *(const bf16x8*)(qptr + (size_t)r * qpitch + 16 * ds + 8 * h);
  f32x16 o0, o1, lacc;
#pragma unroll
  for (int i = 0; i < 16; ++i) { o0[i] = 0.f; o1[i] = 0.f; lacc[i] = 0.f; }
  float m_run = -1.0e30f;
  const bf16x8 ones8 = {0x3f80, 0x3f80, 0x3f80, 0x3f80, 0x3f80, 0x3f80, 0x3f80, 0x3f80};
  const int kr0 = tid / KCH, kc0 = tid % KCH, kr1 = (tid + 512) / KCH, kc1 = (tid + 512) % KCH; const bool two = (DQ == 96) && (tid < 256);
  const int vr = tid >> 3, vc = tid & 7;
  u32x4 gk0, gk1 = {0, 0, 0, 0}, gv, hk0 = {0, 0, 0, 0}, hk1 = {0, 0, 0, 0}, hv = {0, 0, 0, 0};
  { const TileSrc ts = tilefn(0); gk0 = *(const u32x4*)(ts.k + (size_t)kr0 * kpitch + kc0 * 8); if (two) gk1 = *(const u32x4*)(ts.k + (size_t)kr1 * kpitch + kc1 * 8); gv = *(const u32x4*)(ts.v + (size_t)vr * vpitch + vc * 8);
    *(u32x4*)(smem + kr0 * L::KP + kc0 * 16) = gk0; if (two) *(u32x4*)(smem + kr1 * L::KP + kc1 * 16) = gk1; *(u32x4*)(smem + L::KB + vr * ATT_VP + vc * 16) = gv; }
  if (ntiles > 1) { const TileSrc ts = tilefn(1); gk0 = *(const u32x4*)(ts.k + (size_t)kr0 * kpitch + kc0 * 8); if (two) gk1 = *(const u32x4*)(ts.k + (size_t)kr1 * kpitch + kc1 * 8); gv = *(const u32x4*)(ts.v + (size_t)vr * vpitch + vc * 8); }
  __syncthreads();
  const int nat_rs = NAT ? (nat_qi - 4 < 0 ? 0 : (nat_qi - 4 > GROWS - 8 ? GROWS - 8 : nat_qi - 4)) : 0;
  const int qc = nat_c0 + r, cs = qc - 8 < 0 ? 0 : (qc - 8 > 48 ? 48 : qc - 8);
  for (int it = 0; it < ntiles; ++it) {
    const char* buf = smem + (it & 1) * L::BUF; char* nbuf = smem + ((it + 1) & 1) * L::BUF;
    const TileSrc cur = tilefn(it);
    if (it + 2 < ntiles) { const TileSrc ts = tilefn(it + 2); hk0 = *(const u32x4*)(ts.k + (size_t)kr0 * kpitch + kc0 * 8); if (two) hk1 = *(const u32x4*)(ts.k + (size_t)kr1 * kpitch + kc1 * 8); hv = *(const u32x4*)(ts.v + (size_t)vr * vpitch + vc * 8); }
    const bool active = !NAT || cur.kr < 0 || (cur.kr >= nat_rs && cur.kr < nat_rs + 8);
    if (active) {
      f32x16 s0, s1;
#pragma unroll
      for (int i = 0; i < 16; ++i) { s0[i] = 0.f; s1[i] = 0.f; }
#pragma unroll
      for (int ds = 0; ds < NDS; ++ds) { const bf16x8 a0 = *(const bf16x8*)(buf + r * L::KP + (16 * ds + 8 * h) * 2), a1 = *(const bf16x8*)(buf + (32 + r) * L::KP + (16 * ds + 8 * h) * 2);
        s0 = dev_mfma32(a0, qf[ds], s0); s1 = dev_mfma32(a1, qf[ds], s1); }
      float mx = -1.0e30f;
      if (NAT && cur.kr >= 0) {
#pragma unroll
        for (int i = 0; i < 16; ++i) { float x0 = s0[i] * sc, x1 = s1[i] * sc;
          const int k0 = crow(i, h), k1 = 32 + k0; const float* brow = btab + (cur.kr - nat_qi + 7) * 31 + 15 - qc;
          x0 = (k0 >= cs && k0 < cs + 16) ? x0 + brow[k0] * LOG2E : -1.0e30f; x1 = (k1 >= cs && k1 < cs + 16) ? x1 + brow[k1] * LOG2E : -1.0e30f;
          s0[i] = x0; s1[i] = x1; mx = fmaxf(mx, fmaxf(x0, x1)); }
      } else {
        dev_mfma_settle(s0, s1);
#pragma unroll
        for (int i = 0; i < 16; ++i) mx = dev_max3(mx, s0[i], s1[i]);
        mx *= sc;
      }
      mx = fmaxf(mx, dev_shfl_xor(mx, 32));
      const float m_new = fmaxf(m_run, mx), alpha = dev_exp2(m_run - m_new); const bool grew = m_new > m_run; m_run = m_new;
      if (NAT && cur.kr >= 0) {
#pragma unroll
        for (int i = 0; i < 16; ++i) { s0[i] = dev_exp2(s0[i] - m_new); s1[i] = dev_exp2(s1[i] - m_new); }
      } else {
#pragma unroll
        for (int i = 0; i < 16; ++i) { s0[i] = dev_exp2(s0[i] * sc - m_new); s1[i] = dev_exp2(s1[i] * sc - m_new); }
      }
      if (dev_any(grew)) {
        if (h == 0) scr[r] = alpha;
        dev_wave_fence();
#pragma unroll
        for (int g = 0; g < 4; ++g) { const f32x4 a = *(const f32x4*)(scr + 8 * g + 4 * h);
#pragma unroll
          for (int e = 0; e < 4; ++e) { o0[4 * g + e] *= a[e]; o1[4 * g + e] *= a[e]; lacc[4 * g + e] *= a[e]; } }
        dev_wave_fence();
      }
      const char* vbase = buf + L::KB + (4 * h + ((lane & 15) >> 2)) * ATT_VP + (((lane >> 4) & 1) * 16 + (lane & 3) * 4) * 2;
#pragma unroll
      for (int kvb = 0; kvb < 2; ++kvb)
#pragma unroll
        for (int s = 0; s < 2; ++s) { bf16x8 pa;
#pragma unroll
          for (int j = 0; j < 8; j += 2) { const unsigned w = kvb ? pk2(s1[8 * s + j], s1[8 * s + j + 1]) : pk2(s0[8 * s + j], s0[8 * s + j + 1]); pa[j] = (short)(w & 0xffffu); pa[j + 1] = (short)(w >> 16); }
          lacc = dev_mfma32(pa, ones8, lacc);
          const char* vb = vbase + (32 * kvb + 16 * s) * ATT_VP;
          { const s16x4 lo = dev_tr16(vb), hi = dev_tr16(vb + 8 * ATT_VP); const bf16x8 bv = {lo[0], lo[1], lo[2], lo[3], hi[0], hi[1], hi[2], hi[3]}; o0 = dev_mfma32(pa, bv, o0); }
          { const s16x4 lo = dev_tr16(vb + 64), hi = dev_tr16(vb + 8 * ATT_VP + 64); const bf16x8 bv = {lo[0], lo[1], lo[2], lo[3], hi[0], hi[1], hi[2], hi[3]}; o1 = dev_mfma32(pa, bv, o1); } }
    }
    if (it + 1 < ntiles) { *(u32x4*)(nbuf + kr0 * L::KP + kc0 * 16) = gk0; if (two) *(u32x4*)(nbuf + kr1 * L::KP + kc1 * 16) = gk1; *(u32x4*)(nbuf + L::KB + vr * ATT_VP + vc * 16) = gv; }
    __syncthreads();
    gk0 = hk0; gk1 = hk1; gv = hv;
  }
#pragma unroll
  for (int i = 0; i < 16; ++i) { const float li = dev_rcp(lacc[i]); bf16_t* orow = optr + (size_t)crow(i, h) * opitch;
    orow[r] = (bf16_t)f2bf(o0[i] * li); orow[32 + r] = (bf16_t)f2bf(o1[i] * li); }
  dev_wave_fence();
  __syncthreads();
}

DI f32x16 zero16() { f32x16 z;
#pragma unroll
  for (int i = 0; i < 16; ++i) z[i] = 0.f;
  return z; }
template <int NDS> struct A2L { static constexpr int SLOT = NDS * 2048, K = 0, V = 3 * SLOT, WS = 6 * SLOT, OST = WS + 8 * 256, BYTES = OST + 8 * 4096; };
static_assert(A2L<6>::BYTES <= 131072 - 256, "attn2 LDS map");
#ifdef EMU
typedef const char* a2_lptr;
#define A2_SBAR() do {} while (0)
#define A2_PIN(x) do {} while (0)
template <int N> DI void a2_waitbar() { __syncthreads(); }
DI bf16x8 a2_ld8(a2_lptr q) { return *(const bf16x8*)q; }
DI float a2_swapmax(float m) { return fmaxf(m, dev_shfl_xor(m, 32)); }
DI float a2_swapsum(float m) { return m + dev_shfl_xor(m, 32); }
DI float a2_sub(float a, float b) { return a - b; }
DI float a2_rcp(float x) { return 1.0f / x; }
#else
typedef LAS const char* a2_lptr;
#define A2_SBAR() __builtin_amdgcn_sched_barrier(0)
#define A2_PIN(x) asm volatile("" : "+v"(x))
template <int N> DI void a2_waitbar() { asm volatile("s_waitcnt vmcnt(%0) lgkmcnt(0)\n\ts_barrier" ::"n"(N) : "memory"); }
DI bf16x8 a2_ld8(a2_lptr q) { return *(LAS const bf16x8*)q; }
DI float a2_swapmax(float m) { auto rr = __builtin_amdgcn_permlane32_swap(__float_as_uint(m), __float_as_uint(m), false, false); return __builtin_fmaxf(__uint_as_float(rr[0]), __uint_as_float(rr[1])); }
DI float a2_swapsum(float m) { auto rr = __builtin_amdgcn_permlane32_swap(__float_as_uint(m), __float_as_uint(m), false, false); return __uint_as_float(rr[0]) + __uint_as_float(rr[1]); }
DI float a2_sub(float a, float b) { float r; asm("v_sub_f32_e32 %0, %1, %2" : "=v"(r) : "v"(a), "v"(b)); return r; }
DI float a2_rcp(float x) { return __builtin_amdgcn_rcpf(x); }
#endif
DI s16x4 a2_vtr(a2_lptr q) { return dev_tr16((const void*)q); }

template <int NDS, int THRL, bool HALF = false>
DI void attn2_unit(char* smem, const bf16_t* qptr, int qpitch, bf16_t* optr, int opitch, const bf16_t* kcol, int kpitch, const bf16_t* vcol, int vpitch, int b, int half = 0, float* stats = nullptr) {
  const int tid = TID, lane = tid & 63, r32 = lane & 31, hi = lane >> 5; const int wid = dev_uniform(tid >> 6);
  typedef A2L<NDS> L; constexpr int A2_SLOT = L::SLOT, KN = NDS == 4 ? 1 : 2;
  constexpr int NT = HALF ? NK / 128 : NK / 64; static_assert((NK / 64) % 4 == 0 && NK / 128 >= 8 && (NDS == 4 || NDS == 6), "tile count / head dim"); const int t0 = HALF ? half * NT : 0;
  auto mrow = [&](int tt) { const int t = tt + t0; return t < T / 64 ? b * T + 64 * t : TL + b * C + 64 * (t - T / 64); };
  float* wsf = (float*)(smem + L::WS) + wid * 64;
  const bf16_t* ksrc = kcol + (size_t)lane * kpitch + wid * 8;
  const bf16_t* vsrc = vcol + (size_t)(16 * (wid & 3) + (lane >> 2)) * vpitch + (wid >> 2) * 32 + (lane & 3) * 8;
  char* kdst = smem + L::K + wid * 1024; char* vdst = smem + L::V + wid * 1024;
  const bf16_t* ksrc2 = kcol + (size_t)(32 * (wid & 1) + r32) * kpitch + (8 + (wid >> 1)) * 8; char* kdst2 = smem + L::K + (8 + (wid >> 1)) * 1024 + (wid & 1) * 512;
#define DMA_K(t, slot) do { dev_glds16(ksrc + (size_t)mrow(t) * kpitch, kdst + (slot)); if (NDS == 6) { if (lane < 32) dev_glds16(ksrc2 + (size_t)mrow(t) * kpitch, kdst2 + (slot)); } } while (0)
#define DMA_V(t, slot) dev_glds16(vsrc + (size_t)mrow(t) * vpitch, vdst + (slot))
  const a2_lptr shm3 = (a2_lptr)smem; const a2_lptr kp0 = shm3 + L::K + hi * 1024 + r32 * 16; const a2_lptr vp0 = shm3 + L::V + ((lane >> 4) & 1) * 32 + (lane & 3) * 8 + (4 * hi + ((lane & 15) >> 2)) * 64;
  bf16x8 kf[2 * NDS];
  DMA_K(0, 0); DMA_V(0, 0); DMA_K(1, A2_SLOT);
  bf16x8 qr[NDS];
#pragma unroll
  for (int d0 = 0; d0 < NDS; ++d0) qr[d0] = *(const bf16x8*)(qptr + (size_t)r32 * qpitch + d0 * 16 + hi * 8);
  float mhat = 0.f, l_reg = 0.f; f32x16 o[2]; o[0] = zero16(); o[1] = zero16(); f32x16 negm = zero16(); A2_PIN(negm);
  bool resc = false;
#define RESC() do { if (resc) { dev_wave_fence(); _Pragma("unroll") for (int d_ = 0; d_ < 2; ++d_) _Pragma("unroll") for (int r = 0; r < 16; ++r) o[d_][r] *= wsf[crow(r, hi)]; } } while (0)
  f32x16 pA0, pA1, pB0, pB1;
  int sl_prev = 0, sl_cur = 0, sl_next = A2_SLOT;
#define ROT() do { sl_prev = sl_cur; sl_cur = sl_next; sl_next = (sl_next == 2 * A2_SLOT) ? 0 : sl_next + A2_SLOT; } while (0)
#define KLD2(kp, j) do { kf[2 * (j)] = a2_ld8((kp) + (j) * 2048); kf[2 * (j) + 1] = a2_ld8((kp) + (j) * 2048 + 512); } while (0)
  DMA_K(2, 2 * A2_SLOT);
  a2_waitbar<1 + 2 * KN>();
#pragma unroll
  for (int j = 0; j < NDS; ++j) KLD2(kp0, j);
  pA0 = dev_mfma32(kf[0], qr[0], negm); pA1 = dev_mfma32(kf[1], qr[0], negm);
#pragma unroll
  for (int d0 = 1; d0 < NDS; ++d0) { pA0 = dev_mfma32(kf[2 * d0], qr[d0], pA0); pA1 = dev_mfma32(kf[2 * d0 + 1], qr[d0], pA1); }
  dev_mfma_settle(pA0, pA1);
  { float a = dev_max3(pA0[0], pA0[1], pA1[0]), c = dev_max3(pA0[2], pA0[3], pA1[1]); a = dev_max3(a, pA1[2], pA1[3]);
#pragma unroll
    for (int r = 4; r < 16; r += 4) { a = dev_max3(a, pA0[r], pA0[r + 1]); c = dev_max3(c, pA0[r + 2], pA0[r + 3]); a = dev_max3(a, pA1[r], pA1[r + 1]); c = dev_max3(c, pA1[r + 2], pA1[r + 3]); }
    const float dl = a2_swapmax(fmaxf(a, c)); mhat = dl;
#pragma unroll
    for (int r = 0; r < 16; ++r) { pA0[r] = dev_exp2(a2_sub(pA0[r], dl)); pA1[r] = dev_exp2(a2_sub(pA1[r], dl)); }
#pragma unroll
    for (int r = 0; r < 16; ++r) negm[r] = -mhat;
    A2_PIN(negm); }
  a2_waitbar<0>();
  DMA_K(3, 0); DMA_V(1, A2_SLOT);
  ROT();
#pragma unroll
  for (int j = 0; j < NDS; ++j) KLD2(kp0 + sl_cur, j);
  a2_waitbar<KN + 1>();
  s16x4 vlo[8], vhi[8]; u32x4 pw0, pw1, pw2, pw3;
#define PKW(P, B) pk2(P[B], P[(B) + 1])
#define PAF(k) __builtin_bit_cast(bf16x8, pw##k)
#define VFR(i) (bf16x8){vlo[i][0], vlo[i][1], vlo[i][2], vlo[i][3], vhi[i][0], vhi[i][1], vhi[i][2], vhi[i][3]}
#define MX3(a, b, c) __builtin_fmaxf(__builtin_fmaxf((a), (b)), (c))
#define GAPA(MF, A0, A1, A2, A3, W0, W1, PW) do { MF; sacc += A0; sacc += A1; sacc += A2; sacc += A3; A2_PIN(sacc); W0; W1; A2_PIN(PW); A2_SBAR(); } while (0)
#define GAPB(MF, X, B) do { MF; X[B] = dev_exp2(X[B]); X[(B) + 1] = dev_exp2(X[(B) + 1]); X[(B) + 2] = dev_exp2(X[(B) + 2]); X[(B) + 3] = dev_exp2(X[(B) + 3]); A2_PIN(X); A2_SBAR(); } while (0)
#define VRD(i) do { vlo[i] = a2_vtr(vp_ + (((i) >> 2) * 4096 + ((i) & 3) * 1024)); vhi[i] = a2_vtr(vp_ + (((i) >> 2) * 4096 + ((i) & 3) * 1024 + 512)); } while (0)
#define KRD(G, j) do { if (G) { KLD2(kp0 + sl_next, j); A2_SBAR(); } } while (0)
#define STEP(C0, C1, P0, P1, t, GK, GV, GL) do { A2_SBAR(); \
    const a2_lptr vp_ = vp0 + sl_prev; \
    VRD(0); A2_SBAR(); float sacc = (P0[0] + P0[1]); \
    GAPA(C0 = dev_mfma32(kf[0], qr[0], negm), P0[2], P0[3], P0[4], P0[5], pw0[0] = PKW(P0, 0), pw0[1] = PKW(P0, 2), pw0); \
    VRD(4); A2_SBAR(); GAPA(C1 = dev_mfma32(kf[1], qr[0], negm), P0[6], P0[7], P0[8], P0[9], pw0[2] = PKW(P0, 4), pw0[3] = PKW(P0, 6), pw0); \
    VRD(1); A2_SBAR(); GAPA(C0 = dev_mfma32(kf[2], qr[1], C0), P0[10], P0[11], P0[12], P0[13], pw1[0] = PKW(P0, 8), pw1[1] = PKW(P0, 10), pw1); \
    VRD(5); A2_SBAR(); GAPA(C1 = dev_mfma32(kf[3], qr[1], C1), P0[14], P0[15], P1[0], P1[1], pw1[2] = PKW(P0, 12), pw1[3] = PKW(P0, 14), pw1); \
    VRD(2); A2_SBAR(); GAPA(C0 = dev_mfma32(kf[4], qr[2], C0), P1[2], P1[3], P1[4], P1[5], pw2[0] = PKW(P1, 0), pw2[1] = PKW(P1, 2), pw2); \
    VRD(6); A2_SBAR(); GAPA(C1 = dev_mfma32(kf[5], qr[2], C1), P1[6], P1[7], P1[8], P1[9], pw2[2] = PKW(P1, 4), pw2[3] = PKW(P1, 6), pw2); \
    VRD(3); A2_SBAR(); GAPA(C0 = dev_mfma32(kf[6], qr[3], C0), P1[10], P1[11], P1[12], P1[13], pw3[0] = PKW(P1, 8), pw3[1] = PKW(P1, 10), pw3); \
    VRD(7); A2_SBAR(); GAPA(C1 = dev_mfma32(kf[7], qr[3], C1), P1[14], P1[15], 0.f, 0.f, pw3[2] = PKW(P1, 12), pw3[3] = PKW(P1, 14), pw3); \
    if constexpr (NDS == 6) { C0 = dev_mfma32(kf[8], qr[4], C0); A2_SBAR(); C1 = dev_mfma32(kf[9], qr[4], C1); A2_SBAR(); C0 = dev_mfma32(kf[10], qr[5], C0); A2_SBAR(); C1 = dev_mfma32(kf[11], qr[5], C1); A2_SBAR(); } \
    l_reg += sacc; \
    if (GK) { DMA_K((t) + 3, sl_cur); } if (GV) { DMA_V((t) + 1, sl_next); } \
    { float a = MX3(C0[0], C0[1], C1[0]), c_ = MX3(C0[2], C0[3], C1[1]); a = MX3(a, C1[2], C1[3]); \
      _Pragma("unroll") for (int r = 4; r < 16; r += 4) { a = MX3(a, C0[r], C0[r + 1]); c_ = MX3(c_, C0[r + 2], C0[r + 3]); a = MX3(a, C1[r], C1[r + 1]); c_ = MX3(c_, C1[r + 2], C1[r + 3]); } \
      const float rm = a2_swapmax(__builtin_fmaxf(a, c_)); \
      resc = false; \
      if (__builtin_expect(dev_any(rm > (float)THRL), 0)) { const float dl = __builtin_fmaxf(rm, 0.f); mhat += dl; \
        _Pragma("unroll") for (int r = 0; r < 16; ++r) { C0[r] -= dl; C1[r] -= dl; } \
        _Pragma("unroll") for (int r = 0; r < 16; ++r) negm[r] = -mhat; \
        A2_PIN(negm); \
        const float f = dev_exp2(-dl); l_reg *= f; if (hi == 0) wsf[r32] = f; resc = true; } } \
    A2_SBAR(); \
    GAPB(o[0] = dev_mfma32(PAF(0), VFR(0), o[0]), C0, 0); \
    GAPB(o[1] = dev_mfma32(PAF(0), VFR(4), o[1]), C0, 4); \
    KRD(GL, 0); GAPB(o[0] = dev_mfma32(PAF(1), VFR(1), o[0]), C0, 8); \
    KRD(GL, 1); GAPB(o[1] = dev_mfma32(PAF(1), VFR(5), o[1]), C0, 12); \
    KRD(GL, 2); GAPB(o[0] = dev_mfma32(PAF(2), VFR(2), o[0]), C1, 0); \
    KRD(GL, 3); GAPB(o[1] = dev_mfma32(PAF(2), VFR(6), o[1]), C1, 4); \
    if constexpr (NDS == 6) { KRD(GL, 4); } GAPB(o[0] = dev_mfma32(PAF(3), VFR(3), o[0]), C1, 8); \
    if constexpr (NDS == 6) { KRD(GL, 5); } GAPB(o[1] = dev_mfma32(PAF(3), VFR(7), o[1]), C1, 12); \
  } while (0)
  int t = 1;
  for (; t + 5 < NT; t += 2) {
    STEP(pB0, pB1, pA0, pA1, t, true, true, true);     a2_waitbar<KN + 1>(); RESC(); ROT();
    STEP(pA0, pA1, pB0, pB1, t + 1, true, true, true); a2_waitbar<KN + 1>(); RESC(); ROT();
  }
#define ENDW(tt) do { if ((tt) + 3 < NT) { a2_waitbar<KN + 1>(); } else if ((tt) + 2 < NT) { a2_waitbar<1>(); } else { a2_waitbar<0>(); } } while (0)
  for (; t + 1 < NT; t += 2) {
    STEP(pB0, pB1, pA0, pA1, t, (t + 3 < NT), (t + 1 < NT), (t + 1 < NT));         ENDW(t);     RESC(); ROT();
    STEP(pA0, pA1, pB0, pB1, t + 1, (t + 4 < NT), (t + 2 < NT), (t + 2 < NT));     ENDW(t + 1); RESC(); ROT();
  }
  STEP(pB0, pB1, pA0, pA1, NT - 1, false, false, false); RESC();
  { float sacc = pB0[0] + pB0[1];
#pragma unroll
    for (int r = 2; r < 16; ++r) sacc += pB0[r];
#pragma unroll
    for (int r = 0; r < 16; ++r) sacc += pB1[r];
    l_reg += sacc;
    pw0 = (u32x4){PKW(pB0, 0), PKW(pB0, 2), PKW(pB0, 4), PKW(pB0, 6)}; pw1 = (u32x4){PKW(pB0, 8), PKW(pB0, 10), PKW(pB0, 12), PKW(pB0, 14)};
    pw2 = (u32x4){PKW(pB1, 0), PKW(pB1, 2), PKW(pB1, 4), PKW(pB1, 6)}; pw3 = (u32x4){PKW(pB1, 8), PKW(pB1, 10), PKW(pB1, 12), PKW(pB1, 14)};
    const a2_lptr vp_ = vp0 + sl_cur;
#pragma unroll
    for (int i = 0; i < 8; ++i) VRD(i);
    o[0] = dev_mfma32(PAF(0), VFR(0), o[0]); o[1] = dev_mfma32(PAF(0), VFR(4), o[1]); o[0] = dev_mfma32(PAF(1), VFR(1), o[0]); o[1] = dev_mfma32(PAF(1), VFR(5), o[1]);
    o[0] = dev_mfma32(PAF(2), VFR(2), o[0]); o[1] = dev_mfma32(PAF(2), VFR(6), o[1]); o[0] = dev_mfma32(PAF(3), VFR(3), o[0]); o[1] = dev_mfma32(PAF(3), VFR(7), o[1]); }
  l_reg = a2_swapsum(l_reg);
  if (hi == 0) { wsf[32 + r32] = l_reg; if (HALF) { stats[2 * r32] = mhat; stats[2 * r32 + 1] = l_reg; } }
  dev_wave_fence();
  float rli[16];
#pragma unroll
  for (int r = 0; r < 16; ++r) rli[r] = a2_rcp(wsf[32 + crow(r, hi)]);
  { bf16_t* stg = (bf16_t*)(smem + L::OST) + wid * 2048;
#pragma unroll
    for (int r = 0; r < 16; ++r) { const int orow = crow(r, hi);
#pragma unroll
      for (int d0 = 0; d0 < 2; ++d0) stg[orow * 64 + d0 * 32 + r32] = (bf16_t)f2bf_hw(o[d0][r] * rli[r]); }
    dev_wave_fence();
#pragma unroll
    for (int i = 0; i < 4; ++i) { const int row = i * 8 + (lane >> 3), ch = lane & 7; *(u32x4*)(optr + (size_t)row * opitch + ch * 8) = *(const u32x4*)(stg + row * 64 + ch * 8); } }
  dev_bar();
#undef DMA_K
#undef DMA_V
#undef RESC
#undef ROT
#undef KLD2
#undef PKW
#undef PAF
#undef VFR
#undef MX3
#undef GAPA
#undef GAPB
#undef VRD
#undef KRD
#undef STEP
#undef ENDW
}

constexpr int SC_CH = 16, SC_RING = 4, SC_CHB = SC_CH * 1536, SC_YB = SC_RING * SC_CHB;
static_assert(NK % SC_CH == 0 && NK / SC_CH >= 4 && SC_YB + 2 * SC_CH * 32 * 4 <= 131072 - 256 && ATT_LDS <= 131072 - 256, "scan LDS map");
DI int scan_kpos(int s, int d) { return s < C ? T + (d == 0 ? s : C - 1 - s) : (d == 0 ? s - C : T - 1 - (s - C)); }
constexpr int CK = 32, NCHK = NK / CK, U_PREP = 2 * NB * 4 * NCHK;
constexpr int SB_AS = 0, SB_AY = 8192, SB_GS = 12288, SB_GY = 16384, SB_VT = 18432, SB_BYTES = CK * 768;
static_assert(NK % CK == 0 && C % CK == 0 && SB_VT + 4096 <= SB_BYTES, "chunking");
constexpr int PW_REC = 896  , PW_RAW = 0, PW_KC = CK * PW_REC, PW_RT = PW_KC + 4608, PW_BT = PW_RT + 4608, PW_KT = PW_BT + 4608, PW_BHT = PW_KT + 4608, PW_KHT = PW_BHT + 5120, PW_VT = PW_KHT + 5120, PW_GC = PW_VT + 4096,
              PW_KCT = PW_GC + 256, PW_J = PW_KCT + 5120  , PW_TT = PW_J + 4 * 2560  ,
              PW_WT = PW_TT + 2560  , PW_MKJ = PW_WT + 2560  , PW_NBT = PW_MKJ + 2560, PW_X16 = PW_NBT + 2560, PW_WT8 = PW_X16 + 7680  , PW_END = PW_WT8 + 2048;
static_assert(PW_END <= 131072 - 256, "prep LDS map");
DI int chunk_kmin(int c, int d) { const int k0 = scan_kpos(c * CK, d), k1 = scan_kpos(c * CK + CK - 1, d); return k0 < k1 ? k0 : k1; }
DI bf16x8 pack8(const f32x16& x, int s) { u32x4 w;
#pragma unroll
  for (int j = 0; j < 4; ++j) w[j] = pk2(x[8 * s + 2 * j], x[8 * s + 2 * j + 1]);
  return __builtin_bit_cast(bf16x8, w); }
DI bf16x8 pack8lo(const f32x16& x, int s) { u32x4 w;
#pragma unroll
  for (int j = 0; j < 4; ++j) { const float a = x[8 * s + 2 * j], b = x[8 * s + 2 * j + 1]; w[j] = pk2(a - bf2f(f2bf_hw(a)), b - bf2f(f2bf_hw(b))); }
  return __builtin_bit_cast(bf16x8, w); }
DI bf16x8 ld2x8(const bf16_t* p0, const bf16_t* p1) { const u32x2 a = *(const u32x2*)p0, b = *(const u32x2*)p1; return __builtin_bit_cast(bf16x8, (u32x4){a.x, a.y, b.x, b.y}); }

struct PrepDesc { int sin[4], pofs[4]; };
constexpr int PREP_NP = CK * (PW_REC / 16);
static_assert(PREP_NP == 4 * 448, "prep DMA pieces");
DI void prep_desc(int tid, PrepDesc& ds) {
#pragma unroll
  for (int i = 0; i < 4; ++i) { const int idx = i * 448 + (tid - 64), sin = idx / 56, piece = idx % 56; ds.sin[i] = sin; ds.pofs[i] = piece < 24 ? piece * 16 : (piece - 24) * 16 + (1 << 30); }
}
DI void prep_issue(const Params& p, int unit, int tid, const PrepDesc& ds, char* smem) {
  const int wave = tid >> 6; if (wave == 0) return;
  const int chain = dev_uniform(unit / NCHK), c = dev_uniform(unit % NCHK); const int d = chain / (NB * 4), b = (chain / 4) % NB, hd = chain % 4;
  const char* scs = (const char*)(wsp<bf16_t>(p, A_SCS) + (size_t)(b * 4 + hd) * NK * 192); const char* scd = (const char*)(wsp<float>(p, A_SCD) + (size_t)((d * NB + b) * 4 + hd) * NK * 192);
  const long k0 = (long)scan_kpos(c * CK, d); const int sgn = d == 0 ? 1 : -1;
#pragma unroll
  for (int i = 0; i < 4; ++i) { const bool isd = ((ds.pofs[i] >> 30) & 1) != 0; const long rec = k0 + sgn * ds.sin[i]; const char* src = (isd ? scd + rec * 768 : scs + rec * 384) + (ds.pofs[i] & 0xffff);
    dev_glds16(src, smem + PW_RAW + (i * 448 + (wave - 1) * 64) * 16); }
}
DI void prep_chunk(const Params& p, int l, int unit, int next_unit, bool first, const PrepDesc& ds, char* smem) {
  const int tid = TID, lane = tid & 63, wave = tid >> 6, r = lane & 31, h = lane >> 5; const int chain = unit / NCHK, c = unit % NCHK; const int d = chain / (NB * 4), b = (chain / 4) % NB, hd = chain % 4;
  float* scd = wsp<float>(p, A_SCD) + (size_t)((d * NB + b) * 4 + hd) * NK * 192;
  { const int wu = dev_uniform(wave); if (first) dev_vmwait<0>(); else if (wu == 3) dev_vmwait<5>(); else if (wu < 3) dev_vmwait<3>(); else dev_vmwait<2>(); }
  dev_bar();
  const char* raw = smem + PW_RAW;
  for (int rep_b = 0; rep_b < (PROBE_REP == 30 ? 2 : 1); ++rep_b)
  { const int k = tid & 63, t0 = dev_uniform(4 * (tid >> 6)); float Pm0, Pt[4]; const float rkk = p.in(I_RK)[l * 256 + hd * 64 + k];
    const float* lw = (const float*)(raw + 384 + k * 4);
    float l4[4];
#pragma unroll
    for (int q = 0; q < 4; ++q) l4[q] = lw[(t0 + q) * (PW_REC / 4)];
    float* wt = (float*)(smem + PW_WT8);
    wt[wave * 64 + k] = (l4[0] + l4[1]) + (l4[2] + l4[3]);
    dev_bar();
    float base = 0.f, P = 0.f;
#pragma unroll
    for (int w = 0; w < 8; ++w) { const float x = wt[w * 64 + k]; P += x; base += (w < wave) ? x : 0.f; }
    Pm0 = base; Pt[0] = base + l4[0]; Pt[1] = Pt[0] + l4[1]; Pt[2] = Pt[1] + l4[2]; Pt[3] = Pt[2] + l4[3];
    const float gc = dev_exp2(P); float em = dev_exp2(Pm0);
    float bh4[4], kh4[4], vv4[4], kc4[4];
#pragma unroll
    for (int q = 0; q < 4; ++q) { const int t = t0 + q; const bf16_t* rec = (const bf16_t*)(raw + t * PW_REC) + k;
      const float rr = bf2f(rec[0]), vv = bf2f(rec[64]), kk = bf2f(rec[128]), bb = bf2f(rec[320]), kd = bf2f(rec[384]);
      const float et = dev_exp2(Pt[q]), ei = dev_exp2(-Pt[q]), ec = gc * ei;
      ((bf16_t*)(smem + PW_KC))[t * 72 + k] = (bf16_t)f2bf_hw(kk * em); ((bf16_t*)(smem + PW_RT))[t * 72 + k] = (bf16_t)f2bf_hw(rr * et);
      ((bf16_t*)(smem + PW_BT))[t * 72 + k] = (bf16_t)f2bf_hw(bb * ei); ((bf16_t*)(smem + PW_KT))[t * 72 + k] = (bf16_t)f2bf_hw(kd * ei);
      bh4[q] = bb * ec; kh4[q] = kd * ec; vv4[q] = vv; kc4[q] = kk * em;
      const float rho = wave_sum(rr * kd * rkk);
      if (lane == 0) wsp<float>(p, A_RHO)[((size_t)d * MT + kpos_row(b, scan_kpos(c * CK + t, d))) * 4 + hd] = rho;
      em = et; }
    { u32x2 w; w.x = pk2(bh4[0], bh4[1]); w.y = pk2(bh4[2], bh4[3]); *(u32x2*)((bf16_t*)(smem + PW_BHT) + k * 40 + t0) = w;
      w.x = pk2(kh4[0], kh4[1]); w.y = pk2(kh4[2], kh4[3]); *(u32x2*)((bf16_t*)(smem + PW_KHT) + k * 40 + t0) = w;
      w.x = pk2(vv4[0], vv4[1]); w.y = pk2(vv4[2], vv4[3]); *(u32x2*)((bf16_t*)(smem + PW_VT) + k * 32 + t0) = w;
      w.x = pk2(kc4[0], kc4[1]); w.y = pk2(kc4[2], kc4[3]); *(u32x2*)((bf16_t*)(smem + PW_KCT) + k * 40 + t0) = w; }
    if (t0 == 0) ((float*)(smem + PW_GC))[k] = gc; }
  dev_bar();
  if (next_unit < U_PREP) prep_issue(p, next_unit, tid, ds, smem);
  f32x16 nk = zero16();
  auto mm64 = [&](const bf16_t* X, const bf16_t* Y) { f32x16 acc = zero16();
#pragma unroll
    for (int s = 0; s < 4; ++s) acc = dev_mfma32(*(const bf16x8*)(X + r * 72 + 16 * s + 8 * h), *(const bf16x8*)(Y + r * 72 + 16 * s + 8 * h), acc);
    return acc; };
  auto wr_rows = [&](int off, const f32x16& a) { bf16_t* dst = (bf16_t*)(smem + off) + r * 40;
#pragma unroll
    for (int g = 0; g < 4; ++g) { u32x2 w; w.x = pk2(a[4 * g], a[4 * g + 1]); w.y = pk2(a[4 * g + 2], a[4 * g + 3]); *(u32x2*)(dst + 8 * g + 4 * h) = w; } };
  auto aform = [&](int off, int s) { const bf16_t* q = (const bf16_t*)(smem + off) + r * 40 + 16 * s + 4 * h; return ld2x8(q, q + 8); };
  const bf16_t *KC = (const bf16_t*)(smem + PW_KC), *RT = (const bf16_t*)(smem + PW_RT), *BT = (const bf16_t*)(smem + PW_BT), *KT = (const bf16_t*)(smem + PW_KT);
  if (wave == 0) {
    f32x16 M = mm64(BT, KC), MT = mm64(KC, BT);
#pragma unroll
    for (int i = 0; i < 16; ++i) { M[i] = crow(i, h) < r ? M[i] : 0.f; MT[i] = crow(i, h) > r ? MT[i] : 0.f; }
    wr_rows(PW_J, MT);
    wr_rows(PW_TT, M);
    f32x16 Pk = M, PkT = MT, R;
#pragma unroll
    for (int i = 0; i < 16; ++i) R[i] = (crow(i, h) == r ? 1.f : 0.f) - M[i];
#pragma unroll
    for (int lev = 1; lev < 5; ++lev) { dev_wave_fence();
      f32x16 N = zero16(), NT = zero16(), Q = zero16();
#pragma unroll
      for (int s = 0; s < 2; ++s) { N = dev_mfma32(aform(PW_J + (lev - 1) * 2560, s), pack8(Pk, s), N); NT = dev_mfma32(aform(PW_TT, s), pack8(PkT, s), NT);
        if (lev > 1) Q = dev_mfma32(aform(PW_J + (lev - 1) * 2560, s), pack8(R, s), Q); }
      if (lev > 1) {
#pragma unroll
        for (int i = 0; i < 16; ++i) R[i] += Q[i]; }
      Pk = N; PkT = NT; dev_wave_fence();
      wr_rows(PW_J + (lev & 3) * 2560, PkT); if (lev < 4) wr_rows(PW_TT, Pk); }
    { dev_wave_fence(); f32x16 Q = zero16();
#pragma unroll
      for (int s = 0; s < 2; ++s) Q = dev_mfma32(aform(PW_J, s), pack8(R, s), Q);
#pragma unroll
      for (int i = 0; i < 16; ++i) R[i] += Q[i]; }
    wr_rows(PW_WT, R);
  } else if (wave == 1) { f32x16 MkT = mm64(KC, KT);
#pragma unroll
    for (int i = 0; i < 16; ++i) MkT[i] = crow(i, h) > r ? MkT[i] : 0.f;
    wr_rows(PW_MKJ, MkT);
  } else if (wave == 2) { f32x16 Nb = mm64(BT, RT);
#pragma unroll
    for (int i = 0; i < 16; ++i) Nb[i] = crow(i, h) <= r ? Nb[i] : 0.f;
    wr_rows(PW_NBT, Nb);
  } else if (wave == 3) { nk = mm64(KT, RT);
#pragma unroll
    for (int i = 0; i < 16; ++i) nk[i] = crow(i, h) <= r ? nk[i] : 0.f; }
  dev_bar();
  if (wave < 3) { f32x16 Q = zero16(); const bf16_t* WT = (const bf16_t*)(smem + PW_WT) + r * 40; const bf16_t* Bsrc = wave < 2 ? (const bf16_t*)(smem + PW_KCT) + (32 * wave + r) * 40 : (const bf16_t*)(smem + PW_MKJ) + r * 40;
#pragma unroll
    for (int s = 0; s < 2; ++s) Q = dev_mfma32(*(const bf16x8*)(WT + 16 * s + 8 * h), *(const bf16x8*)(Bsrc + 16 * s + 8 * h), Q);
    wr_rows(PW_X16 + (wave < 2 ? 32 * wave : 64) * 80, Q); }
  dev_bar();
  { char* dst = (char*)(scd + (size_t)chunk_kmin(c, d) * 192); const bf16_t* X16 = (const bf16_t*)(smem + PW_X16); const bf16_t* BHT = (const bf16_t*)(smem + PW_BHT); const bf16_t* NBT = (const bf16_t*)(smem + PW_NBT);
    if (wave < 4) { const int sb = wave & 1, kb = wave >> 1;
      f32x16 z = zero16();
#pragma unroll
      for (int s = 0; s < 2; ++s) z = dev_mfma32(*(const bf16x8*)(X16 + (32 * sb + r) * 40 + 16 * s + 8 * h), *(const bf16x8*)(BHT + (32 * kb + r) * 40 + 16 * s + 8 * h), z);
      const float gc = ((const float*)(smem + PW_GC))[32 * kb + r];
#pragma unroll
      for (int i = 0; i < 16; ++i) z[i] = ((32 * sb + crow(i, h)) == (32 * kb + r) ? gc : 0.f) - z[i];
#pragma unroll
      for (int s = 0; s < 2; ++s) *(bf16x8*)(dst + SB_AS + (((kb * 2 + sb) * 2 + s) * 64 + lane) * 16) = pack8(z, s); }
    else if (wave < 6) { const int sb = wave - 4;
      f32x16 z = zero16();
#pragma unroll
      for (int s = 0; s < 2; ++s) z = dev_mfma32(*(const bf16x8*)(X16 + (32 * sb + r) * 40 + 16 * s + 8 * h), *(const bf16x8*)(NBT + r * 40 + 16 * s + 8 * h), z);
      const bf16_t* rt = (const bf16_t*)(smem + PW_RT) + r * 72 + 32 * sb;
#pragma unroll
      for (int g = 0; g < 4; ++g) { const f32x4 rv = ldp4(rt, 8 * g + 4 * h);
#pragma unroll
        for (int e = 0; e < 4; ++e) z[4 * g + e] = rv[e] - z[4 * g + e]; }
#pragma unroll
      for (int s = 0; s < 2; ++s) *(bf16x8*)(dst + SB_AY + ((sb * 2 + s) * 64 + lane) * 16) = pack8(z, s); }
    else { const int kb = wave - 6;
      f32x16 z = zero16();
#pragma unroll
      for (int s = 0; s < 2; ++s) z = dev_mfma32(*(const bf16x8*)(X16 + (64 + r) * 40 + 16 * s + 8 * h), *(const bf16x8*)(BHT + (32 * kb + r) * 40 + 16 * s + 8 * h), z);
      const bf16_t* kh = (const bf16_t*)(smem + PW_KHT) + (32 * kb + r) * 40;
#pragma unroll
      for (int g = 0; g < 4; ++g) { const f32x4 kv = ldp4(kh, 8 * g + 4 * h);
#pragma unroll
        for (int e = 0; e < 4; ++e) z[4 * g + e] = kv[e] - z[4 * g + e]; }
#pragma unroll
      for (int s = 0; s < 2; ++s) *(bf16x8*)(dst + SB_GS + ((kb * 2 + s) * 64 + lane) * 16) = pack8(z, s); }
    if (wave == 3) {
      f32x16 z = zero16();
#pragma unroll
      for (int s = 0; s < 2; ++s) z = dev_mfma32(*(const bf16x8*)(X16 + (64 + r) * 40 + 16 * s + 8 * h), *(const bf16x8*)(NBT + r * 40 + 16 * s + 8 * h), z);
#pragma unroll
      for (int i = 0; i < 16; ++i) z[i] = nk[i] - z[i];
#pragma unroll
      for (int s = 0; s < 2; ++s) *(bf16x8*)(dst + SB_GY + (s * 64 + lane) * 16) = pack8(z, s); }
    if (tid < 256) *(u32x4*)(dst + SB_VT + tid * 16) = *(const u32x4*)(smem + PW_VT + tid * 16); }
  dev_bar();
}
DI void phase_scan_prep(const Params& p, int l, char* smem) { const int G = (int)gridDim.x; int u = (int)blockIdx.x; if (u >= U_PREP) return; PrepDesc ds; prep_desc(TID, ds); prep_issue(p, u, TID, ds, smem);
  for (bool first = true; u < U_PREP; u += G, first = false) prep_chunk(p, l, u, u + G, first, ds, smem);
  dev_vmwait<0>(); dev_bar(); }

constexpr int SQ_RING = 4, SQ_YB = SQ_RING * SB_BYTES;
static_assert(SQ_YB + 2 * CK * 64 * 4 <= 131072 - 256, "scan LDS map");
DI void scan_chain(const Params& p, int chain, char* smem) {
  const int tid = TID, lane = tid & 63, wave = tid >> 6, r = lane & 31, h = lane >> 5; const int d = chain / (NB * 4), b = (chain / 4) % NB, hd = chain % 4;
  const char* scd = (const char*)(wsp<float>(p, A_SCD) + (size_t)((d * NB + b) * 4 + hd) * NK * 192);
  bf16_t* ys = wsp<bf16_t>(p, A_YS) + (size_t)d * MT * 256 + hd * 64; const int sgn = d == 0 ? 1 : -1;
  const int th = tid - 128;
  auto issue = [&](int c) { const char* src = scd + (size_t)dev_uniform(chunk_kmin(c, d)) * 768 + th * 16; char* dst = smem + (c % SQ_RING) * SB_BYTES + (wave - 2) * 1024;
#pragma unroll
    for (int i = 0; i < 4; ++i) dev_glds16(src + i * 6144, dst + i * 6144); };
  auto store_y = [&](int c) { const int m0 = dev_uniform(kpos_row(b, scan_kpos(c * CK, d)));
#pragma unroll
    for (int i = 0; i < 6; ++i) { const int e = (i * 384 + th) & (CK * 64 - 1), st = e >> 6, row = e & 63;
      ys[(size_t)(m0 + sgn * st) * 256 + row] = (bf16_t)f2bf_hw(((const float*)(smem + SQ_YB))[((c & 1) * CK + st) * 64 + row]); } };
  if (wave >= 2) { issue(0); issue(1); issue(2); }
  f32x16 T0 = zero16(), T1 = zero16();
  for (int c = 0; c < NCHK; ++c) {
    if (wave >= 2) { if (c + 2 < NCHK) dev_vmwait<8>(); else dev_vmwait<0>(); }
    dev_bar();
    if (wave < 2) { const int vb = wave; const char* blk = smem + (c % SQ_RING) * SB_BYTES; const bf16_t* vt = (const bf16_t*)(blk + SB_VT) + (32 * vb + r) * 32;
      f32x16 N0 = zero16(), N1 = zero16(), Yt = zero16();
#pragma unroll
      for (int s = 0; s < 2; ++s) { const bf16x8 vf = ld2x8(vt + 16 * s + 4 * h, vt + 16 * s + 8 + 4 * h);
        N0 = dev_mfma32(*(const bf16x8*)(blk + SB_GS + ((0 * 2 + s) * 64 + lane) * 16), vf, N0); N1 = dev_mfma32(*(const bf16x8*)(blk + SB_GS + ((1 * 2 + s) * 64 + lane) * 16), vf, N1);
        Yt = dev_mfma32(*(const bf16x8*)(blk + SB_GY + (s * 64 + lane) * 16), vf, Yt); }
#pragma unroll
      for (int sb = 0; sb < 2; ++sb)
#pragma unroll
        for (int s = 0; s < 2; ++s) { const bf16x8 bh = pack8(sb ? T1 : T0, s), bl = pack8lo(sb ? T1 : T0, s);
          const bf16x8 a0 = *(const bf16x8*)(blk + SB_AS + (((0 * 2 + sb) * 2 + s) * 64 + lane) * 16), a1 = *(const bf16x8*)(blk + SB_AS + (((1 * 2 + sb) * 2 + s) * 64 + lane) * 16), ay = *(const bf16x8*)(blk + SB_AY + ((sb * 2 + s) * 64 + lane) * 16);
          N0 = dev_mfma32(a0, bh, N0); N0 = dev_mfma32(a0, bl, N0); N1 = dev_mfma32(a1, bh, N1); N1 = dev_mfma32(a1, bl, N1); Yt = dev_mfma32(ay, bh, Yt); }
      T0 = N0; T1 = N1;
      float* yb = (float*)(smem + SQ_YB) + (c & 1) * CK * 64;
#pragma unroll
      for (int i = 0; i < 16; ++i) yb[crow(i, h) * 64 + 32 * vb + r] = Yt[i]; }
    if (wave >= 2) { if (c > 0) store_y(c - 1); if (c + 3 < NCHK) issue(c + 3); }
  }
  dev_bar();
  if (wave >= 2) store_y(NCHK - 1);
  dev_vmwait<0>();
  dev_bar();
}

constexpr int U_SCAN = 2 * NB * 4, U_MLA = NB * 4 * (T / 256), U_GQA = GQ_UNITS + GQ_SPLIT  , U_NAT = NB * 4 * (GROWS / 4);
constexpr int U_CGQA = NB * 2 * (C / 128), U_CMLA = NB * 4 * (C / 256), U_CNAT = NB * 4 * (C / 256);
DI void phase_mixer(const Params& p, int l, char* smem, int mode = 0, int qsel = 0) {
  const int tid = TID, wave = tid >> 6; int* qslot = (int*)(smem + 131072 - 256);
  const int total = U_SCAN + U_MLA + U_GQA + U_NAT + (l == 0 ? U_CGQA + U_CMLA + U_CNAT : 0);
  const bf16_t *QG = wsp<bf16_t>(p, A_QG), *KG = wsp<bf16_t>(p, A_KG), *QKVN = wsp<bf16_t>(p, A_QKVN), *KM = wsp<bf16_t>(p, A_KM), *QM = wsp<bf16_t>(p, A_QM), *VM = wsp<bf16_t>(p, A_VM); bf16_t* Y = wsp<bf16_t>(p, A_Y);
  const float SC64 = 0.125f * LOG2E, SC96 = 0.10206207261596575f * LOG2E;
  for (;;) {
    if (tid == 0) *qslot = (int)dev_atomic_add(wsp<unsigned>(p, WS_CTL) + CW_QUEUE + 64 * (l + 2 * qsel), 1u);
    __syncthreads();
    int u = *qslot;
    __syncthreads();
    if (u >= total) break;
    if (mode == 1 && u >= U_SCAN) continue;
    if (mode == 2 && u < U_SCAN) continue;
    if (u < U_SCAN) { scan_chain(p, u, smem); continue; } u -= U_SCAN;
    if (u < U_MLA) { const int qb = u % (T / 256), hd = (u / (T / 256)) % 4, b = u / (4 * (T / 256)); const int m0 = b * T + qb * 256 + wave * 32;
      attn2_unit<6, 8>(smem, QM + (size_t)m0 * 384 + hd * 96, 384, Y + (size_t)m0 * D + 512 + hd * 64, D, KM + hd * 96, 384, VM + hd * 64, 256, b); continue; } u -= U_MLA;
    if (u < U_GQA) { const int half = u >= GQ_UNITS - GQ_SPLIT ? (u - (GQ_UNITS - GQ_SPLIT)) & 1 : -1, su = (u - (GQ_UNITS - GQ_SPLIT)) >> 1; const int uu = half < 0 ? u : GQ_UNITS - GQ_SPLIT + su;
      const int qb = uu % (T / 128), g = (uu / (T / 128)) % 2, b = uu / (2 * (T / 128)); const int hd = 2 * g + (wave >> 2), m0 = b * T + qb * 128 + (wave & 3) * 32;
      if (half < 0) attn2_unit<4, 8>(smem, QG + (size_t)m0 * 256 + hd * 64, 256, Y + (size_t)m0 * D + 256 + hd * 64, D, KG + g * 64, 128, QKVN + 768 + g * 64, 896, b);
      else attn2_unit<4, 8, true>(smem, QG + (size_t)m0 * 256 + hd * 64, 256, wsp<bf16_t>(p, A_GPO) + (size_t)((su * 2 + half) * 8 + wave) * 2048, 64, KG + g * 64, 128, QKVN + 768 + g * 64, 896, b, half,
                            wsp<float>(p, A_GST) + (size_t)((su * 2 + half) * 8 + wave) * 64);
      continue; } u -= U_GQA;
    if (u < U_NAT) { const int rb = u % (GROWS / 4), hd = (u / (GROWS / 4)) % 4, b = u / (4 * (GROWS / 4)); const int qi = 4 * rb + (wave >> 1), c0 = 32 * (wave & 1), m0 = b * T + 64 * qi + c0;
      auto clampr = [](int i) { return i - 4 < 0 ? 0 : (i - 4 > GROWS - 8 ? GROWS - 8 : i - 4); };
      const int kr_lo = clampr(4 * rb), kr_hi = clampr(4 * rb + 3) + 7, nwin = kr_hi - kr_lo + 1;
      for (int e = tid; e < 15 * 31; e += 512) ((float*)(smem + ATT_BIAS))[e] = p.in(I_NATB)[((size_t)(l * 4 + hd) * 15) * 31 + e];
      __syncthreads();
      auto tf = [&](int i) { if (i < nwin) { const int m = b * T + 64 * (kr_lo + i); return TileSrc{QKVN + (size_t)m * 896 + 256 + hd * 64, QKVN + (size_t)m * 896 + 512 + hd * 64, kr_lo + i}; }
        const int m = TL + b * C + 64 * (i - nwin); return TileSrc{QKVN + (size_t)m * 896 + 256 + hd * 64, QKVN + (size_t)m * 896 + 512 + hd * 64, -1}; };
      attn_unit<64, true>(smem, QKVN + (size_t)m0 * 896 + hd * 64, 896, Y + (size_t)m0 * D + 768 + hd * 64, D, nwin + C / 64, tf, 896, 896, SC64, qi, c0); continue; } u -= U_NAT;
    if (u < U_CGQA) { const int qb = u % (C / 128), g = (u / (C / 128)) % 2, b = u / (2 * (C / 128)); const int hd = 2 * g + (wave >> 2), m0 = TL + b * C + qb * 128 + (wave & 3) * 32;
      auto tf = [&](int i) { const int m = TL + b * C + 64 * i; return TileSrc{KG + (size_t)m * 128 + g * 64, QKVN + (size_t)m * 896 + 768 + g * 64, -1}; };
      attn_unit<64, false>(smem, QG + (size_t)m0 * 256 + hd * 64, 256, Y + (size_t)m0 * D + 256 + hd * 64, D, C / 64, tf, 128, 896, 1.0f, 0, 0); continue; } u -= U_CGQA;
    if (u < U_CMLA) { const int qb = u % (C / 256), hd = (u / (C / 256)) % 4, b = u / (4 * (C / 256)); const int m0 = TL + b * C + qb * 256 + wave * 32;
      auto tf = [&](int i) { const int m = TL + b * C + 64 * i; return TileSrc{KM + (size_t)m * 384 + hd * 96, VM + (size_t)m * 256 + hd * 64, -1}; };
      attn_unit<96, false>(smem, QM + (size_t)m0 * 384 + hd * 96, 384, Y + (size_t)m0 * D + 512 + hd * 64, D, C / 64, tf, 384, 256, 1.0f, 0, 0); continue; } u -= U_CMLA;
    { const int qb = u % (C / 256), hd = (u / (C / 256)) % 4, b = u / (4 * (C / 256)); const int m0 = TL + b * C + qb * 256 + wave * 32;
      auto tf = [&](int i) { const int m = TL + b * C + 64 * i; return TileSrc{QKVN + (size_t)m * 896 + 256 + hd * 64, QKVN + (size_t)m * 896 + 512 + hd * 64, -1}; };
      attn_unit<64, false>(smem, QKVN + (size_t)m0 * 896 + hd * 64, 896, Y + (size_t)m0 * D + 768 + hd * 64, D, C / 64, tf, 896, 896, SC64, 0, 0); }
  }
}
#ifndef EMU
template <class F> struct EpiFn {
  static constexpr bool PERM = true, AFTER_DRAIN = false; F f;
  __device__ __forceinline__ void operator()(const pg8::f32x4 (&acc)[2][2][4][2], const pg8::Unit& u, int wr, int wc, int fr, int fq) const {
    int fr_ = fr, fq_ = fq; asm volatile("" : "+v"(fr_), "+v"(fq_));
    const int row0 = u.pm * 256 + wr * 64 + fr_, col0 = u.pc * 256 + wc * 32 + 8 * fq_;
#pragma unroll
    for (int ai = 0; ai < 2; ++ai)
#pragma unroll
      for (int m = 0; m < 4; ++m)
#pragma unroll
        for (int bj = 0; bj < 2; ++bj) { const pg8::f32x4 a = acc[ai][bj][m][0], b = acc[ai][bj][m][1]; const float v[8] = {a[0], a[1], a[2], a[3], b[0], b[1], b[2], b[3]};
          f.store8(u.pm * 256, row0 + ai * 128 + m * 16, col0 + bj * 128, v); __builtin_amdgcn_sched_barrier(0); }
  }
};
struct EpiLoraFn {
  static constexpr bool PERM = true, AFTER_DRAIN = false; EpiLora f;
  __device__ __forceinline__ void operator()(const pg8::f32x4 (&acc)[2][2][4][2], const pg8::Unit& u, int wr, int wc, int fr, int fq) const {
    int fr_ = fr, fq_ = fq; asm volatile("" : "+v"(fr_), "+v"(fq_));
    const int urow = u.pm * 256, row0 = urow + wr * 64 + fr_, cc0 = wc * 32 + 8 * fq_; const int blk = __builtin_amdgcn_readfirstlane(u.pc);
    const int b = row_batch(urow), kpos0 = row_kpos(urow) + (row0 - urow); const Params& p = *f.p; const int l = f.l;
#define LORA_V8(ai, m, bj) const pg8::f32x4 a_ = acc[ai][bj][m][0], b_ = acc[ai][bj][m][1]; const float v[8] = {a_[0], a_[1], a_[2], a_[3], b_[0], b_[1], b_[2], b_[3]}
    if (blk < 2) { f32x4 wv[2][2];
#pragma unroll
      for (int bj = 0; bj < 2; ++bj) { const float* w0 = p.in(I_W0) + (l * 2 + blk) * 256 + cc0 + bj * 128; wv[bj][0] = *(const f32x4*)w0; wv[bj][1] = *(const f32x4*)(w0 + 4); }
#pragma unroll
      for (int ai = 0; ai < 2; ++ai)
#pragma unroll
        for (int m = 0; m < 4; ++m)
#pragma unroll
          for (int bj = 0; bj < 2; ++bj) { LORA_V8(ai, m, bj); const int cc = cc0 + bj * 128; f32x4 oa, ob; lora_lw8(v, wv[bj][0], wv[bj][1], oa, ob);
            float* dst = f.lw_dst(blk, b, cc >> 6, kpos0 + ai * 128 + m * 16, cc & 63); *(f32x4*)dst = oa; *(f32x4*)(dst + 4) = ob; __builtin_amdgcn_sched_barrier(0); }
    } else if (blk < 4) { const int d = blk - 2; f32x4 a0v[2][2], kav[2][2];
#pragma unroll
      for (int bj = 0; bj < 2; ++bj) { const float* a0 = p.in(I_A0) + (l * 2 + d) * 256 + cc0 + bj * 128; const float* ka = p.in(I_KA) + l * 256 + cc0 + bj * 128;
        a0v[bj][0] = *(const f32x4*)a0; a0v[bj][1] = *(const f32x4*)(a0 + 4); kav[bj][0] = *(const f32x4*)ka; kav[bj][1] = *(const f32x4*)(ka + 4); }
#pragma unroll
      for (int ai = 0; ai < 2; ++ai)
#pragma unroll
        for (int mh = 0; mh < 2; ++mh) { LoraIn in[2][2];
#pragma unroll
          for (int mm = 0; mm < 2; ++mm)
#pragma unroll
            for (int bj = 0; bj < 2; ++bj) { const int cc = cc0 + bj * 128, ro = ai * 128 + (2 * mh + mm) * 16; f.bk_load(b, cc >> 6, kpos0 + ro, cc & 63, row0 + ro, cc, in[mm][bj]); }
          __builtin_amdgcn_sched_barrier(0);
#pragma unroll
          for (int mm = 0; mm < 2; ++mm)
#pragma unroll
            for (int bj = 0; bj < 2; ++bj) { const int m = 2 * mh + mm; LORA_V8(ai, m, bj); const int cc = cc0 + bj * 128, ro = ai * 128 + m * 16; u32x4 wb, wk; lora_bk8(v, a0v[bj], kav[bj], in[mm][bj], wb, wk);
              bf16_t* dst = f.bk_dst(d, b, cc >> 6, kpos0 + ro, cc & 63); *(u32x4*)dst = wb; *(u32x4*)(dst + 64) = wk; }
          __builtin_amdgcn_sched_barrier(0); }
    } else {
#pragma unroll
      for (int ai = 0; ai < 2; ++ai)
#pragma unroll
        for (int m = 0; m < 4; ++m)
#pragma unroll
          for (int bj = 0; bj < 2; ++bj) { const pg8::f32x4 a = acc[ai][bj][m][0], b2 = acc[ai][bj][m][1]; u32x4 w; w.x = pk2(a[0], a[1]); w.y = pk2(a[2], a[3]); w.z = pk2(b2[0], b2[1]); w.w = pk2(b2[2], b2[3]);
            *(u32x4*)(wsp<bf16_t>(p, A_RWG) + (size_t)(row0 + ai * 128 + m * 16) * 256 + cc0 + bj * 128) = w; __builtin_amdgcn_sched_barrier(0); }
    }
#undef LORA_V8
  }
};
struct InProjRoute { bf16_t* P; bf16_t* QKVN;
  __device__ __forceinline__ bool route(int cbase, bf16_t*& base, int& pitch) const { if (cbase >= 2720) return false;
    if (cbase >= 1952) { base = QKVN + (cbase - 1952); pitch = 896; } else if (cbase >= 1408 && cbase < 1536) { base = QKVN + 768 + (cbase - 1408); pitch = 896; } else { base = P + cbase; pitch = PW; } return true; } };
struct PlainRoute { bf16_t* O; int ld;
  __device__ __forceinline__ bool route(int cbase, bf16_t*& base, int& pitch) const { base = O + cbase; pitch = ld; return true; } };
template <class R> struct EpiRouteFn {
  static constexpr bool PERM = true, AFTER_DRAIN = false; R r;
  __device__ __forceinline__ void operator()(const pg8::f32x4 (&acc)[2][2][4][2], const pg8::Unit& u, int wr, int wc, int fr, int fq) const {
    int fr_ = fr, fq_ = fq; asm volatile("" : "+v"(fr_), "+v"(fq_));
    const int row0 = u.pm * 256 + wr * 64 + fr_;
#pragma unroll
    for (int bj = 0; bj < 2; ++bj) { const int cbase = __builtin_amdgcn_readfirstlane(u.pc * 256 + wc * 32 + bj * 128); bf16_t* base; int pitch; if (!r.route(cbase, base, pitch)) continue;
      char* lanep = (char*)(base + (size_t)row0 * pitch + 8 * fq_); const size_t rstep = (size_t)pitch * 32;
#pragma unroll
      for (int ai = 0; ai < 2; ++ai)
#pragma unroll
        for (int m = 0; m < 4; ++m) { const pg8::f32x4 a = acc[ai][bj][m][0], b = acc[ai][bj][m][1]; u32x4 w; w.x = pk2(a[0], a[1]); w.y = pk2(a[2], a[3]); w.z = pk2(b[0], b[1]); w.w = pk2(b[2], b[3]);
          *(u32x4*)(lanep + (size_t)(ai * 8 + m) * rstep) = w; __builtin_amdgcn_sched_barrier(0); } }
  }
};
struct EpiSwiGluFn {
  static constexpr bool PERM = true, AFTER_DRAIN = false; bf16_t* O; int ld;
  __device__ __forceinline__ void operator()(const pg8::f32x4 (&acc)[2][2][4][2], const pg8::Unit& u, int wr, int wc, int fr, int fq) const {
    int fr_ = fr, fq_ = fq; asm volatile("" : "+v"(fr_), "+v"(fq_));
    const int row0 = u.pm * 256 + wr * 64 + fr_; const size_t rstep = (size_t)ld * 32;
#pragma unroll
    for (int bj = 0; bj < 2; ++bj) { const int cbase = __builtin_amdgcn_readfirstlane(u.pc * 256 + wc * 32 + bj * 128); char* lanep = (char*)(O + (size_t)row0 * ld + (cbase >> 1) + 4 * fq_);
#pragma unroll
      for (int ai = 0; ai < 2; ++ai)
#pragma unroll
        for (int m = 0; m < 4; ++m) { const pg8::f32x4 a = acc[ai][bj][m][0], b = acc[ai][bj][m][1]; u32x2 w; w.x = pk2(siluf_(a[0]) * a[1], siluf_(a[2]) * a[3]); w.y = pk2(siluf_(b[0]) * b[1], siluf_(b[2]) * b[3]);
          *(u32x2*)(lanep + (size_t)(ai * 8 + m) * rstep) = w; __builtin_amdgcn_sched_barrier(0); } }
  }
};
struct LoraOrder : pg8::StaticOrder {
  __device__ __forceinline__ bool next(int i, pg8::Unit& u) const { if (!pg8::StaticOrder::next(i, u)) return false; u.ko = (u.pn == 4) ? 128 : 0; return true; }
};
struct SliceOrder {
  int nM, nN, nS, sliceK, G, c;
  __device__ __forceinline__ bool next(int i, pg8::Unit& u) const {
    const long L = (long)i * G + c; if (L >= (long)nM * nN * nS) return false;
    const int ks = (int)(L % nS), t = (int)(L / nS); u.pn = t % nN; u.pm = t / nN; u.pc = u.pn; u.ks = ks; u.ko = ks * sliceK; return true;
  }
  __device__ __forceinline__ void a_ready(const pg8::Unit&) const {}
  __device__ __forceinline__ void done(const pg8::Unit&) const {}
};
struct EpiSlab {
  static constexpr bool PERM = true, AFTER_DRAIN = false; float* O; int ld; size_t slab;
  __device__ __forceinline__ void operator()(const pg8::f32x4 (&acc)[2][2][4][2], const pg8::Unit& u, int wr, int wc, int fr, int fq) const {
    int fr_ = fr, fq_ = fq; asm volatile("" : "+v"(fr_), "+v"(fq_));
    const int row0 = u.pm * 256 + wr * 64 + fr_, col0 = u.pc * 256 + wc * 32 + 8 * fq_; float* base = O + (size_t)u.ks * slab;
#pragma unroll
    for (int ai = 0; ai < 2; ++ai)
#pragma unroll
      for (int m = 0; m < 4; ++m)
#pragma unroll
        for (int bj = 0; bj < 2; ++bj) { float* o = base + (size_t)(row0 + ai * 128 + m * 16) * ld + col0 + bj * 128; *(pg8::f32x4*)o = acc[ai][bj][m][0]; *(pg8::f32x4*)(o + 4) = acc[ai][bj][m][1]; __builtin_amdgcn_sched_barrier(0); }
  }
};
struct EpiSlabBf16 {
  static constexpr bool PERM = true, AFTER_DRAIN = false; bf16_t* O; int ld; size_t slab;
  __device__ __forceinline__ void operator()(const pg8::f32x4 (&acc)[2][2][4][2], const pg8::Unit& u, int wr, int wc, int fr, int fq) const {
    int fr_ = fr, fq_ = fq; asm volatile("" : "+v"(fr_), "+v"(fq_));
    const int row0 = u.pm * 256 + wr * 64 + fr_, col0 = u.pc * 256 + wc * 32 + 8 * fq_; bf16_t* base = O + (size_t)u.ks * slab;
#pragma unroll
    for (int ai = 0; ai < 2; ++ai)
#pragma unroll
      for (int m = 0; m < 4; ++m)
#pragma unroll
        for (int bj = 0; bj < 2; ++bj) { const pg8::f32x4 a = acc[ai][bj][m][0], b = acc[ai][bj][m][1]; u32x4 w; w.x = pk2(a[0], a[1]); w.y = pk2(a[2], a[3]); w.z = pk2(b[0], b[1]); w.w = pk2(b[2], b[3]);
          *(u32x4*)(base + (size_t)(row0 + ai * 128 + m * 16) * ld + col0 + bj * 128) = w; __builtin_amdgcn_sched_barrier(0); }
  }
};
struct GroupedOrder {
  int off[NE + 1]; int nN, G, c; int lim = 1 << 20;
  __device__ __forceinline__ bool next(int i, pg8::Unit& u) const {
    const long L = (long)i * G + c; int ntile = off[NE] >> 8; ntile = ntile < lim ? ntile : lim; if (L >= (long)ntile * nN) return false;
    const int pm = (int)(L / nN), pl = (int)(L % nN); int e = 0;
#pragma unroll
    for (int k = 1; k < NE; ++k) e += (pm * 256 >= off[k]) ? 1 : 0;
    u.pm = pm; u.pc = pl; u.pn = e * nN + pl; u.ko = 0; u.ks = 0; return true;
  }
  __device__ __forceinline__ void a_ready(const pg8::Unit&) const {}
  __device__ __forceinline__ void done(const pg8::Unit&) const {}
};

struct GroupedSliceOrder {
  int off[NE + 1]; int nN, G, c, t0, nS, sliceK;
  __device__ __forceinline__ bool next(int i, pg8::Unit& u) const {
    const int L = i * G + c; const int ntile = off[NE] >> 8; if (ntile <= t0 || L >= (ntile - t0) * nN * nS) return false;
    const int ks = L % nS, t = L / nS, pl = t % nN, pm = t0 + t / nN; int e = 0;
#pragma unroll
    for (int k = 1; k < NE; ++k) e += (pm * 256 >= off[k]) ? 1 : 0;
    u.pm = pm; u.pc = pl; u.pn = e * nN + pl; u.ks = ks; u.ko = ks * sliceK; return true;
  }
  __device__ __forceinline__ void a_ready(const pg8::Unit&) const {}
  __device__ __forceinline__ void done(const pg8::Unit&) const {}
};
#ifdef NO_GEMM
#define GEMM_PHASE(...) do {} while (0)
#else
#define GEMM_PHASE(...) pg8::gemm_phase<__VA_ARGS__>
#define GEMM_TWICE(...) do { __VA_ARGS__; if (PROBE_REP == 4) { __VA_ARGS__; } } while (0)
#define GEMM_TWICE_ID(id, ...) do { __VA_ARGS__; if (PROBE_REP == 4 || PROBE_REP == (id)) { __VA_ARGS__; } } while (0)
#endif
#ifdef NO_MIX
#define MIX_PHASE(...) do {} while (0)
#else
#define MIX_PHASE(...) phase_mixer(__VA_ARGS__)
#endif
#ifdef NO_ROW
#define ROW(x) do {} while (0)
#else
#define ROW(x) x
#endif
constexpr int LDS_BYTES = 147456, MISC_OFF = 131072 + 320;
#ifndef PROBE_REP
#define PROBE_REP 0
#endif
#ifndef MK_CUTS
#define MK_CUTS 0
#endif
constexpr int N_PHASES = 26;

#define IN(k) (lo <= (k) && (k) < hi)
#define SEAM(k) do { if (IN(k) && IN((k) + 1)) { xcd_barrier(bar); if (PROBE_REP == 8) xcd_barrier(bar); } } while (0)
template <int L> __device__ __forceinline__ void run_layer(const Params& p, char* smem, PG8_LAS unsigned char* glds, const XcdBarrier& bar, int lo, int hi, int G, int cb) {
  constexpr int l = L; constexpr int pb = 2 + 12 * l;
    if (IN(pb + 0)) { pg8::Gemm g{(const pg8::bf16_t*)(p.ws + A_XN), (const pg8::bf16_t*)(p.ws + WS_WIN) + (size_t)l * PW * D, MT, PW, D}; pg8::StaticOrder S; S.init(MT, PW, G, cb);
      EpiRouteFn<InProjRoute> E{{wsp<bf16_t>(p, A_P), wsp<bf16_t>(p, A_QKVN)}}; GEMM_TWICE_ID(10, GEMM_PHASE(EpiRouteFn<InProjRoute>, pg8::StaticOrder, true, true)(glds, g, S, E)); } SEAM(pb + 0);
    if (IN(pb + 1)) { ROW(phase_prep(p, l)); if (PROBE_REP == 7) phase_prep(p, l); } SEAM(pb + 1);
    if (IN(pb + 2)) {
      { pg8::Gemm g{(const pg8::bf16_t*)(p.ws + A_RWA), (const pg8::bf16_t*)(p.ws + WS_WLORA) + (size_t)l * 1280 * 256, MT, 1280, 128, 256}; LoraOrder S; S.init(MT, 1280, G, cb);
        EpiLoraFn E{{&p, l}}; GEMM_TWICE_ID(17, GEMM_PHASE(EpiLoraFn, LoraOrder, true, true)(glds, g, S, E)); }
      { pg8::Gemm g{(const pg8::bf16_t*)(p.ws + A_CQN), (const pg8::bf16_t*)(p.ws + WS_WUQ) + (size_t)l * 512 * 256, MT, 512, 256}; pg8::StaticOrder S; S.init(MT, 512, G, (cb + 168) % G);
        EpiFn<EpiMlaQ> E{{&p}}; GEMM_TWICE_ID(18, GEMM_PHASE(EpiFn<EpiMlaQ>, pg8::StaticOrder, true, true)(glds, g, S, E)); }
      { pg8::Gemm g{(const pg8::bf16_t*)(p.ws + A_CKVN), (const pg8::bf16_t*)(p.ws + WS_WUKV) + (size_t)l * 512 * 128, MT, 512, 128}; pg8::StaticOrder S; S.init(MT, 512, G, (cb + 32) % G);
        EpiFn<EpiMlaKV> E{{&p}}; GEMM_TWICE_ID(19, GEMM_PHASE(EpiFn<EpiMlaKV>, pg8::StaticOrder, true, true)(glds, g, S, E)); }
    } SEAM(pb + 2);
    if (IN(pb + 3)) { ROW(phase_scan_prep(p, l, smem)); } SEAM(pb + 3);
    if (IN(pb + 4)) { MIX_PHASE(p, l, smem);
      if (PROBE_REP >= 1 && PROBE_REP <= 3) { xcd_barrier(bar); phase_mixer(p, l, smem, PROBE_REP - 1, 1); } } SEAM(pb + 4);
    if (IN(pb + 5)) { ROW(phase_rwkv_out(p, l)); if (PROBE_REP == 7) phase_rwkv_out(p, l); } SEAM(pb + 5);
    if (IN(pb + 6)) {
      { pg8::Gemm g{(const pg8::bf16_t*)(p.ws + A_Y), (const pg8::bf16_t*)(p.ws + WS_WOUT) + (size_t)l * D * D, TL, D, D}; pg8::StaticOrder S; S.init(TL, D, G, cb);
        EpiRouteFn<PlainRoute> E{{wsp<bf16_t>(p, A_YO), D}}; GEMM_TWICE_ID(12, GEMM_PHASE(EpiRouteFn<PlainRoute>, pg8::StaticOrder, true, true)(glds, g, S, E)); }
      if constexpr (l == 0) { pg8::Gemm g{(const pg8::bf16_t*)(p.ws + A_Y) + (size_t)TL * D, (const pg8::bf16_t*)(p.ws + WS_WOUT) + (size_t)l * D * D, TC, D, 256, D}; SliceOrder S{TC / 256, D / 256, OS_NS, 256, G, (cb + 128) % G};
        EpiSlabBf16 E{wsp<bf16_t>(p, A_YOS), D, (size_t)TC * D}; GEMM_PHASE(EpiSlabBf16, SliceOrder, true, true)(glds, g, S, E); }
      if constexpr (l == 1) { ROW(moe_convert(p, smem)); if (PROBE_REP == 6) { __syncthreads(); moe_convert(p, smem); } } } SEAM(pb + 6);
    if (IN(pb + 7)) { ROW(phase_post_mixer(p, l, smem)); } SEAM(pb + 7);
    if constexpr (l == 0) {
      if (IN(pb + 8)) { pg8::Gemm g{(const pg8::bf16_t*)(p.ws + A_XN), (const pg8::bf16_t*)(p.ws + WS_WGU), MT, 2 * FF, D}; pg8::StaticOrder S; S.init(MT, 2 * FF, G, cb);
        EpiSwiGluFn E{wsp<bf16_t>(p, A_ACT), FF}; GEMM_TWICE_ID(13, GEMM_PHASE(EpiSwiGluFn, pg8::StaticOrder, true, true)(glds, g, S, E)); } SEAM(pb + 8);
      if (IN(pb + 9)) {
        { pg8::Gemm g{(const pg8::bf16_t*)(p.ws + A_ACT), (const pg8::bf16_t*)(p.ws + WS_WDN), TL, D, FF}; pg8::StaticOrder S; S.init(TL, D, G, cb);
          EpiRouteFn<PlainRoute> E{{wsp<bf16_t>(p, A_F), D}}; GEMM_TWICE_ID(14, GEMM_PHASE(EpiRouteFn<PlainRoute>, pg8::StaticOrder, true, true)(glds, g, S, E)); }
        { pg8::Gemm g{(const pg8::bf16_t*)(p.ws + A_ACT) + (size_t)TL * FF, (const pg8::bf16_t*)(p.ws + WS_WDN), TC, D, 256, FF}; SliceOrder S{TC / 256, D / 256, FS_NS, 256, G, (cb + 64) % G};
          EpiSlabBf16 E{wsp<bf16_t>(p, A_FS), D, (size_t)TC * D}; GEMM_PHASE(EpiSlabBf16, SliceOrder, true, true)(glds, g, S, E); } } SEAM(pb + 9);
      if (IN(pb + 10)) { ROW(phase_post_ffn0(p)); } SEAM(pb + 10);
    } else {
      if (IN(pb + 8)) { ROW(phase_moe_gather(p, l)); if (PROBE_REP == 21) phase_moe_gather(p, l); } SEAM(pb + 8);
      if (IN(pb + 9)) { GroupedOrder S; moe_offsets(p, S.off); S.nN = 2 * FF / 256; S.G = G; S.c = cb;
        pg8::Gemm g{(const pg8::bf16_t*)(p.ws + A_XG), (const pg8::bf16_t*)(p.ws + A_MWGU), XG_ROWS, NE * 2 * FF, D};
        EpiSwiGluFn E{wsp<bf16_t>(p, A_ACTG), FF}; GEMM_TWICE_ID(15, GEMM_PHASE(EpiSwiGluFn, GroupedOrder, true, true)(glds, g, S, E)); } SEAM(pb + 9);
      if (IN(pb + 10)) {
        { GroupedOrder S; moe_offsets(p, S.off); S.nN = D / 256; S.G = G; S.c = cb; S.lim = MOE_NFULL;
          pg8::Gemm g{(const pg8::bf16_t*)(p.ws + A_ACTG), (const pg8::bf16_t*)(p.ws + A_MWDN), XG_ROWS, NE * D, FF};
          EpiRouteFn<PlainRoute> E{{wsp<bf16_t>(p, A_XG), D}}; GEMM_TWICE_ID(16, GEMM_PHASE(EpiRouteFn<PlainRoute>, GroupedOrder, true, true)(glds, g, S, E)); }
        { GroupedSliceOrder S; moe_offsets(p, S.off); S.nN = D / 256; S.G = G; S.c = cb; S.t0 = MOE_NFULL; S.nS = MOE_NS; S.sliceK = MOE_SK;
          pg8::Gemm g{(const pg8::bf16_t*)(p.ws + A_ACTG), (const pg8::bf16_t*)(p.ws + A_MWDN), XG_ROWS, NE * D, MOE_SK, FF};
          EpiSlab E{wsp<float>(p, WS_MSLAB) - (size_t)MOE_NFULL * 256 * D, D, (size_t)MOE_TAILROWS * D}; GEMM_PHASE(EpiSlab, GroupedSliceOrder, true, true)(glds, g, S, E); }
      } SEAM(pb + 10);
      if (IN(pb + 11)) { ROW(phase_moe_combine(p, l)); }
    }

}
struct Args { const float* in[N_IN]; float* out; unsigned char* ws; int ph_lo, ph_hi; };
static_assert(sizeof(Args) == (N_IN + 2) * 8 + 8, "no padding holes in the argument struct");
constexpr int INTAB_OFF = 131072 + 1024;

__global__ void __launch_bounds__(512, 2) fwd_kernel(Args args) {
  extern __shared__ __attribute__((aligned(16))) unsigned char lds[];
  char* smem = (char*)lds;
  const int tid = threadIdx.x;
  Params p; p.in_ = (LAS cfptr_t*)((LAS unsigned char*)lds + INTAB_OFF); p.out = args.out; p.ws = args.ws;
  for (int u = tid; u < (LDS_BYTES - 131072) / 4; u += 512) ((LAS unsigned*)((LAS unsigned char*)lds + 131072))[u] = 0u;
  if (tid < N_IN) p.in_[tid] = args.in[tid];
  __syncthreads();
  unsigned* ctl = (unsigned*)(p.ws + WS_CTL);
  XcdBarrier bar; bar.bar = ctl + CW_BAR; bar.x = 0; bar.st = nullptr;
  const int lo = args.ph_lo, hi = args.ph_hi;
  if (hi - lo > 1) bar = xcd_barrier_post(ctl + CW_BAR, (volatile LAS unsigned*)((LAS unsigned char*)lds + MISC_OFF) + 8);
  const int G = gridDim.x, cb = blockIdx.x;
  PG8_LAS unsigned char* glds = (PG8_LAS unsigned char*)lds;

  if (IN(0)) { ROW(phase_prologue(p, smem)); if (PROBE_REP == 5) { __syncthreads(); phase_prologue(p, smem); } } SEAM(0);
  if (IN(1)) { ROW(phase_adaln0(p)); if (PROBE_REP == 20) phase_adaln0(p); } SEAM(1);
  run_layer<0>(p, smem, glds, bar, lo, hi, G, cb);
  run_layer<1>(p, smem, glds, bar, lo, hi, G, cb);
#undef IN
#undef SEAM
}

extern "C" void kernel_launch(void* const* d_in, const int* in_sizes, int n_in, void* d_out, int out_size, void* d_ws, size_t ws_size, hipStream_t stream) {
  static int grid = 0;
  if (grid == 0) {
    if (n_in != N_IN || in_sizes[I_X] != TL * D || out_size != TL * D || ws_size < WS_NEED) { fprintf(stderr, "kernel_launch: unexpected shapes / workspace (%zu needed, %zu given)\n", (size_t)WS_NEED, ws_size); grid = -1; return; }
    int dev = 0, cus = 0, per_cu = 0;
    if (hipGetDevice(&dev) != hipSuccess || hipDeviceGetAttribute(&cus, hipDeviceAttributeMultiprocessorCount, dev) != hipSuccess) { grid = -1; return; }
    if (hipFuncSetAttribute((const void*)fwd_kernel, hipFuncAttributeMaxDynamicSharedMemorySize, LDS_BYTES) != hipSuccess) { grid = -1; return; }
    if (hipOccupancyMaxActiveBlocksPerMultiprocessor(&per_cu, (const void*)fwd_kernel, 512, LDS_BYTES) != hipSuccess || per_cu < 1) { fprintf(stderr, "kernel_launch: occupancy query says %d\n", per_cu); }
    (void)hipGetLastError();
    grid = cus;
  }
  if (grid < 0) return;
  if (hipMemsetAsync((char*)d_ws + WS_CTL, 0, CTL_BYTES, stream) != hipSuccess) return;
  Args a{};
  for (int i = 0; i < N_IN; ++i) a.in[i] = (const float*)d_in[i];
  a.out = (float*)d_out; a.ws = (unsigned char*)d_ws;
#if MK_CUTS
  for (int ph = 0; ph < N_PHASES; ++ph) { if (ph == 13) continue; a.ph_lo = ph; a.ph_hi = ph + 1; hipLaunchKernelGGL(fwd_kernel, dim3(grid), dim3(512), LDS_BYTES, stream, a); }
#else
  a.ph_lo = 0; a.ph_hi = N_PHASES; hipLaunchKernelGGL(fwd_kernel, dim3(grid), dim3(512), LDS_BYTES, stream, a);
#endif
}
#endif
```

```cpp
#ifndef EMU
#include <hip/hip_runtime.h>
#include <cstdio>
#include <cstdint>
#endif

#ifndef CFG_B
#define CFG_B 4
#define CFG_T 4096
#define CFG_C 256
#endif
constexpr int NB = CFG_B, T = CFG_T, C = CFG_C, NK = T + C, D = 1024;
constexpr int TL = NB * T, TC = NB * C, MT = TL + TC;
constexpr int GW = 64, GROWS = T / GW;
constexpr int PW = 2816, FF = 2816, NE = 8;
constexpr int XG_ROWS = 2 * TL + NE * 256;
constexpr int XG_TILES = XG_ROWS / 256;
constexpr float RMS_EPS = 1e-6f, GN_EPS = 64e-5f, LOG2E = 1.4426950408889634f;
static_assert(T % 256 == 0 && C % 256 == 0 && GROWS >= 8, "shape assumptions");

enum { I_X = 0, I_C, I_CTX, I_CCTX, I_MODW, I_MODB, I_NORMG, I_WIN, I_WOUT, I_MU, I_W0, I_WUP, I_A0, I_AUP, I_GUP, I_KK, I_KA, I_RK, I_LNG, I_LNB,
       I_GQG, I_GKG, I_MQG, I_WUQ, I_MKVG, I_WUKV, I_NATB, I_FG, I_FU, I_FD, I_ROUTER, I_MG, I_MU2, I_MD, N_IN };

constexpr size_t al256(size_t x) { return (x + 255) & ~(size_t)255; }
constexpr size_t WS_CTL = 0, CTL_BYTES = 1u << 20;
constexpr size_t WS_MOD = WS_CTL + CTL_BYTES;
constexpr size_t WS_TABG = WS_MOD + al256((size_t)2 * (NB + 1) * 6144 * 4);
constexpr size_t WS_TABM = WS_TABG + al256((size_t)T * 64 * 4);
constexpr size_t WS_WIN = WS_TABM + al256((size_t)T * 32 * 4);
constexpr size_t WS_WOUT = WS_WIN + (size_t)2 * PW * D * 2;
constexpr size_t WS_WGU = WS_WOUT + (size_t)2 * D * D * 2;
constexpr size_t WS_WDN = WS_WGU + (size_t)2 * FF * D * 2;
constexpr size_t WS_WUQ = WS_WDN + (size_t)D * FF * 2;
constexpr size_t WS_WUKV = WS_WUQ + (size_t)2 * 512 * 256 * 2;
constexpr size_t WS_WLORA = WS_WUKV + (size_t)2 * 512 * 128 * 2;
constexpr size_t WS_XSC = WS_WLORA + (size_t)2 * 1280 * 256 * 2;
constexpr size_t WS_ROUTE = WS_XSC + (size_t)TC * D * 4;
constexpr size_t WS_ARENA = al256(WS_ROUTE + (size_t)TL * 24);
constexpr size_t A_XN = WS_ARENA;
constexpr size_t A_RWA = A_XN, A_CQN = A_RWA + (size_t)MT * 256 * 2, A_CKVN = A_CQN + (size_t)MT * 256 * 2;
constexpr size_t A_Y = A_XN;
constexpr size_t A_P = A_XN + (size_t)MT * D * 2;
constexpr size_t A_SCD = A_P;
constexpr size_t A_YO = A_P;
constexpr size_t SCD_BYTES = (size_t)2 * NB * 4 * NK * 192 * 4, P_BYTES = (size_t)MT * PW * 2;
constexpr size_t A_SCS = A_P + (SCD_BYTES > P_BYTES ? SCD_BYTES : P_BYTES);
constexpr size_t A_KSH = A_SCS + (size_t)NB * 4 * NK * 192 * 4;
constexpr size_t A_RHO = A_KSH;
constexpr size_t A_QG = A_KSH + (size_t)MT * 256 * 4;
constexpr size_t A_KG = A_QG + (size_t)MT * 256 * 2;
constexpr size_t A_QKVN = A_KG + (size_t)MT * 128 * 2;
constexpr size_t A_KM = A_QKVN + (size_t)MT * 896 * 2;
constexpr size_t A_QM = A_KM + (size_t)MT * 384 * 2;
constexpr size_t A_VM = A_QM + (size_t)MT * 384 * 2;
constexpr size_t A_RWG = A_VM + (size_t)MT * 256 * 2;
constexpr size_t A_YS = A_RWG + (size_t)MT * 256 * 4;
constexpr int GQ_UNITS = NB * 2 * (T / 128), GQ_SPLIT = GQ_UNITS / 8;
constexpr size_t A_GPO = A_YS + (size_t)2 * MT * 256 * 4;
constexpr size_t A_GST = A_GPO + (size_t)GQ_SPLIT * 2 * 8 * 32 * 64 * 2;
constexpr size_t A_MIX_END = A_GST + (size_t)GQ_SPLIT * 2 * 8 * 32 * 2 * 4;
constexpr int OS_NS = 4, FS_NS = 11;
constexpr size_t A_YOS = A_YO + (size_t)MT * D * 4;
constexpr size_t A_ACT = A_YO + (size_t)MT * D * 4;
constexpr size_t A_F = A_ACT + (size_t)MT * FF * 2;
constexpr size_t A_FS = A_F + (size_t)MT * D * 4;
constexpr size_t A_FFN_END = A_FS + (size_t)FS_NS * TC * D * 4;
static_assert(OS_NS * 256 == D && FS_NS * 256 == FF, "slices of 256");
constexpr size_t A_XG = WS_ARENA;
constexpr size_t A_ACTG = A_XG + (size_t)XG_ROWS * D * 2;
constexpr size_t A_MWGU = A_ACTG + (size_t)XG_ROWS * FF * 2;
constexpr size_t A_MWDN = A_MWGU + (size_t)NE * 2 * FF * D * 2;
constexpr size_t A_MOE_END = A_MWDN + (size_t)NE * D * FF * 2;
static_assert(A_MWGU >= A_YO + (size_t)MT * D * 4, "MoE weights are converted while Y (A_XN) and YO are live");
constexpr int MOE_NFULL = 2 * TL / 256, MOE_NS = 2, MOE_SK = FF / MOE_NS, MOE_TAILROWS = NE * 256;
constexpr size_t WS_MSLAB = WS_WGU;
static_assert((size_t)MOE_NS * MOE_TAILROWS * D * 4 <= (size_t)2 * FF * D * 2 + (size_t)D * FF * 2 && MOE_SK % 128 == 0 && (2 * TL) % 256 == 0, "MoE tail slabs");
constexpr size_t cmax(size_t a, size_t b) { return a > b ? a : b; }
constexpr size_t WS_NEED = cmax(cmax(A_MIX_END, A_FFN_END), A_MOE_END);

constexpr int CW_TMO = 0, CW_BAR = 4096, CW_QUEUE = 16384  , CW_CNT = 16384 + 1024  ;

typedef unsigned short bf16_t;
typedef short bf16x8 __attribute__((ext_vector_type(8)));
typedef short s16x4 __attribute__((ext_vector_type(4)));
typedef float f32x4 __attribute__((ext_vector_type(4)));
typedef float f32x16 __attribute__((ext_vector_type(16)));
typedef unsigned u32x4 __attribute__((ext_vector_type(4)));
typedef unsigned u32x2 __attribute__((ext_vector_type(2)));
#define DI __device__ __forceinline__

DI unsigned f2bf(float f) { unsigned u = __builtin_bit_cast(unsigned, f); return (u + 0x7fffu + ((u >> 16) & 1u)) >> 16; }
DI float bf2f(unsigned h) { return __builtin_bit_cast(float, h << 16); }
#ifdef EMU
DI unsigned pk2(float lo, float hi) { return f2bf(lo) | (f2bf(hi) << 16); }
#else
typedef float f32x2_t __attribute__((ext_vector_type(2))); typedef __bf16 bf16x2_t __attribute__((ext_vector_type(2)));
DI unsigned pk2(float lo, float hi) { const f32x2_t v = {lo, hi}; return __builtin_bit_cast(unsigned, __builtin_convertvector(v, bf16x2_t)); }
#endif
DI unsigned f2bf_hw(float f) { return pk2(f, 0.f) & 0xffffu; }
DI int crow(int r, int hi) { return (r & 3) + 8 * (r >> 2) + 4 * hi; }

#ifdef EMU
DI float dev_shfl_xor(float v, int m) { uint64_t d = __builtin_bit_cast(unsigned, v); emu_exchange_begin(&d, 1); int lane = (int)threadIdx.x & 63; float r = __builtin_bit_cast(float, (unsigned)emu_slot(lane ^ m)[0]); emu_exchange_end(); return r; }
DI f32x16 dev_mfma32(bf16x8 a, bf16x8 b, f32x16 c) {
  uint64_t d[4]; memcpy(d, &a, 16); memcpy(d + 2, &b, 16); emu_exchange_begin(d, 4);
  int lane = (int)threadIdx.x & 63, r = lane & 31, h = lane >> 5; f32x16 o;
  for (int i = 0; i < 16; ++i) { int row = crow(i, h); float s = c[i];
    for (int hh = 0; hh < 2; ++hh) { const short* A = (const short*)emu_slot(row + 32 * hh); const short* B = (const short*)(emu_slot(r + 32 * hh) + 2);
      for (int j = 0; j < 8; ++j) s += bf2f((unsigned short)A[j]) * bf2f((unsigned short)B[j]); }
    o[i] = s; }
  emu_exchange_end(); return o; }
DI s16x4 dev_tr16(const void* p) { uint64_t d = (uint64_t)p; emu_exchange_begin(&d, 1); int lane = (int)threadIdx.x & 63, G = lane >> 4, i16 = lane & 15; s16x4 o;
  for (int e = 0; e < 4; ++e) o[e] = ((const short*)emu_slot(16 * G + 4 * e + (i16 >> 2))[0])[i16 & 3];
  emu_exchange_end(); return o; }
DI void dev_wave_fence() { emu_wave_sync(); }
DI int dev_uniform(int x) { return x; }
DI float dev_max3(float a, float b, float c) { return fmaxf(fmaxf(a, b), c); }
DI void dev_mfma_settle(f32x16&, f32x16&) {}
DI bool dev_any(bool pr) { uint64_t d = pr ? 1 : 0; emu_exchange_begin(&d, 1); bool r = false; for (int i = 0; i < 64; ++i) r = r || (emu_slot(i)[0] != 0); emu_exchange_end(); return r; }
template <int CTRL> DI float dev_dpp(float v) { uint64_t d = __builtin_bit_cast(unsigned, v); emu_exchange_begin(&d, 1); int lane = (int)threadIdx.x & 63, src;
  if (CTRL == 0xB1) src = lane ^ 1; else if (CTRL == 0x4E) src = lane ^ 2; else if (CTRL == 0x141) src = (lane & ~7) | (7 - (lane & 7)); else src = (lane & ~15) | (15 - (lane & 15));
  float r = __builtin_bit_cast(float, (unsigned)emu_slot(src)[0]); emu_exchange_end(); return r; }
DI void dev_glds16(const void* g, char* lds_wave_base) { memcpy(lds_wave_base + ((int)threadIdx.x & 63) * 16, g, 16); }
template <int N> DI void dev_vmwait() {}
DI void dev_bar() { __syncthreads(); }
DI float dev_exp2(float x) { return exp2f(x); }
DI float dev_rsqrt(float x) { return 1.0f / sqrtf(x); }
DI float dev_rcp(float x) { return 1.0f / x; }
DI unsigned dev_atomic_add(unsigned* p, unsigned v) { return __atomic_fetch_add(p, v, __ATOMIC_RELAXED); }
DI unsigned dev_atomic_load(const unsigned* p) { return __atomic_load_n(p, __ATOMIC_RELAXED); }
DI int dev_lds_add(int* p, int v) { const int o = *p; *p = o + v; return o; }
#else
#define LAS __attribute__((address_space(3)))
#define GAS __attribute__((address_space(1)))
DI float dev_shfl_xor(float v, int m) { return __shfl_xor(v, m); }
DI f32x16 dev_mfma32(bf16x8 a, bf16x8 b, f32x16 c) { return __builtin_amdgcn_mfma_f32_32x32x16_bf16(a, b, c, 0, 0, 0); }
typedef short v4i16_t __attribute__((ext_vector_type(4)));
DI s16x4 dev_tr16(const void* p) { return __builtin_bit_cast(s16x4, __builtin_amdgcn_ds_read_tr16_b64_v4i16((LAS v4i16_t*)p)); }
DI void dev_wave_fence() { asm volatile("s_waitcnt lgkmcnt(0)" ::: "memory"); }
DI int dev_uniform(int x) { return __builtin_amdgcn_readfirstlane(x); }
DI void dev_mfma_settle(f32x16& a, f32x16& b) { asm volatile("s_nop 15\n\ts_nop 7" : "+v"(a), "+v"(b)); }
DI float dev_max3(float a, float b, float c) { float r; asm("v_max3_f32 %0, %1, %2, %3" : "=v"(r) : "v"(a), "v"(b), "v"(c)); return r; }
DI bool dev_any(bool pr) { return __any(pr) != 0; }
template <int CTRL> DI float dev_dpp(float v) { return __builtin_bit_cast(float, __builtin_amdgcn_update_dpp(0, __builtin_bit_cast(int, v), CTRL, 0xf, 0xf, true)); }
DI void dev_glds16(const void* g, char* lds_wave_base) {
  unsigned keep; const unsigned dst = (unsigned)__builtin_amdgcn_readfirstlane((int)(unsigned)(uintptr_t)lds_wave_base);
  asm volatile("s_mov_b32 %0, m0\n\ts_mov_b32 m0, %2\n\ts_nop 0\n\tglobal_load_lds_dwordx4 %1, off\n\ts_mov_b32 m0, %0" : "=&s"(keep) : "v"(g), "s"(dst) : "memory"); }
template <int N> DI void dev_vmwait() { asm volatile("s_waitcnt vmcnt(%0)" ::"n"(N) : "memory"); }
DI void dev_bar() { asm volatile("s_waitcnt lgkmcnt(0)" ::: "memory"); __builtin_amdgcn_s_barrier(); asm volatile("" ::: "memory"); }
DI float dev_exp2(float x) { return __builtin_amdgcn_exp2f(x); }
DI float dev_rsqrt(float x) { return __builtin_amdgcn_rsqf(x); }
DI float dev_rcp(float x) { return __builtin_amdgcn_rcpf(x); }
DI unsigned dev_atomic_add(unsigned* p, unsigned v) { return __hip_atomic_fetch_add(p, v, __ATOMIC_RELAXED, __HIP_MEMORY_SCOPE_AGENT); }
DI unsigned dev_atomic_load(const unsigned* p) { return __hip_atomic_load(p, __ATOMIC_RELAXED, __HIP_MEMORY_SCOPE_AGENT); }
DI int dev_lds_add(int* p, int v) { return __hip_atomic_fetch_add(p, v, __ATOMIC_RELAXED, __HIP_MEMORY_SCOPE_WORKGROUP); }
#endif

DI float sum16(float v) {
  v += dev_dpp<0xB1>(v); v += dev_dpp<0x4E>(v); v += dev_dpp<0x141>(v); v += dev_dpp<0x140>(v);
  return v;
}
#ifdef EMU
DI float dev_swapsum16(float v) { return v + dev_shfl_xor(v, 16); }
DI float dev_swapsum32(float v) { return v + dev_shfl_xor(v, 32); }
#else
DI float dev_swapsum16(float v) { auto rr = __builtin_amdgcn_permlane16_swap(__float_as_uint(v), __float_as_uint(v), false, false); return __uint_as_float(rr[0]) + __uint_as_float(rr[1]); }
DI float dev_swapsum32(float v) { auto rr = __builtin_amdgcn_permlane32_swap(__float_as_uint(v), __float_as_uint(v), false, false); return __uint_as_float(rr[0]) + __uint_as_float(rr[1]); }
#endif
DI float wave_sum(float v) { v = sum16(v); v = dev_swapsum16(v); v = dev_swapsum32(v); return v; }
DI float sum8(float v) {
  v += dev_dpp<0xB1>(v); v += dev_dpp<0x4E>(v); v += dev_dpp<0x141>(v);
  return v;
}
DI float sigmoidf_(float x) { return dev_rcp(1.0f + __expf(-x)); }
DI float siluf_(float x) { return x * dev_rcp(1.0f + __expf(-x)); }
DI float softplusf_(float x) { return x > 20.f ? x : log1pf(__expf(x)); }

typedef const float* cfptr_t;
#ifdef EMU
struct Params { cfptr_t in_[N_IN]; float* out; unsigned char* ws; DI cfptr_t in(int i) const { return in_[i]; } };
#else
struct Params { LAS cfptr_t* in_; float* out; unsigned char* ws;
  DI cfptr_t in(int i) const { const unsigned long long v = (unsigned long long)in_[i]; const unsigned lo = __builtin_amdgcn_readfirstlane((unsigned)v), hi = __builtin_amdgcn_readfirstlane((unsigned)(v >> 32));
    return (cfptr_t)(((unsigned long long)hi << 32) | lo); } };
#endif
template <class Tp> DI Tp* wsp(const Params& p, size_t off) { return (Tp*)(p.ws + off); }

DI int row_batch(int m) { return m < TL ? m / T : (m - TL) / C; }
DI int row_kpos(int m) { return m < TL ? m % T : T + (m - TL) % C; }
DI int kpos_row(int b, int kpos) { return kpos < T ? b * T + kpos : TL + b * C + (kpos - T); }
#ifndef EMU
namespace pg8 {
#define PG8_LAS __attribute__((address_space(3)))
typedef unsigned short bf16_t;
typedef short bf16x8 __attribute__((ext_vector_type(8)));
typedef float f32x4 __attribute__((ext_vector_type(4)));
typedef unsigned u32x4 __attribute__((ext_vector_type(4)));
constexpr int BM = 256, BK = 64, HALF = 128, HTB = HALF * BK * 2  , STAGE_BYTES = 8 * HTB, NXCD = 8, WGM = 8;

__host__ __device__ __forceinline__ int lds_byte(int r, int c) { const int st = (r >> 4) * 2 + (c >> 5), rr = r & 15, cc = c & 31, ob = rr * 64 + cc * 2; return st * 1024 + (ob ^ (((ob >> 9) & 1) << 5)); }
__host__ __device__ __forceinline__ void stage_rc(int b, int& R, int& C) { const int st = b / 1024, sb = b % 1024, swz = sb ^ (((sb >> 9) & 1) << 5); R = (st >> 1) * 16 + swz / 64; C = (st & 1) * 32 + (swz % 64) / 2; }
__host__ __device__ __forceinline__ int perm32(int rho) { const int n = rho >> 4, i = rho & 15; return 8 * (i >> 2) + 4 * n + (i & 3); }

struct Unit { int pm, pn, pc, ko, ks; };
struct Gemm { const bf16_t* A; const bf16_t* Bt; int M, N, K; int ld = 0; };

struct StaticOrder {
    int nM, nN, nwg, G, c;
    __host__ __device__ void init(int M, int N, int G_, int c_) { nM = M / BM; nN = N / BM; nwg = nM * nN; G = G_; c = c_; }
    __host__ __device__ bool next(int i, Unit& u) const {
        const long L = (long)i * G + c; if (L >= nwg) return false;
        int wgid = (int)L; { const int q = nwg / NXCD, r = nwg % NXCD, xcd = wgid % NXCD, off = wgid / NXCD; wgid = (xcd < r ? xcd * (q + 1) : r * (q + 1) + (xcd - r) * q) + off; }
        const int nig = WGM * nN, gid = wgid / nig, fm = gid * WGM, gsz = (nM - fm) < WGM ? (nM - fm) : WGM;
        u.pm = fm + ((wgid % nig) % gsz); u.pn = (wgid % nig) / gsz; u.pc = u.pn; u.ko = 0; u.ks = 0; return true;
    }
    __device__ __forceinline__ void a_ready(const Unit&) const {}
    __device__ __forceinline__ void done(const Unit&) const {}
};

template <class Epi, class Sched, bool ALIGN_EPI = false, bool SP2 = false>
__device__ __forceinline__ void gemm_phase(PG8_LAS unsigned char* lds, const Gemm g, const Sched& S, const Epi& E) {
    int tid_ = threadIdx.x; asm volatile("" : "+v"(tid_));
    const int tid = tid_, wid = __builtin_amdgcn_readfirstlane(tid >> 6), lane = tid & 63, wr = wid >> 2, wc = wid & 3, fr = lane & 15, fq = lane >> 4;
    const int K = g.K, nt = K / BK, LD = g.ld ? g.ld : g.K;
    unsigned voffA[2], voffB[2];
#pragma unroll
    for (int i = 0; i < 2; ++i) { int R, C; stage_rc(tid * 16 + i * 8192, R, C); const int Rb = Epi::PERM ? ((R & ~31) + perm32(R & 31)) : R;
        voffA[i] = (unsigned)(R * LD + C) * 2u; voffB[i] = (unsigned)(Rb * LD + C) * 2u; }
    const size_t kstep = (size_t)(BK * 2);
    const size_t hstep = (size_t)HALF * LD * 2;
    const size_t tstep = 2 * hstep;
    const unsigned ldsw = (unsigned)wid * 1024u;
    const int aoff = lds_byte(wr * 64 + fr, fq * 8), boff = lds_byte(wc * 32 + fr, fq * 8);
#define PG8_SA(b, h) (((b) * 2 + (h)) * HTB)
#define PG8_SB(b, h) ((4 + (b) * 2 + (h)) * HTB)
#define PG8_STAGE(bufoff, gbase, voff) do { _Pragma("unroll") for (int _i = 0; _i < 2; ++_i) \
        __builtin_amdgcn_global_load_lds((const unsigned*)((const char*)(gbase) + (voff)[_i]), (PG8_LAS unsigned*)(lds + (bufoff) + ldsw + _i * 8192), 16, 0, 0); } while (0)
#define PG8_LDA(dst, b, h) do { _Pragma("unroll") for (int m = 0; m < 4; ++m) _Pragma("unroll") for (int k = 0; k < 2; ++k) dst[m][k] = *(const PG8_LAS bf16x8*)(lds + PG8_SA(b, h) + aoff + m * 2048 + k * 1024); } while (0)
#define PG8_LDB(dst, b, h) do { _Pragma("unroll") for (int n = 0; n < 2; ++n) _Pragma("unroll") for (int k = 0; k < 2; ++k) dst[n][k] = *(const PG8_LAS bf16x8*)(lds + PG8_SB(b, h) + boff + n * 2048 + k * 1024); } while (0)
#define PG8_MMA(ai, bj, At, Bt) do { __builtin_amdgcn_s_setprio(1); _Pragma("unroll") for (int m = 0; m < 4; ++m) _Pragma("unroll") for (int n = 0; n < 2; ++n) _Pragma("unroll") for (int k = 0; k < 2; ++k) \
        acc[ai][bj][m][n] = __builtin_amdgcn_mfma_f32_16x16x32_bf16(Bt[n][k], At[m][k], acc[ai][bj][m][n], 0, 0, 0); __builtin_amdgcn_s_setprio(0); } while (0)
#define PG8_WAIT_V(n) asm volatile("s_waitcnt vmcnt(" #n ")" ::: "memory")
#define PG8_WAIT_L(n) asm volatile("s_waitcnt lgkmcnt(" #n ")" ::: "memory")
#define PG8_BAR __builtin_amdgcn_s_barrier()
#define PG8_SCHED __builtin_amdgcn_sched_barrier(0)
    Unit cur, nxt; int ui = 0;
    if (!S.next(0, cur)) return;
    f32x4 acc[2][2][4][2];
#pragma unroll
    for (int a = 0; a < 2; ++a)
#pragma unroll
        for (int b = 0; b < 2; ++b)
#pragma unroll
            for (int m = 0; m < 4; ++m)
#pragma unroll
                for (int n = 0; n < 2; ++n) acc[a][b][m][n] = (f32x4){0.f, 0.f, 0.f, 0.f};
    bf16x8 At[4][2], B0[2][2], B1[2][2];
    const char* cA = (const char*)g.A + (size_t)cur.pm * tstep + (size_t)cur.ko * 2; const char* cB = (const char*)g.Bt + (size_t)cur.pn * tstep + (size_t)cur.ko * 2;
    S.a_ready(cur);
    if constexpr (SP2) {
        PG8_STAGE(PG8_SB(0, 0), cB, voffB); PG8_STAGE(PG8_SB(0, 1), cB + hstep, voffB); PG8_STAGE(PG8_SA(0, 0), cA, voffA); PG8_STAGE(PG8_SA(0, 1), cA + hstep, voffA);
        if (wr == 1) PG8_BAR;
        PG8_WAIT_V(2); PG8_BAR;
        PG8_STAGE(PG8_SB(1, 0), cB + kstep, voffB); PG8_STAGE(PG8_SA(1, 0), cA + kstep, voffA); PG8_STAGE(PG8_SB(1, 1), cB + hstep + kstep, voffB);
        PG8_WAIT_V(6); PG8_BAR;
    } else {
        PG8_STAGE(PG8_SB(0, 0), cB, voffB); PG8_STAGE(PG8_SA(0, 0), cA, voffA); PG8_STAGE(PG8_SB(0, 1), cB + hstep, voffB); PG8_STAGE(PG8_SA(0, 1), cA + hstep, voffA);
        if (wr == 1) PG8_BAR;
        PG8_WAIT_V(4); PG8_BAR;
        PG8_STAGE(PG8_SB(1, 0), cB + kstep, voffB); PG8_STAGE(PG8_SA(1, 0), cA + kstep, voffA); PG8_STAGE(PG8_SB(1, 1), cB + hstep + kstep, voffB);
        PG8_WAIT_V(6); PG8_BAR;
    }
    for (;;) {
        const bool has_next = S.next(ui + 1, nxt);
        const char* nA = has_next ? (const char*)g.A + (size_t)nxt.pm * tstep + (size_t)nxt.ko * 2 : cA; const char* nB = has_next ? (const char*)g.Bt + (size_t)nxt.pn * tstep + (size_t)nxt.ko * 2 : cB;
        for (int t = 0; t < nt; t += 2) {
            const bool last = (t == nt - 2);
            const char* a1 = cA + (size_t)(t + 1) * kstep;
            const char* a2 = last ? nA : cA + (size_t)(t + 2) * kstep; const char* b2 = last ? nB : cB + (size_t)(t + 2) * kstep;
            const char* a3 = a2 + kstep; const char* b3 = b2 + kstep;
            if (last && has_next) S.a_ready(nxt);
            if constexpr (SP2) {
            PG8_LDB(B0, 0, 0); PG8_LDB(B1, 0, 1); PG8_SCHED; PG8_LDA(At, 0, 0); PG8_STAGE(PG8_SA(1, 1), a1 + hstep, voffA);
            PG8_WAIT_V(8); PG8_WAIT_L(0); PG8_BAR; PG8_MMA(0, 0, At, B0); PG8_MMA(0, 1, At, B1); PG8_BAR; PG8_SCHED;
            PG8_LDA(At, 0, 1); PG8_STAGE(PG8_SB(0, 0), b2, voffB); PG8_STAGE(PG8_SB(0, 1), b2 + hstep, voffB); PG8_STAGE(PG8_SA(0, 0), a2, voffA);
            PG8_WAIT_V(8); PG8_WAIT_L(0); PG8_BAR; PG8_MMA(1, 0, At, B0); PG8_MMA(1, 1, At, B1); PG8_BAR; PG8_SCHED;
            PG8_LDB(B0, 1, 0); PG8_LDB(B1, 1, 1); PG8_SCHED; PG8_LDA(At, 1, 0); PG8_STAGE(PG8_SA(0, 1), a2 + hstep, voffA);
            PG8_WAIT_V(8); PG8_WAIT_L(0); PG8_BAR; PG8_MMA(0, 0, At, B0); PG8_MMA(0, 1, At, B1); PG8_BAR; PG8_SCHED;
            PG8_LDA(At, 1, 1); PG8_STAGE(PG8_SB(1, 0), b3, voffB); PG8_STAGE(PG8_SB(1, 1), b3 + hstep, voffB); PG8_STAGE(PG8_SA(1, 0), a3, voffA);
            PG8_WAIT_V(8); PG8_WAIT_L(0); PG8_BAR; PG8_MMA(1, 0, At, B0); PG8_MMA(1, 1, At, B1); PG8_BAR; PG8_SCHED;
            } else {
            PG8_LDB(B0, 0, 0); PG8_SCHED; PG8_LDA(At, 0, 0); PG8_STAGE(PG8_SA(1, 1), a1 + hstep, voffA);
            PG8_WAIT_L(8); PG8_BAR; PG8_WAIT_L(0); PG8_MMA(0, 0, At, B0); PG8_BAR; PG8_SCHED;
            PG8_LDB(B1, 0, 1); PG8_STAGE(PG8_SB(0, 0), b2, voffB);
            PG8_BAR; PG8_WAIT_L(0); PG8_MMA(0, 1, At, B1); PG8_BAR;
            PG8_LDA(At, 0, 1); PG8_STAGE(PG8_SA(0, 0), a2, voffA);
            PG8_BAR; PG8_WAIT_L(0); PG8_MMA(1, 0, At, B0); PG8_BAR; PG8_SCHED;
            PG8_STAGE(PG8_SB(0, 1), b2 + hstep, voffB);
            PG8_WAIT_V(6); PG8_BAR; PG8_MMA(1, 1, At, B1); PG8_BAR;
            PG8_LDB(B0, 1, 0); PG8_SCHED; PG8_LDA(At, 1, 0); PG8_STAGE(PG8_SA(0, 1), a2 + hstep, voffA);
            PG8_WAIT_L(8); PG8_BAR; PG8_WAIT_L(0); PG8_MMA(0, 0, At, B0); PG8_BAR; PG8_SCHED;
            PG8_LDB(B1, 1, 1); PG8_STAGE(PG8_SB(1, 0), b3, voffB);
            PG8_BAR; PG8_WAIT_L(0); PG8_MMA(0, 1, At, B1); PG8_BAR;
            PG8_LDA(At, 1, 1); PG8_STAGE(PG8_SA(1, 0), a3, voffA);
            PG8_BAR; PG8_WAIT_L(0); PG8_MMA(1, 0, At, B0); PG8_BAR; PG8_SCHED;
            PG8_STAGE(PG8_SB(1, 1), b3 + hstep, voffB);
            PG8_WAIT_V(6); PG8_BAR; PG8_MMA(1, 1, At, B1); PG8_BAR;
            }
        }
        if constexpr (ALIGN_EPI) { if (wr == 0) PG8_BAR; }
        if constexpr (!Epi::AFTER_DRAIN) { E(acc, cur, wr, wc, fr, fq); S.done(cur); }
        if (!has_next) break;
#pragma unroll
        for (int a = 0; a < 2; ++a)
#pragma unroll
            for (int b = 0; b < 2; ++b)
#pragma unroll
                for (int m = 0; m < 4; ++m)
#pragma unroll
                    for (int n = 0; n < 2; ++n) acc[a][b][m][n] = (f32x4){0.f, 0.f, 0.f, 0.f};
        cur = nxt; cA = nA; cB = nB; ++ui;
        if constexpr (ALIGN_EPI) { if (wr == 1) PG8_BAR; }
    }
    PG8_WAIT_V(0);
    if constexpr (!ALIGN_EPI) { if (wr == 0) PG8_BAR; }
    PG8_BAR;
    if constexpr (Epi::AFTER_DRAIN) { E.fused(acc, cur, wr, wc, fr, fq, lds, wid, lane); S.done(cur); }
#undef PG8_SA
#undef PG8_SB
#undef PG8_STAGE
#undef PG8_LDA
#undef PG8_LDB
#undef PG8_MMA
#undef PG8_WAIT_V
#undef PG8_WAIT_L
#undef PG8_BAR
#undef PG8_SCHED
}
}
#define XB_TMO      128
#define XB_XCNT(j)  (256  + 64 * (j))
#define XB_XSUB(j)  (1280 + 64 * (j))
#define XB_XGEN(j)  (2304 + 64 * (j))
#define XB_TOP      3328
#define XB_TOPGEN   3392
#define XCD_BAR_WORDS 3456
#define XB_SPIN_CAP (1u << 18)

__device__ __forceinline__ unsigned xb_ld(unsigned* p)              { return __hip_atomic_load(p, __ATOMIC_RELAXED, __HIP_MEMORY_SCOPE_AGENT); }
__device__ __forceinline__ unsigned xb_add(unsigned* p, unsigned v) { return __hip_atomic_fetch_add(p, v, __ATOMIC_RELAXED, __HIP_MEMORY_SCOPE_AGENT); }
__device__ __forceinline__ unsigned xb_xcc_id() { return (unsigned)__builtin_amdgcn_s_getreg((3 << 11) | 20) & 0xFu; }
#define XB_SPIN(cond, bar) do { unsigned _sp = 0; while (cond) { __builtin_amdgcn_s_sleep(1); \
    if ((++_sp & 255u) == 0u) { if (xb_ld(&(bar)[XB_TMO])) break; if (_sp > XB_SPIN_CAP) { atomicAdd(&(bar)[XB_TMO], 1u); break; } } } } while (0)

struct XcdBarrier {
    unsigned* bar; unsigned x;
    volatile LAS unsigned* st;
};

__device__ __forceinline__ XcdBarrier xcd_barrier_post(unsigned* bar, volatile LAS unsigned* st) {
    XcdBarrier b; b.bar = bar; b.x = xb_xcc_id(); b.st = st;
    if (threadIdx.x == 0) (void)xb_add(&bar[XB_XCNT(b.x)], 1u);
    return b;
}
__device__ __forceinline__ void xcd_barrier_complete(unsigned* bar, unsigned x, unsigned& nloc, unsigned& nx) {
    const unsigned G = gridDim.x * gridDim.y * gridDim.z;
    unsigned sum, cnt, mine, sp = 0u;
    for (;;) {
        sum = 0u; cnt = 0u; mine = 0u;
#pragma unroll
        for (unsigned j = 0; j < 16; ++j) { const unsigned c = xb_ld(&bar[XB_XCNT(j)]); sum += c; cnt += (c > 0u) ? 1u : 0u; mine = (j == x) ? c : mine; }
        if (sum == G) break;
        __builtin_amdgcn_s_sleep(1);
        if ((++sp & 255u) == 0u) { if (xb_ld(&bar[XB_TMO])) break; if (sp > XB_SPIN_CAP) { atomicAdd(&bar[XB_TMO], 1u); break; } }
    }
    nloc = mine > 0u ? mine : 1u; nx = cnt > 0u ? cnt : 1u;
}

__device__ __forceinline__ void xcd_barrier(const XcdBarrier& b) {
    asm volatile("s_waitcnt vmcnt(0)" ::: "memory");
    __syncthreads();
    if (threadIdx.x == 0) {
        unsigned* bar = b.bar;
        __builtin_amdgcn_s_waitcnt(0);
        unsigned nloc = b.st[0], nx = b.st[1];
        if (nloc == 0u) { xcd_barrier_complete(bar, b.x, nloc, nx); b.st[0] = nloc; b.st[1] = nx; }
        const unsigned old = xb_add(&bar[XB_XSUB(b.x)], 1u);
        const unsigned gen = old / nloc;
        if (old + 1u == (gen + 1u) * nloc) {
            __builtin_amdgcn_fence(__ATOMIC_RELEASE, "agent");
            asm volatile("s_waitcnt vmcnt(0)" ::: "memory");
            const unsigned og = xb_add(&bar[XB_TOP], 1u);
            const unsigned tg = og / nx;
            if (og + 1u == (tg + 1u) * nx) xb_add(&bar[XB_TOPGEN], 1u);
            else XB_SPIN(xb_ld(&bar[XB_TOPGEN]) == tg, bar);
            __builtin_amdgcn_fence(__ATOMIC_ACQUIRE, "agent");
            xb_add(&bar[XB_XGEN(b.x)], 1u);
            asm volatile("s_waitcnt vmcnt(0)" ::: "memory");
        } else {
            XB_SPIN(xb_ld(&bar[XB_XGEN(b.x)]) == gen, bar);
            __builtin_amdgcn_fence(__ATOMIC_ACQUIRE, "agent");
            asm volatile("s_waitcnt vmcnt(0)" ::: "memory");
        }
    }
    __syncthreads();
}
#endif
#ifndef PROBE_REP
#define PROBE_REP 0
#endif
#define NWAVES 8
#ifdef EMU
#define TID ((int)threadIdx.x)
#else
DI int tid_fresh() { int t = threadIdx.x; asm volatile("" : "+v"(t)); return t; }
#define TID tid_fresh()
#endif
#define GWAVE dev_uniform((int)blockIdx.x * NWAVES + (TID >> 6))
#define NGWAVE ((int)gridDim.x * NWAVES)

struct TItem { const float* W; bf16_t* WT; int K, N, kind, k0, n0; };
DI int titem_row(const TItem& t, int n) { if (t.kind == 0) return n; if (t.kind == 1) return 2 * n; if (t.kind == 2) return 2 * n + 1;
  const int hd = n / 96, dd = n % 96; if (dd < 64) return n; const int i = dd - 64; return hd * 96 + 64 + (i < 16 ? 2 * i : 2 * (i - 16) + 1); }
DI void titem_set(TItem& t, const float* W, int K, int N, bf16_t* WT, int kind, int item) { t.W = W; t.WT = WT; t.K = K; t.N = N; t.kind = kind; const int nblk = N / 32; t.k0 = 64 * (item / nblk); t.n0 = 32 * (item % nblk); }
DI void titem_load(const TItem& t, int lane, float (&v)[32]) {
#pragma unroll
  for (int i = 0; i < 32; ++i) v[i] = t.W[(size_t)(t.k0 + 2 * i + (lane >> 5)) * t.N + t.n0 + (lane & 31)];
}
DI void titem_stage(float* scr, int lane, const float (&v)[32]) {
#pragma unroll
  for (int i = 0; i < 32; ++i) scr[(2 * i + (lane >> 5)) * 33 + (lane & 31)] = v[i];
  dev_wave_fence();
}
DI void titem_finish(const TItem& t, const float* scr, int lane) {
  const int c = lane & 7;
#pragma unroll
  for (int j = 0; j < 4; ++j) { const int n = (lane >> 3) + 8 * j; const float* s = scr + (8 * c) * 33 + n;
    u32x4 o; o.x = pk2(s[0 * 33], s[1 * 33]); o.y = pk2(s[2 * 33], s[3 * 33]); o.z = pk2(s[4 * 33], s[5 * 33]); o.w = pk2(s[6 * 33], s[7 * 33]);
    *(u32x4*)(t.WT + (size_t)titem_row(t, t.n0 + n) * t.K + t.k0 + 8 * c) = o; }
  dev_wave_fence();
}
template <class Decode> DI void transpose_items(int first, int total, int stride, Decode decode, float* scr, int lane) {
  if (first >= total) return;
  TItem cur, nxt; float v[32]; decode(first, cur); titem_load(cur, lane, v);
  for (int it = first; it < total; it += stride) {
    titem_stage(scr, lane, v);
    const bool more = it + stride < total;
    if (more) { decode(it + stride, nxt); titem_load(nxt, lane, v); }
    titem_finish(cur, scr, lane);
    cur = nxt;
  }
}

DI void phase_prologue(const Params& p, char* smem) {
  const int lane = TID & 63, wave = TID >> 6;
  float* scr = (float*)(smem + wave * 8704);
  const int gw = GWAVE, ngw = NGWAVE;
  constexpr int I_IN = (D / 64) * (2720 / 32), I_OUT = (D / 64) * (D / 32), I_G = (D / 64) * (FF / 32), I_DN = (FF / 64) * (D / 32), I_UQ = (256 / 64) * (384 / 32), I_UKV = (128 / 64) * (512 / 32);
  constexpr int NITEMS = 2 * I_IN + 2 * I_OUT + 2 * I_G + I_DN + 2 * I_UQ + 2 * I_UKV;
  auto decode = [&](int it, TItem& t) { int r = it;
    if (r < 2 * I_IN) { const int l = r / I_IN; titem_set(t, p.in(I_WIN) + (size_t)l * D * 2720, D, 2720, wsp<bf16_t>(p, WS_WIN) + (size_t)l * PW * D, 0, r % I_IN); return; } r -= 2 * I_IN;
    if (r < 2 * I_OUT) { const int l = r / I_OUT; titem_set(t, p.in(I_WOUT) + (size_t)l * D * D, D, D, wsp<bf16_t>(p, WS_WOUT) + (size_t)l * D * D, 0, r % I_OUT); return; } r -= 2 * I_OUT;
    if (r < I_G) { titem_set(t, p.in(I_FG), D, FF, wsp<bf16_t>(p, WS_WGU), 1, r); return; } r -= I_G;
    if (r < I_G) { titem_set(t, p.in(I_FU), D, FF, wsp<bf16_t>(p, WS_WGU), 2, r); return; } r -= I_G;
    if (r < I_DN) { titem_set(t, p.in(I_FD), FF, D, wsp<bf16_t>(p, WS_WDN), 0, r); return; } r -= I_DN;
    if (r < 2 * I_UQ) { const int l = r / I_UQ; titem_set(t, p.in(I_WUQ) + (size_t)l * 256 * 384, 256, 384, wsp<bf16_t>(p, WS_WUQ) + (size_t)l * 512 * 256, 3, r % I_UQ); return; } r -= 2 * I_UQ;
    { const int l = r / I_UKV; titem_set(t, p.in(I_WUKV) + (size_t)l * 128 * 512, 128, 512, wsp<bf16_t>(p, WS_WUKV) + (size_t)l * 512 * 128, 0, r % I_UKV); } };
  transpose_items(gw, NITEMS, ngw, decode, scr, lane);
  const int gt = (int)blockIdx.x * 512 + TID, ngt = (int)gridDim.x * 512;
  { constexpr int LI = 16;
    auto dec2 = [&](int it, TItem& t) { const int l = it / (3 * LI), kind = (it / LI) % 3, j = it % LI; bf16_t* WL = wsp<bf16_t>(p, WS_WLORA) + (size_t)l * 1280 * 256;
      if (kind == 0) { const int d = j >> 3; titem_set(t, p.in(I_WUP) + (size_t)(l * 2 + d) * 64 * 256, 256, 256, WL + (size_t)(d * 256) * 256, 0, j & 7); }
      else if (kind == 1) { const int d = j >> 3; titem_set(t, p.in(I_AUP) + (size_t)(l * 2 + d) * 64 * 256, 256, 256, WL + (size_t)(512 + d * 256) * 256 + 64, 0, j & 7); }
      else { titem_set(t, p.in(I_GUP) + (size_t)l * 128 * 256, 256, 256, WL + (size_t)1024 * 256 + 128, 0, j); } };
    transpose_items(gw, 2 * 3 * LI, ngw, dec2, scr, lane);
    for (int e = gt; e < 2 * 1280 * 32; e += ngt) { const int l = e / (1280 * 32), n = (e / 32) % 1280, c = e % 32, k = 8 * c;
      const bool data = n < 512 ? k < 64 : (n < 1024 ? (k >= 64 && k < 128) : k >= 128);
      if (!data) *(u32x4*)(wsp<bf16_t>(p, WS_WLORA) + ((size_t)l * 1280 + n) * 256 + k) = (u32x4){0u, 0u, 0u, 0u}; } }
  for (int e = gt; e < T * 32; e += ngt) { const int t = e / 32, i = e % 32; const float pos = (i < 16) ? (float)(t / GW) : (float)(t % GW);
    const float invf = exp2f(-(float)(i & 15) / 16.0f * 13.287712379549449f); const float ang = pos * invf;
    wsp<float>(p, WS_TABG)[2 * e] = cosf(ang); wsp<float>(p, WS_TABG)[2 * e + 1] = sinf(ang); }
  for (int e = gt; e < T * 16; e += ngt) { const int t = e / 16, i = e % 16; const float pos = (i < 8) ? (float)(t / GW) : (float)(t % GW);
    const float invf = exp2f(-(float)(i & 7) / 8.0f * 13.287712379549449f); const float ang = pos * invf;
    wsp<float>(p, WS_TABM)[2 * e] = cosf(ang); wsp<float>(p, WS_TABM)[2 * e + 1] = sinf(ang); }
  __syncthreads();
  float* sc = (float*)smem;
  float* red = (float*)(smem + (NB + 1) * D * 4);
  for (int e = TID; e < (NB + 1) * D; e += 512) { const int s = e / D, k = e % D; sc[e] = siluf_(s < NB ? p.in(I_C)[s * D + k] : p.in(I_CCTX)[k]); }
  __syncthreads();
  for (int u = (int)blockIdx.x; u < 2 * 96; u += (int)gridDim.x) {
    const int l = u / 96, jb = (u % 96) * 64, jq = TID & 15, kg = TID >> 4;
    f32x4 acc[NB + 1];
#pragma unroll
    for (int s = 0; s <= NB; ++s) acc[s] = (f32x4){0.f, 0.f, 0.f, 0.f};
    const float* W = p.in(I_MODW) + (size_t)l * D * 6144 + jb + 4 * jq + (size_t)(kg * 32) * 6144;
#pragma unroll
    for (int h0 = 0; h0 < 32; h0 += 16) { f32x4 w[16];
#pragma unroll
      for (int i = 0; i < 16; ++i) w[i] = *(const f32x4*)(W + (size_t)(h0 + i) * 6144);
#pragma unroll
      for (int i = 0; i < 16; ++i) { const int k = kg * 32 + h0 + i;
#pragma unroll
        for (int s = 0; s <= NB; ++s) acc[s] += w[i] * sc[s * D + k]; } }
#pragma unroll
    for (int s = 0; s <= NB; ++s) *(f32x4*)(red + (kg * (NB + 1) + s) * 64 + 4 * jq) = acc[s];
    __syncthreads();
    if (TID < 64 * (NB + 1)) { const int s = TID / 64, jj = TID & 63; float t = 0.f;
#pragma unroll 8
      for (int g = 0; g < 32; ++g) t += red[(g * (NB + 1) + s) * 64 + jj];
      const int jc = jb + jj; wsp<float>(p, WS_MOD)[((size_t)l * (NB + 1) + s) * 6144 + jc] = t + p.in(I_MODB)[l * 6144 + jc]; }
    __syncthreads();
  }
}

DI void moe_convert(const Params& p, char* smem) {
  const int lane = TID & 63, wave = TID >> 6; float* scr = (float*)(smem + wave * 8704);
  constexpr int I_G = (D / 64) * (FF / 32), I_DN = (FF / 64) * (D / 32);
  auto decode = [&](int it, TItem& t) { const int e = it / (2 * I_G + I_DN); int r = it % (2 * I_G + I_DN);
    if (r < I_G) { titem_set(t, p.in(I_MG) + (size_t)e * D * FF, D, FF, wsp<bf16_t>(p, A_MWGU) + (size_t)e * 2 * FF * D, 1, r); return; } r -= I_G;
    if (r < I_G) { titem_set(t, p.in(I_MU2) + (size_t)e * D * FF, D, FF, wsp<bf16_t>(p, A_MWGU) + (size_t)e * 2 * FF * D, 2, r); return; } r -= I_G;
    titem_set(t, p.in(I_MD) + (size_t)e * FF * D, FF, D, wsp<bf16_t>(p, A_MWDN) + (size_t)e * D * FF, 0, r); };
  transpose_items(GWAVE, NE * (2 * I_G + I_DN), NGWAVE, decode, scr, lane);
}

constexpr int RW_NR = 4;
DI const float* mod_ptr(const Params& p, int l, int m, int chunk) { const int s = m < TL ? m / T : NB; return wsp<float>(p, WS_MOD) + ((size_t)l * (NB + 1) + s) * 6144 + chunk * 1024; }
DI void load_row4(const float* src, int lane, f32x4 (&v)[4]) {
#pragma unroll
  for (int j = 0; j < 4; ++j) v[j] = *(const f32x4*)(src + 4 * lane + 256 * j);
}
DI void load_row4_bf(const bf16_t* src, int lane, f32x4 (&v)[4]) {
#pragma unroll
  for (int j = 0; j < 4; ++j) { const u32x2 u = *(const u32x2*)(src + 4 * lane + 256 * j); v[j] = (f32x4){bf2f(u.x & 0xffffu), bf2f(u.x >> 16), bf2f(u.y & 0xffffu), bf2f(u.y >> 16)}; }
}
DI float sumsq4(const f32x4 (&v)[4]) { float s = 0.f;
#pragma unroll
  for (int j = 0; j < 4; ++j) s += (v[j].x * v[j].x + v[j].y * v[j].y) + (v[j].z * v[j].z + v[j].w * v[j].w);
  return s; }
DI void adaln_store(const f32x4 (&v)[4], float rinv, const float* gain, const float* scale, const float* shift, bf16_t* dst, int lane) {
#pragma unroll
  for (int j = 0; j < 4; ++j) { const int c = 4 * lane + 256 * j; const f32x4 g = *(const f32x4*)(gain + c), sc = *(const f32x4*)(scale + c), sh = *(const f32x4*)(shift + c);
    const f32x4 h = v[j] * rinv * g * (sc + 1.0f) + sh; u32x2 o; o.x = pk2(h.x, h.y); o.y = pk2(h.z, h.w); *(u32x2*)(dst + c) = o; }
}
DI void phase_adaln0(const Params& p) {
  const int lane = TID & 63; const int ngw = NGWAVE; const int m0 = GWAVE;
  auto src = [&](int r) { return r < TL ? p.in(I_X) + (size_t)r * D : p.in(I_CTX) + (size_t)(r - TL) * D; };
  for (int mb = m0; mb < MT; mb += 4 * ngw) {
    f32x4 v[4][4];
#pragma unroll
    for (int q = 0; q < 4; ++q) { const int m = mb + q * ngw; if (m < MT) load_row4(src(m), lane, v[q]); }
#pragma unroll
    for (int q = 0; q < 4; ++q) { const int m = mb + q * ngw; if (m < MT) {
      const float rinv = dev_rsqrt(wave_sum(sumsq4(v[q])) * (1.0f / D) + RMS_EPS);
      adaln_store(v[q], rinv, p.in(I_NORMG) + 0 * D, mod_ptr(p, 0, m, 1), mod_ptr(p, 0, m, 0), wsp<bf16_t>(p, A_XN) + (size_t)m * D, lane); } }
  }
}

DI f32x4 ldp4(const bf16_t* row, int c) { const u32x2 u = *(const u32x2*)(row + c); return (f32x4){bf2f(u.x & 0xffffu), bf2f(u.x >> 16), bf2f(u.y & 0xffffu), bf2f(u.y >> 16)}; }
DI float tanh_fast(float x) { return 1.0f - 2.0f * dev_rcp(1.0f + __expf(2.0f * x)); }
DI void st4bf(bf16_t* dst, f32x4 v) { u32x2 o; o.x = pk2(v.x, v.y); o.y = pk2(v.z, v.w); *(u32x2*)dst = o; }
struct PrepRaw { u32x2 x[4], xp[4], xn[4], q, k, cq, ck; };
DI f32x4 up4(u32x2 u) { return (f32x4){bf2f(u.x & 0xffffu), bf2f(u.x >> 16), bf2f(u.y & 0xffffu), bf2f(u.y >> 16)}; }
DI void prep_load(const bf16_t* P, int m, int lane, PrepRaw& r) {
  const bf16_t* row = P + (size_t)m * PW; const bool lat = m < TL; const int pos = lat ? m % T : (m - TL) % C, seqlen = lat ? T : C; const bool hasp = pos > 0, hasn = pos + 1 < seqlen;
#pragma unroll
  for (int j = 0; j < 4; ++j) { const int c = 4 * lane + 256 * j; r.x[j] = *(const u32x2*)(row + c); r.xp[j] = hasp ? *(const u32x2*)(row - PW + c) : (u32x2){0u, 0u}; r.xn[j] = hasn ? *(const u32x2*)(row + PW + c) : (u32x2){0u, 0u}; }
  r.q = *(const u32x2*)(row + 1024 + 4 * lane); r.k = *(const u32x2*)(row + 1280 + 4 * lane); r.cq = *(const u32x2*)(row + 1536 + 4 * lane);
  r.ck = *(const u32x2*)(row + 1792 + 4 * (lane & 31) + (lane >= 32 ? 128 : 0));
}
DI void phase_prep(const Params& p, int l) {
  const int lane = TID & 63; const bf16_t* P = wsp<bf16_t>(p, A_P); const int ngw = NGWAVE; int m = GWAVE; if (m >= MT) return;
  PrepRaw nraw; prep_load(P, m, lane, nraw);
  for (; m < MT; m += ngw) {
    const PrepRaw raw = nraw;
    if (m + ngw < MT) prep_load(P, m + ngw, lane, nraw);
    const int b = row_batch(m), kpos = row_kpos(m); const bool lat = m < TL; const int t = lat ? m % T : 0;
    f32x4 rw[4];
#pragma unroll
    for (int j = 0; j < 4; ++j) { const int c = 4 * lane + 256 * j; const f32x4 x = up4(raw.x[j]), xp = up4(raw.xp[j]), xn = up4(raw.xn[j]);
      const f32x4 mu = *(const f32x4*)(p.in(I_MU) + l * 1024 + c); rw[j] = x + mu * ((xp + xn) * 0.5f - x); }
    const int hd = lane >> 4, dd = 4 * (lane & 15);
    { const f32x4 kkw = *(const f32x4*)(p.in(I_KK) + l * 256 + 4 * lane); f32x4 kk = rw[1] * kkw;
      const float ss = sum16((kk.x * kk.x + kk.y * kk.y) + (kk.z * kk.z + kk.w * kk.w)); kk = kk * dev_rsqrt(ss + 1e-12f);
      bf16_t* scs = wsp<bf16_t>(p, A_SCS) + ((size_t)(b * 4 + hd) * NK + kpos) * 192;
      st4bf(scs + dd, rw[0]); st4bf(scs + 64 + dd, rw[2]); st4bf(scs + 128 + dd, kk);
      st4bf(wsp<bf16_t>(p, A_KSH) + (size_t)m * 256 + 4 * lane, rw[1]);
      f32x4 a; const f32x4 x = rw[3];
      if (lane < 16) a = (f32x4){tanh_fast(x.x), tanh_fast(x.y), tanh_fast(x.z), tanh_fast(x.w)};
      else if (lane < 32) a = x;
      else a = (f32x4){sigmoidf_(x.x), sigmoidf_(x.y), sigmoidf_(x.z), sigmoidf_(x.w)};
      st4bf(wsp<bf16_t>(p, A_RWA) + (size_t)m * 256 + 4 * lane, a); }
    { f32x4 q = up4(raw.q); const float ss = sum16((q.x * q.x + q.y * q.y) + (q.z * q.z + q.w * q.w));
      q = q * (dev_rsqrt(ss * (1.0f / 64.0f) + RMS_EPS) * (0.125f * LOG2E)) * *(const f32x4*)(p.in(I_GQG) + l * 64 + dd);
      if (lat) { f32x4 o; const bool lo = (lane & 15) < 8; const int i0 = dd & 31; const float* tab = wsp<float>(p, WS_TABG) + ((size_t)t * 32 + i0) * 2;
#pragma unroll
        for (int e = 0; e < 4; ++e) { const f32x4 tv = *(const f32x4*)(tab + 4 * (e >> 1)); const float mine = q[e], oth = dev_shfl_xor(q[e], 8), cs = (e & 1) ? tv.z : tv.x, sn = (e & 1) ? tv.w : tv.y; o[e] = lo ? mine * cs - oth * sn : oth * sn + mine * cs; }
        q = o; }
      st4bf(wsp<bf16_t>(p, A_QG) + (size_t)m * 256 + 4 * lane, q);
      const f32x4 k = up4(raw.k);
      const float ssk = sum16((k.x * k.x + k.y * k.y) + (k.z * k.z + k.w * k.w));
      f32x4 kn = k * dev_rsqrt(ssk * (1.0f / 64.0f) + RMS_EPS) * *(const f32x4*)(p.in(I_GKG) + l * 64 + dd);
      if (lat) { f32x4 o; const bool lo = (lane & 15) < 8; const int i0 = dd & 31; const float* tab = wsp<float>(p, WS_TABG) + ((size_t)t * 32 + i0) * 2;
#pragma unroll
        for (int e = 0; e < 4; ++e) { const f32x4 tv = *(const f32x4*)(tab + 4 * (e >> 1)); const float mine = kn[e], oth = dev_shfl_xor(kn[e], 8), cs = (e & 1) ? tv.z : tv.x, sn = (e & 1) ? tv.w : tv.y; o[e] = lo ? mine * cs - oth * sn : oth * sn + mine * cs; }
        kn = o; }
      if (lane < 32) st4bf(wsp<bf16_t>(p, A_KG) + (size_t)m * 128 + 4 * lane, kn);
 }
    { f32x4 cq = up4(raw.cq); const float ss = wave_sum((cq.x * cq.x + cq.y * cq.y) + (cq.z * cq.z + cq.w * cq.w));
      cq = cq * dev_rsqrt(ss * (1.0f / 256.0f) + RMS_EPS) * *(const f32x4*)(p.in(I_MQG) + l * 256 + 4 * lane);
      st4bf(wsp<bf16_t>(p, A_CQN) + (size_t)m * 256 + 4 * lane, cq);
      f32x4 x = up4(raw.ck);
      if (lane >= 40) x = (f32x4){0.f, 0.f, 0.f, 0.f};
      const float s2 = wave_sum(lane < 32 ? (x.x * x.x + x.y * x.y) + (x.z * x.z + x.w * x.w) : 0.f);
      if (lane < 32) { const f32x4 o = x * dev_rsqrt(s2 * (1.0f / 128.0f) + RMS_EPS) * *(const f32x4*)(p.in(I_MKVG) + l * 128 + 4 * lane); st4bf(wsp<bf16_t>(p, A_CKVN) + (size_t)m * 128 + 4 * lane, o); }
      f32x4 oth;
#pragma unroll
      for (int e = 0; e < 4; ++e) oth[e] = dev_shfl_xor(x[e], 4);
      if (lane >= 32 && lane < 36) { const int i0 = 4 * (lane - 32); f32x4 o1 = x, o2 = oth;
        if (lat) { const float* tab = wsp<float>(p, WS_TABM) + ((size_t)t * 16 + i0) * 2;
#pragma unroll
          for (int e = 0; e < 4; ++e) { const f32x4 tv = *(const f32x4*)(tab + 4 * (e >> 1)); const float cs = (e & 1) ? tv.z : tv.x, sn = (e & 1) ? tv.w : tv.y; o1[e] = x[e] * cs - oth[e] * sn; o2[e] = x[e] * sn + oth[e] * cs; } }
        u32x4 w; w.x = pk2(o1.x, o2.x); w.y = pk2(o1.y, o2.y); w.z = pk2(o1.z, o2.z); w.w = pk2(o1.w, o2.w);
#pragma unroll
        for (int h4 = 0; h4 < 4; ++h4) *(u32x4*)(wsp<bf16_t>(p, A_KM) + (size_t)m * 384 + h4 * 96 + 64 + 2 * i0) = w; } }
  }
}

struct RoRaw { f32x4 v, y[2], g; float rho[2]; };
DI void ro_load(const Params& p, int m, int lane, RoRaw& o) {
  const int hd = lane >> 4, dd = 4 * (lane & 15); const int b = row_batch(m), kpos = row_kpos(m);
  const bf16_t* scs = wsp<bf16_t>(p, A_SCS) + ((size_t)(b * 4 + hd) * NK + kpos) * 192; o.v = ldp4(scs + 64, dd);
#pragma unroll
  for (int d = 0; d < 2; ++d) { o.y[d] = ldp4(wsp<bf16_t>(p, A_YS) + ((size_t)d * MT + m) * 256, 4 * lane);
    o.rho[d] = wsp<float>(p, A_RHO)[((size_t)d * MT + m) * 4 + hd]; }
  o.g = ldp4(wsp<bf16_t>(p, A_RWG) + (size_t)m * 256, 4 * lane);
}
DI void phase_rwkv_out(const Params& p, int l) {
  const int lane = TID & 63; const int ngw = NGWAVE; const int m0 = GWAVE; const int MR = l == 0 ? MT : TL; if (m0 >= MR) return;
  const f32x4 lg = *(const f32x4*)(p.in(I_LNG) + l * 256 + 4 * lane), lb = *(const f32x4*)(p.in(I_LNB) + l * 256 + 4 * lane);
  constexpr int RO_NR = 4;
  for (int mb = m0; mb < MR; mb += RO_NR * ngw) {
    RoRaw rr[RO_NR];
#pragma unroll
    for (int q = 0; q < RO_NR; ++q) if (mb + q * ngw < MR) ro_load(p, mb + q * ngw, lane, rr[q]);
#pragma unroll
    for (int q = 0; q < RO_NR; ++q) { const int m = mb + q * ngw; if (m >= MR) continue; const RoRaw& raw = rr[q];
    f32x4 tot = {0.f, 0.f, 0.f, 0.f};
#pragma unroll
    for (int d = 0; d < 2; ++d) {
      const f32x4 y = raw.y[d];
      const float mean = sum16((y.x + y.y) + (y.z + y.w)) * (1.0f / 64.0f); const f32x4 yc = y - mean;
      const float var = sum16((yc.x * yc.x + yc.y * yc.y) + (yc.z * yc.z + yc.w * yc.w)) * (1.0f / 64.0f);
      tot += yc * dev_rsqrt(var + GN_EPS) * lg + lb + raw.v * raw.rho[d];
    }
    st4bf(wsp<bf16_t>(p, A_Y) + (size_t)m * D + 4 * lane, tot * raw.g);
    if (m < TL) {
      const int b = m / T, tq = m % T, qb = tq / 128, rq = tq % 128, hd = lane >> 4, uu = (b * 2 + (hd >> 1)) * (T / 128) + qb;
      if (uu >= GQ_UNITS - GQ_SPLIT) { const int su = uu - (GQ_UNITS - GQ_SPLIT), w = (hd & 1) * 4 + (rq >> 5), r = rq & 31;
        const size_t i0 = (size_t)((su * 2) * 8 + w), i1 = (size_t)((su * 2 + 1) * 8 + w);
        const float* s0 = wsp<float>(p, A_GST) + i0 * 64 + 2 * r; const float* s1 = wsp<float>(p, A_GST) + i1 * 64 + 2 * r;
        const float m0_ = s0[0], l0 = s0[1], m1_ = s1[0], l1 = s1[1], mx = fmaxf(m0_, m1_), w0 = l0 * dev_exp2(m0_ - mx), w1 = l1 * dev_exp2(m1_ - mx), inv = dev_rcp(w0 + w1);
        const f32x4 o0 = ldp4(wsp<bf16_t>(p, A_GPO) + i0 * 2048 + r * 64, 4 * (lane & 15)), o1 = ldp4(wsp<bf16_t>(p, A_GPO) + i1 * 2048 + r * 64, 4 * (lane & 15));
        st4bf(wsp<bf16_t>(p, A_Y) + (size_t)m * D + 256 + 4 * lane, (o0 * w0 + o1 * w1) * inv); } }
    }
  }
}

constexpr int PMX_LCNT = D * NE * 4  , PMX_RBUF = PMX_LCNT + 64, PMX_MAXR = 32;
template <int NR> DI void post_mixer_rows(const Params& p, int l, char* smem) {
  const int lane = TID & 63; const int mrows = (l == 0) ? MT : TL; const int ngw = NGWAVE; const int m0 = GWAVE;
  auto xsrc_of = [&](int r) { return (l == 0) ? (r < TL ? p.in(I_X) + (size_t)r * D : p.in(I_CTX) + (size_t)(r - TL) * D) : (const float*)(p.out + (size_t)r * D); };
  for (int mb = m0; mb < mrows; mb += NR * ngw) {
    f32x4 yv[NR][4], xv[NR][4];
#pragma unroll
    for (int q = 0; q < NR; ++q) { const int m = mb + q * ngw; if (m < mrows) {
      if (m < TL) load_row4_bf(wsp<bf16_t>(p, A_YO) + (size_t)m * D, lane, yv[q]);
      else { load_row4_bf(wsp<bf16_t>(p, A_YOS) + (size_t)(m - TL) * D, lane, yv[q]);
#pragma unroll
        for (int sl = 1; sl < OS_NS; ++sl) { f32x4 t[4]; load_row4_bf(wsp<bf16_t>(p, A_YOS) + ((size_t)sl * TC + (m - TL)) * D, lane, t);
#pragma unroll
          for (int j = 0; j < 4; ++j) yv[q][j] += t[j]; } }
      load_row4(xsrc_of(m), lane, xv[q]); } }
#pragma unroll
    for (int q = 0; q < NR; ++q) { const int m = mb + q * ngw; if (m < mrows) {
      f32x4 (&y)[4] = yv[q]; f32x4 (&x)[4] = xv[q];
      const float rinv = dev_rsqrt(wave_sum(sumsq4(y)) * (1.0f / D) + RMS_EPS);
      float* xdst = m < TL ? p.out + (size_t)m * D : wsp<float>(p, WS_XSC) + (size_t)(m - TL) * D;
      const float* g1 = p.in(I_NORMG) + (l * 4 + 1) * D; const float* gate = mod_ptr(p, l, m, 2);
#pragma unroll
      for (int j = 0; j < 4; ++j) { const int c = 4 * lane + 256 * j; x[j] = x[j] + *(const f32x4*)(gate + c) * (y[j] * rinv * *(const f32x4*)(g1 + c)); *(f32x4*)(xdst + c) = x[j]; }
      const float rinv2 = dev_rsqrt(wave_sum(sumsq4(x)) * (1.0f / D) + RMS_EPS);
      if (l == 0) { adaln_store(x, rinv2, p.in(I_NORMG) + (l * 4 + 2) * D, mod_ptr(p, l, m, 4), mod_ptr(p, l, m, 3), wsp<bf16_t>(p, A_XN) + (size_t)m * D, lane); }
      else {
        const float* g2 = p.in(I_NORMG) + (l * 4 + 2) * D; const float* sc = mod_ptr(p, l, m, 4); const float* sh = mod_ptr(p, l, m, 3);
        float lg[NE];
#pragma unroll
        for (int e = 0; e < NE; ++e) lg[e] = 0.f;
#pragma unroll
        for (int j = 0; j < 4; ++j) { const int c = 4 * lane + 256 * j; const f32x4 h = x[j] * rinv2 * *(const f32x4*)(g2 + c) * (*(const f32x4*)(sc + c) + 1.0f) + *(const f32x4*)(sh + c);
#pragma unroll
          for (int qq = 0; qq < 4; ++qq) { const float* rr = (const float*)smem + (size_t)(c + qq) * NE;
#pragma unroll
            for (int e = 0; e < NE; ++e) lg[e] += h[qq] * rr[e]; } }
#pragma unroll
        for (int e = 0; e < NE; ++e) lg[e] = wave_sum(lg[e]);
        int e0 = 0; float v0 = lg[0];
#pragma unroll
        for (int e = 1; e < NE; ++e) if (lg[e] > v0) { v0 = lg[e]; e0 = e; }
        int e1 = -1; float v1 = -3.0e38f;
#pragma unroll
        for (int e = 0; e < NE; ++e) if (e != e0 && lg[e] > v1) { v1 = lg[e]; e1 = e; }
        if (lane == 0) { int* lcnt = (int*)(smem + PMX_LCNT); int* rb = (int*)(smem + PMX_RBUF) + ((TID >> 6) * PMX_MAXR + (mb - m0) / ngw + q) * 4;
          rb[0] = e0; rb[1] = dev_lds_add(lcnt + e0, 1); rb[2] = e1; rb[3] = dev_lds_add(lcnt + e1, 1);
          float* rw = (float*)(wsp<int>(p, WS_ROUTE) + (size_t)TL * 4) + (size_t)m * 2; const float w0 = dev_rcp(1.0f + __expf(v1 - v0)); rw[0] = w0; rw[1] = 1.0f - w0; }
      } } }
  }
  if (l == 1) {
    __syncthreads();
    int* lcnt = (int*)(smem + PMX_LCNT); int* lbase = lcnt + NE;
    if (TID < NE) { const int c = lcnt[TID]; lbase[TID] = c ? (int)dev_atomic_add(wsp<unsigned>(p, WS_CTL) + CW_CNT + 64 * TID, (unsigned)c) : 0; }
    __syncthreads();
    const int nrow = m0 < mrows ? (mrows - m0 + ngw - 1) / ngw : 0;
    if (lane < nrow) { const int* rb = (const int*)(smem + PMX_RBUF) + ((TID >> 6) * PMX_MAXR + lane) * 4; int* rt = wsp<int>(p, WS_ROUTE) + (size_t)(m0 + lane * ngw) * 4;
      rt[0] = rb[0]; rt[1] = lbase[rb[0]] + rb[1]; rt[2] = rb[2]; rt[3] = lbase[rb[2]] + rb[3]; }
  }
}
DI void phase_post_mixer(const Params& p, int l, char* smem) {
  if (l == 1) { const int t0 = TID; for (int e = t0; e < D * NE / 4; e += 512) ((f32x4*)smem)[e] = ((const f32x4*)p.in(I_ROUTER))[e]; if (t0 < 2 * NE) ((int*)(smem + PMX_LCNT))[t0] = 0; __syncthreads(); }
  if (l == 0) post_mixer_rows<4>(p, l, smem); else post_mixer_rows<2>(p, l, smem);
}
DI void moe_offsets(const Params& p, int (&off)[NE + 1]) { const unsigned* cnt = wsp<unsigned>(p, WS_CTL) + CW_CNT; off[0] = 0;
#pragma unroll
  for (int e = 0; e < NE; ++e) off[e + 1] = off[e] + (int)((dev_atomic_load(cnt + 64 * e) + 255u) & ~255u); }
DI void phase_moe_gather(const Params& p, int l) {
  const int lane = TID & 63; int off[NE + 1]; moe_offsets(p, off); const int ngw = NGWAVE; const int m0 = GWAVE;
  for (int mb = m0; mb < TL; mb += RW_NR * ngw) {
    f32x4 x[RW_NR][4]; u32x4 rtv[RW_NR];
#pragma unroll
    for (int q = 0; q < RW_NR; ++q) { const int m = mb + q * ngw; if (m < TL) { load_row4(p.out + (size_t)m * D, lane, x[q]); rtv[q] = *(const u32x4*)(wsp<int>(p, WS_ROUTE) + (size_t)m * 4); } }
#pragma unroll
    for (int q = 0; q < RW_NR; ++q) { const int m = mb + q * ngw; if (m < TL) {
      const float rinv2 = dev_rsqrt(wave_sum(sumsq4(x[q])) * (1.0f / D) + RMS_EPS);
      const int e0 = (int)rtv[q].x, p0 = (int)rtv[q].y, e1 = (int)rtv[q].z, p1 = (int)rtv[q].w;
      int o0 = 0, o1 = 0;
#pragma unroll
      for (int e = 0; e < NE; ++e) { if (e == e0) o0 = off[e]; if (e == e1) o1 = off[e]; }
      adaln_store(x[q], rinv2, p.in(I_NORMG) + (l * 4 + 2) * D, mod_ptr(p, l, m, 4), mod_ptr(p, l, m, 3), wsp<bf16_t>(p, A_XG) + (size_t)(o0 + p0) * D, lane);
      adaln_store(x[q], rinv2, p.in(I_NORMG) + (l * 4 + 2) * D, mod_ptr(p, l, m, 4), mod_ptr(p, l, m, 3), wsp<bf16_t>(p, A_XG) + (size_t)(o1 + p1) * D, lane); } }
  }
}
DI void phase_post_ffn0(const Params& p) {
  const int lane = TID & 63; const int ngw = NGWAVE; const int m0 = GWAVE;
  auto xs_of = [&](int r) { return r < TL ? p.out + (size_t)r * D : wsp<float>(p, WS_XSC) + (size_t)(r - TL) * D; };
  for (int mb = m0; mb < MT; mb += RW_NR * ngw) {
    f32x4 f[RW_NR][4], x[RW_NR][4];
#pragma unroll
    for (int q = 0; q < RW_NR; ++q) { const int m = mb + q * ngw; if (m < MT) {
      if (m < TL) load_row4_bf(wsp<bf16_t>(p, A_F) + (size_t)m * D, lane, f[q]);
      else { load_row4_bf(wsp<bf16_t>(p, A_FS) + (size_t)(m - TL) * D, lane, f[q]);
#pragma unroll
        for (int sl = 1; sl < FS_NS; ++sl) { f32x4 t[4]; load_row4_bf(wsp<bf16_t>(p, A_FS) + ((size_t)sl * TC + (m - TL)) * D, lane, t);
#pragma unroll
          for (int j = 0; j < 4; ++j) f[q][j] += t[j]; } }
      load_row4(xs_of(m), lane, x[q]); } }
#pragma unroll
    for (int q = 0; q < RW_NR; ++q) { const int m = mb + q * ngw; if (m < MT) {
      const float rinv = dev_rsqrt(wave_sum(sumsq4(f[q])) * (1.0f / D) + RMS_EPS);
      float* xs = xs_of(m);
      const float* g3 = p.in(I_NORMG) + 3 * D; const float* gate = mod_ptr(p, 0, m, 5);
#pragma unroll
      for (int j = 0; j < 4; ++j) { const int c = 4 * lane + 256 * j; x[q][j] = x[q][j] + *(const f32x4*)(gate + c) * (f[q][j] * rinv * *(const f32x4*)(g3 + c)); *(f32x4*)(xs + c) = x[q][j]; }
      const float rinv2 = dev_rsqrt(wave_sum(sumsq4(x[q])) * (1.0f / D) + RMS_EPS);
      adaln_store(x[q], rinv2, p.in(I_NORMG) + 4 * D, mod_ptr(p, 1, m, 1), mod_ptr(p, 1, m, 0), wsp<bf16_t>(p, A_XN) + (size_t)m * D, lane); } }
  }
}
DI void phase_moe_combine(const Params& p, int l) {
  const int lane = TID & 63; int off[NE + 1]; moe_offsets(p, off); const bf16_t* FG = wsp<bf16_t>(p, A_XG); const int ngw = NGWAVE; const int m0 = GWAVE;
  for (int mb = m0; mb < TL; mb += RW_NR * ngw) {
    u32x2 ra[RW_NR][4], rb[RW_NR][4]; f32x4 x[RW_NR][4]; float w0[RW_NR], w1[RW_NR]; u32x4 rtv[RW_NR];
#pragma unroll
    for (int q = 0; q < RW_NR; ++q) { const int m = mb + q * ngw; if (m < TL) {
      rtv[q] = *(const u32x4*)(wsp<int>(p, WS_ROUTE) + (size_t)m * 4); const float* rw = (const float*)(wsp<int>(p, WS_ROUTE) + (size_t)TL * 4) + (size_t)m * 2; w0[q] = rw[0]; w1[q] = rw[1];
      load_row4(p.out + (size_t)m * D, lane, x[q]); } }
#pragma unroll
    for (int q = 0; q < RW_NR; ++q) { const int m = mb + q * ngw; if (m < TL) {
      const int e0 = (int)rtv[q].x, p0 = (int)rtv[q].y, e1 = (int)rtv[q].z, p1 = (int)rtv[q].w;
      int o0 = 0, o1 = 0;
#pragma unroll
      for (int e = 0; e < NE; ++e) { if (e == e0) o0 = off[e]; if (e == e1) o1 = off[e]; }
      const int s0 = o0 + p0, s1 = o1 + p1; const float* SL = wsp<float>(p, WS_MSLAB);
      auto ldrow = [&](int s, u32x2 (&r)[4]) {
        if (s < MOE_NFULL * 256) { const bf16_t* rr = FG + (size_t)s * D;
#pragma unroll
          for (int j = 0; j < 4; ++j) r[j] = *(const u32x2*)(rr + 4 * lane + 256 * j); }
        else { const float* rr = SL + (size_t)(s - MOE_NFULL * 256) * D;
#pragma unroll
          for (int j = 0; j < 4; ++j) { f32x4 t = *(const f32x4*)(rr + 4 * lane + 256 * j);
#pragma unroll
            for (int ks = 1; ks < MOE_NS; ++ks) t += *(const f32x4*)(rr + (size_t)ks * MOE_TAILROWS * D + 4 * lane + 256 * j);
            r[j].x = pk2(t.x, t.y); r[j].y = pk2(t.z, t.w); } } };
      ldrow(s0, ra[q]); ldrow(s1, rb[q]); } }
#pragma unroll
    for (int q = 0; q < RW_NR; ++q) { const int m = mb + q * ngw; if (m < TL) {
      f32x4 f[4];
#pragma unroll
      for (int j = 0; j < 4; ++j) f[j] = up4(ra[q][j]) * w0[q] + up4(rb[q][j]) * w1[q];
      const float rinv = dev_rsqrt(wave_sum(sumsq4(f)) * (1.0f / D) + RMS_EPS);
      float* xs = p.out + (size_t)m * D; const float* g3 = p.in(I_NORMG) + (l * 4 + 3) * D; const float* gate = mod_ptr(p, l, m, 5);
#pragma unroll
      for (int j = 0; j < 4; ++j) { const int c = 4 * lane + 256 * j; *(f32x4*)(xs + c) = x[q][j] + *(const f32x4*)(gate + c) * (f[j] * rinv * *(const f32x4*)(g3 + c)); } } }
  }
}

struct EpiStoreBf16 { bf16_t* O; int ld; int ncols;
  DI void store8(int urow, int row, int col, const float (&v)[8]) const { if (col >= ncols) return; u32x4 w; w.x = pk2(v[0], v[1]); w.y = pk2(v[2], v[3]); w.z = pk2(v[4], v[5]); w.w = pk2(v[6], v[7]); *(u32x4*)(O + (size_t)row * ld + col) = w; } };
struct EpiInProj { bf16_t* P; bf16_t* QKVN;
  DI void store8(int urow, int row, int col, const float (&v)[8]) const { if (col >= 2720) return; u32x4 w; w.x = pk2(v[0], v[1]); w.y = pk2(v[2], v[3]); w.z = pk2(v[4], v[5]); w.w = pk2(v[6], v[7]);
    if (col >= 1952) *(u32x4*)(QKVN + (size_t)row * 896 + (col - 1952)) = w; else if (col >= 1408 && col < 1536) *(u32x4*)(QKVN + (size_t)row * 896 + 768 + (col - 1408)) = w; else *(u32x4*)(P + (size_t)row * PW + col) = w; } };
struct EpiStoreF32 { float* O; int ld;
  DI void store8(int urow, int row, int col, const float (&v)[8]) const { float* o = O + (size_t)row * ld + col; *(f32x4*)o = (f32x4){v[0], v[1], v[2], v[3]}; *(f32x4*)(o + 4) = (f32x4){v[4], v[5], v[6], v[7]}; } };
struct EpiSwiGlu { bf16_t* O; int ld;
  DI void store8(int urow, int row, int col, const float (&v)[8]) const { u32x2 w; w.x = pk2(siluf_(v[0]) * v[1], siluf_(v[2]) * v[3]); w.y = pk2(siluf_(v[4]) * v[5], siluf_(v[6]) * v[7]); *(u32x2*)(O + (size_t)row * ld + (col >> 1)) = w; } };
struct LoraIn { u32x4 kk8, ks8; };
DI void lora_lw8(const float (&v)[8], const f32x4 wa, const f32x4 wb, f32x4& oa, f32x4& ob) {
#pragma unroll
  for (int i = 0; i < 4; ++i) { oa[i] = (-0.6065306597126334f * LOG2E) * sigmoidf_(wa[i] + v[i]); ob[i] = (-0.6065306597126334f * LOG2E) * sigmoidf_(wb[i] + v[4 + i]); } }
DI void lora_bk8(const float (&v)[8], const f32x4 (&a0v)[2], const f32x4 (&kav)[2], const LoraIn& in, u32x4& wb, u32x4& wk) { float ob[8], ok[8];
#pragma unroll
  for (int hf = 0; hf < 2; ++hf) { const f32x4 ksv = up4((u32x2){in.ks8[2 * hf], in.ks8[2 * hf + 1]}); const f32x4 kkv = up4((u32x2){in.kk8[2 * hf], in.kk8[2 * hf + 1]});
#pragma unroll
    for (int i = 0; i < 4; ++i) { const float a = sigmoidf_(a0v[hf][i] + v[4 * hf + i]); ob[4 * hf + i] = kkv[i] * a; ok[4 * hf + i] = ksv[i] * (1.0f + (a - 1.0f) * kav[hf][i]); } }
  wb.x = pk2(ob[0], ob[1]); wb.y = pk2(ob[2], ob[3]); wb.z = pk2(ob[4], ob[5]); wb.w = pk2(ob[6], ob[7]);
  wk.x = pk2(ok[0], ok[1]); wk.y = pk2(ok[2], ok[3]); wk.z = pk2(ok[4], ok[5]); wk.w = pk2(ok[6], ok[7]); }
struct EpiLora { const Params* p; int l;
  DI float* lw_dst(int blk, int b, int hd, int kpos, int dd) const { return wsp<float>(*p, A_SCD) + ((size_t)((blk * NB + b) * 4 + hd) * NK + kpos) * 192 + dd; }
  DI bf16_t* bk_dst(int d, int b, int hd, int kpos, int dd) const { return (bf16_t*)(wsp<float>(*p, A_SCD) + ((size_t)((d * NB + b) * 4 + hd) * NK + kpos) * 192 + 64) + dd; }
  DI void bk_load(int b, int hd, int kpos, int dd, int m, int cc, LoraIn& in) const { const bf16_t* kk = wsp<bf16_t>(*p, A_SCS) + ((size_t)(b * 4 + hd) * NK + kpos) * 192 + 128 + dd; const bf16_t* ks = wsp<bf16_t>(*p, A_KSH) + (size_t)m * 256 + cc;
    in.kk8 = *(const u32x4*)kk; in.ks8 = *(const u32x4*)ks; }
  DI void store8(int urow, int m, int col, const float (&v)[8]) const {
    const int blk = col >> 8, cc = col & 255, hd = cc >> 6, dd = cc & 63; const int b = row_batch(urow), kpos = row_kpos(urow) + (m - urow);
    if (blk < 2) { const float* w0 = p->in(I_W0) + (l * 2 + blk) * 256 + cc; float* dst = lw_dst(blk, b, hd, kpos, dd); f32x4 oa, ob;
      lora_lw8(v, *(const f32x4*)w0, *(const f32x4*)(w0 + 4), oa, ob); *(f32x4*)dst = oa; *(f32x4*)(dst + 4) = ob; }
    else if (blk < 4) { const int d = blk - 2; const float* a0 = p->in(I_A0) + (l * 2 + d) * 256 + cc; const float* ka = p->in(I_KA) + l * 256 + cc;
      const f32x4 a0v[2] = {*(const f32x4*)a0, *(const f32x4*)(a0 + 4)}, kav[2] = {*(const f32x4*)ka, *(const f32x4*)(ka + 4)};
      LoraIn in; bk_load(b, hd, kpos, dd, m, cc, in); u32x4 wb, wk; lora_bk8(v, a0v, kav, in, wb, wk);
      bf16_t* dst = bk_dst(d, b, hd, kpos, dd); *(u32x4*)dst = wb; *(u32x4*)(dst + 64) = wk; }
    else if (blk == 4) { u32x4 w; w.x = pk2(v[0], v[1]); w.y = pk2(v[2], v[3]); w.z = pk2(v[4], v[5]); w.w = pk2(v[6], v[7]); *(u32x4*)(wsp<bf16_t>(*p, A_RWG) + (size_t)m * 256 + cc) = w; }
  } };
struct EpiMlaQ { const Params* p;
  DI void store8(int urow, int m, int col, const float (&v0)[8]) const { if (col >= 384) return; const int dd = col % 96; float o[8], v[8];
#pragma unroll
    for (int i = 0; i < 8; ++i) { v[i] = v0[i] * (0.10206207261596575f * LOG2E); o[i] = v[i]; }
    if (dd >= 64 && m < TL) { const int i0 = (dd - 64) >> 1; const float* tab = wsp<float>(*p, WS_TABM) + ((size_t)(m % T) * 16 + i0) * 2; const f32x4 t0 = *(const f32x4*)tab, t1 = *(const f32x4*)(tab + 4);
      const float cs4[4] = {t0.x, t0.z, t1.x, t1.z}, sn4[4] = {t0.y, t0.w, t1.y, t1.w};
#pragma unroll
      for (int u = 0; u < 4; ++u) { const float cs = cs4[u], sn = sn4[u]; o[2 * u] = v[2 * u] * cs - v[2 * u + 1] * sn; o[2 * u + 1] = v[2 * u] * sn + v[2 * u + 1] * cs; } }
    u32x4 w; w.x = pk2(o[0], o[1]); w.y = pk2(o[2], o[3]); w.z = pk2(o[4], o[5]); w.w = pk2(o[6], o[7]); *(u32x4*)(wsp<bf16_t>(*p, A_QM) + (size_t)m * 384 + col) = w; } };
struct EpiMlaKV { const Params* p;
  DI void store8(int urow, int m, int col, const float (&v)[8]) const { const int hd = col >> 7, dd = col & 127; u32x4 w; w.x = pk2(v[0], v[1]); w.y = pk2(v[2], v[3]); w.z = pk2(v[4], v[5]); w.w = pk2(v[6], v[7]);
    if (dd < 64) *(u32x4*)(wsp<bf16_t>(*p, A_KM) + (size_t)m * 384 + hd * 96 + dd) = w; else *(u32x4*)(wsp<bf16_t>(*p, A_VM) + (size_t)m * 256 + hd * 64 + dd - 64) = w; } };

struct TileSrc { const bf16_t* k; const bf16_t* v; int kr; };
constexpr int ATT_VP = 144;
template <int DQ> struct AttL { static constexpr int KP = DQ * 2 + 16, KB = 64 * KP, VB = 64 * ATT_VP, BUF = KB + VB; };
constexpr int ATT_SCR = 2 * AttL<96>::BUF;
constexpr int ATT_BIAS = ATT_SCR + 8 * 256;
constexpr int ATT_LDS = ATT_BIAS + 2048;

template <int DQ, bool NAT, class TileFn>
DI void attn_unit(char* smem, const bf16_t* qptr, int qpitch, bf16_t* optr, int opitch, int ntiles, TileFn tilefn, int kpitch, int vpitch, float sc, int nat_qi, int nat_c0) {
  typedef AttL<DQ> L; constexpr int NDS = DQ / 16, KCH = DQ / 8;
  const int tid = TID, lane = tid & 63, wave = tid >> 6, r = lane & 31, h = lane >> 5;
  float* scr = (float*)(smem + ATT_SCR + wave * 256); const float* btab = (const float*)(smem + ATT_BIAS);
  bf16x8 qf[NDS];
#pragma unroll
  for (int ds = 0; ds < NDS; ++ds) qf[ds] = *(const bf16x8*)(qptr + (size_t)r * qpitch + 16 * ds + 8 * h);
  f32x16 o0, o1, lacc;
#pragma unroll
  for (int i = 0; i < 16; ++i) { o0[i] = 0.f; o1[i] = 0.f; lacc[i] = 0.f; }
  float m_run = -1.0e30f;
  const bf16x8 ones8 = {0x3f80, 0x3f80, 0x3f80, 0x3f80, 0x3f80, 0x3f80, 0x3f80, 0x3f80};
  const int kr0 = tid / KCH, kc0 = tid % KCH, kr1 = (tid + 512) / KCH, kc1 = (tid + 512) % KCH; const bool two = (DQ == 96) && (tid < 256);
  const int vr = tid >> 3, vc = tid & 7;
  u32x4 gk0, gk1 = {0, 0, 0, 0}, gv, hk0 = {0, 0, 0, 0}, hk1 = {0, 0, 0, 0}, hv = {0, 0, 0, 0};
  { const TileSrc ts = tilefn(0); gk0 = *(const u32x4*)(ts.k + (size_t)kr0 * kpitch + kc0 * 8); if (two) gk1 = *(const u32x4*)(ts.k + (size_t)kr1 * kpitch + kc1 * 8); gv = *(const u32x4*)(ts.v + (size_t)vr * vpitch + vc * 8);
    *(u32x4*)(smem + kr0 * L::KP + kc0 * 16) = gk0; if (two) *(u32x4*)(smem + kr1 * L::KP + kc1 * 16) = gk1; *(u32x4*)(smem + L::KB + vr * ATT_VP + vc * 16) = gv; }
  if (ntiles > 1) { const TileSrc ts = tilefn(1); gk0 = *(const u32x4*)(ts.k + (size_t)kr0 * kpitch + kc0 * 8); if (two) gk1 = *(const u32x4*)(ts.k + (size_t)kr1 * kpitch + kc1 * 8); gv = *(const u32x4*)(ts.v + (size_t)vr * vpitch + vc * 8); }
  __syncthreads();
  const int nat_rs = NAT ? (nat_qi - 4 < 0 ? 0 : (nat_qi - 4 > GROWS - 8 ? GROWS - 8 : nat_qi - 4)) : 0;
  const int qc = nat_c0 + r, cs = qc - 8 < 0 ? 0 : (qc - 8 > 48 ? 48 : qc - 8);
  for (int it = 0; it < ntiles; ++it) {
    const char* buf = smem + (it & 1) * L::BUF; char* nbuf = smem + ((it + 1) & 1) * L::BUF;
    const TileSrc cur = tilefn(it);
    if (it + 2 < ntiles) { const TileSrc ts = tilefn(it + 2); hk0 = *(const u32x4*)(ts.k + (size_t)kr0 * kpitch + kc0 * 8); if (two) hk1 = *(const u32x4*)(ts.k + (size_t)kr1 * kpitch + kc1 * 8); hv = *(const u32x4*)(ts.v + (size_t)vr * vpitch + vc * 8); }
    const bool active = !NAT || cur.kr < 0 || (cur.kr >= nat_rs && cur.kr < nat_rs + 8);
    if (active) {
      f32x16 s0, s1;
#pragma unroll
      for (int i = 0; i < 16; ++i) { s0[i] = 0.f; s1[i] = 0.f; }
#pragma unroll
      for (int ds = 0; ds < NDS; ++ds) { const bf16x8 a0 = *(const bf16x8*)(buf + r * L::KP + (16 * ds + 8 * h) * 2), a1 = *(const bf16x8*)(buf + (32 + r) * L::KP + (16 * ds + 8 * h) * 2);
        s0 = dev_mfma32(a0, qf[ds], s0); s1 = dev_mfma32(a1, qf[ds], s1); }
      float mx = -1.0e30f;
      if (NAT && cur.kr >= 0) {
#pragma unroll
        for (int i = 0; i < 16; ++i) { float x0 = s0[i] * sc, x1 = s1[i] * sc;
          const int k0 = crow(i, h), k1 = 32 + k0; const float* brow = btab + (cur.kr - nat_qi + 7) * 31 + 15 - qc;
          x0 = (k0 >= cs && k0 < cs + 16) ? x0 + brow[k0] * LOG2E : -1.0e30f; x1 = (k1 >= cs && k1 < cs + 16) ? x1 + brow[k1] * LOG2E : -1.0e30f;
          s0[i] = x0; s1[i] = x1; mx = fmaxf(mx, fmaxf(x0, x1)); }
      } else {
        dev_mfma_settle(s0, s1);
#pragma unroll
        for (int i = 0; i < 16; ++i) mx = dev_max3(mx, s0[i], s1[i]);
        mx *= sc;
      }
      mx = fmaxf(mx, dev_shfl_xor(mx, 32));
      const float m_new = fmaxf(m_run, mx), alpha = dev_exp2(m_run - m_new); const bool grew = m_new > m_run; m_run = m_new;
      if (NAT && cur.kr >= 0) {
#pragma unroll
        for (int i = 0; i < 16; ++i) { s0[i] = dev_exp2(s0[i] - m_new); s1[i] = dev_exp2(s1[i] - m_new); }
      } else {
#pragma unroll
        for (int i = 0; i < 16; ++i) { s0[i] = dev_exp2(s0[i] * sc - m_new); s1[i] = dev_exp2(s1[i] * sc - m_new); }
      }
      if (dev_any(grew)) {
        if (h == 0) scr[r] = alpha;
        dev_wave_fence();
#pragma unroll
        for (int g = 0; g < 4; ++g) { const f32x4 a = *(const f32x4*)(scr + 8 * g + 4 * h);
#pragma unroll
          for (int e = 0; e < 4; ++e) { o0[4 * g + e] *= a[e]; o1[4 * g + e] *= a[e]; lacc[4 * g + e] *= a[e]; } }
        dev_wave_fence();
      }
      const char* vbase = buf + L::KB + (4 * h + ((lane & 15) >> 2)) * ATT_VP + (((lane >> 4) & 1) * 16 + (lane & 3) * 4) * 2;
#pragma unroll
      for (int kvb = 0; kvb < 2; ++kvb)
#pragma unroll
        for (int s = 0; s < 2; ++s) { bf16x8 pa;
#pragma unroll
          for (int j = 0; j < 8; j += 2) { const unsigned w = kvb ? pk2(s1[8 * s + j], s1[8 * s + j + 1]) : pk2(s0[8 * s + j], s0[8 * s + j + 1]); pa[j] = (short)(w & 0xffffu); pa[j + 1] = (short)(w >> 16); }
          lacc = dev_mfma32(pa, ones8, lacc);
          const char* vb = vbase + (32 * kvb + 16 * s) * ATT_VP;
          { const s16x4 lo = dev_tr16(vb), hi = dev_tr16(vb + 8 * ATT_VP); const bf16x8 bv = {lo[0], lo[1], lo[2], lo[3], hi[0], hi[1], hi[2], hi[3]}; o0 = dev_mfma32(pa, bv, o0); }
          { const s16x4 lo = dev_tr16(vb + 64), hi = dev_tr16(vb + 8 * ATT_VP + 64); const bf16x8 bv = {lo[0], lo[1], lo[2], lo[3], hi[0], hi[1], hi[2], hi[3]}; o1 = dev_mfma32(pa, bv, o1); } }
    }
    if (it + 1 < ntiles) { *(u32x4*)(nbuf + kr0 * L::KP + kc0 * 16) = gk0; if (two) *(u32x4*)(nbuf + kr1 * L::KP + kc1 * 16) = gk1; *(u32x4*)(nbuf + L::KB + vr * ATT_VP + vc * 16) = gv; }
    __syncthreads();
    gk0 = hk0; gk1 = hk1; gv = hv;
  }
#pragma unroll
  for (int i = 0; i < 16; ++i) { const float li = dev_rcp(lacc[i]); bf16_t* orow = optr + (size_t)crow(i, h) * opitch;
    orow[r] = (bf16_t)f2bf(o0[i] * li); orow[32 + r] = (bf16_t)f2bf(o1[i] * li); }
  dev_wave_fence();
  __syncthreads();
}

DI f32x16 zero16() { f32x16 z;
#pragma unroll
  for (int i = 0; i < 16; ++i) z[i] = 0.f;
  return z; }
template <int NDS> struct A2L { static constexpr int SLOT = NDS * 2048, K = 0, V = 3 * SLOT, WS = 6 * SLOT, OST = WS + 8 * 256, BYTES = OST + 8 * 4096; };
static_assert(A2L<6>::BYTES <= 131072 - 256, "attn2 LDS map");
#ifdef EMU
typedef const char* a2_lptr;
#define A2_SBAR() do {} while (0)
#define A2_PIN(x) do {} while (0)
template <int N> DI void a2_waitbar() { __syncthreads(); }
DI bf16x8 a2_ld8(a2_lptr q) { return *(const bf16x8*)q; }
DI float a2_swapmax(float m) { return fmaxf(m, dev_shfl_xor(m, 32)); }
DI float a2_swapsum(float m) { return m + dev_shfl_xor(m, 32); }
DI float a2_sub(float a, float b) { return a - b; }
DI float a2_rcp(float x) { return 1.0f / x; }
#else
typedef LAS const char* a2_lptr;
#define A2_SBAR() __builtin_amdgcn_sched_barrier(0)
#define A2_PIN(x) asm volatile("" : "+v"(x))
template <int N> DI void a2_waitbar() { asm volatile("s_waitcnt vmcnt(%0) lgkmcnt(0)\n\ts_barrier" ::"n"(N) : "memory"); }
DI bf16x8 a2_ld8(a2_lptr q) { return *(LAS const bf16x8*)q; }
DI float a2_swapmax(float m) { auto rr = __builtin_amdgcn_permlane32_swap(__float_as_uint(m), __float_as_uint(m), false, false); return __builtin_fmaxf(__uint_as_float(rr[0]), __uint_as_float(rr[1])); }
DI float a2_swapsum(float m) { auto rr = __builtin_amdgcn_permlane32_swap(__float_as_uint(m), __float_as_uint(m), false, false); return __uint_as_float(rr[0]) + __uint_as_float(rr[1]); }
DI float a2_sub(float a, float b) { float r; asm("v_sub_f32_e32 %0, %1, %2" : "=v"(r) : "v"(a), "v"(b)); return r; }
DI float a2_rcp(float x) { return __builtin_amdgcn_rcpf(x); }
#endif
DI s16x4 a2_vtr(a2_lptr q) { return dev_tr16((const void*)q); }

template <int NDS, int THRL, bool HALF = false>
DI void attn2_unit(char* smem, const bf16_t* qptr, int qpitch, bf16_t* optr, int opitch, const bf16_t* kcol, int kpitch, const bf16_t* vcol, int vpitch, int b, int half = 0, float* stats = nullptr) {
  const int tid = TID, lane = tid & 63, r32 = lane & 31, hi = lane >> 5; const int wid = dev_uniform(tid >> 6);
  typedef A2L<NDS> L; constexpr int A2_SLOT = L::SLOT, KN = NDS == 4 ? 1 : 2;
  constexpr int NT = HALF ? NK / 128 : NK / 64; static_assert((NK / 64) % 4 == 0 && NK / 128 >= 8 && (NDS == 4 || NDS == 6), "tile count / head dim"); const int t0 = HALF ? half * NT : 0;
  auto mrow = [&](int tt) { const int t = tt + t0; return t < T / 64 ? b * T + 64 * t : TL + b * C + 64 * (t - T / 64); };
  float* wsf = (float*)(smem + L::WS) + wid * 64;
  const bf16_t* ksrc = kcol + (size_t)lane * kpitch + wid * 8;
  const bf16_t* vsrc = vcol + (size_t)(16 * (wid & 3) + (lane >> 2)) * vpitch + (wid >> 2) * 32 + (lane & 3) * 8;
  char* kdst = smem + L::K + wid * 1024; char* vdst = smem + L::V + wid * 1024;
  const bf16_t* ksrc2 = kcol + (size_t)(32 * (wid & 1) + r32) * kpitch + (8 + (wid >> 1)) * 8; char* kdst2 = smem + L::K + (8 + (wid >> 1)) * 1024 + (wid & 1) * 512;
#define DMA_K(t, slot) do { dev_glds16(ksrc + (size_t)mrow(t) * kpitch, kdst + (slot)); if (NDS == 6) { if (lane < 32) dev_glds16(ksrc2 + (size_t)mrow(t) * kpitch, kdst2 + (slot)); } } while (0)
#define DMA_V(t, slot) dev_glds16(vsrc + (size_t)mrow(t) * vpitch, vdst + (slot))
  const a2_lptr shm3 = (a2_lptr)smem; const a2_lptr kp0 = shm3 + L::K + hi * 1024 + r32 * 16; const a2_lptr vp0 = shm3 + L::V + ((lane >> 4) & 1) * 32 + (lane & 3) * 8 + (4 * hi + ((lane & 15) >> 2)) * 64;
  bf16x8 kf[2 * NDS];
  DMA_K(0, 0); DMA_V(0, 0); DMA_K(1, A2_SLOT);
  bf16x8 qr[NDS];
#pragma unroll
  for (int d0 = 0; d0 < NDS; ++d0) qr[d0] = *(const bf16x8*)(qptr + (size_t)r32 * qpitch + d0 * 16 + hi * 8);
  float mhat = 0.f, l_reg = 0.f; f32x16 o[2]; o[0] = zero16(); o[1] = zero16(); f32x16 negm = zero16(); A2_PIN(negm);
  bool resc = false;
#define RESC() do { if (resc) { dev_wave_fence(); _Pragma("unroll") for (int d_ = 0; d_ < 2; ++d_) _Pragma("unroll") for (int r = 0; r < 16; ++r) o[d_][r] *= wsf[crow(r, hi)]; } } while (0)
  f32x16 pA0, pA1, pB0, pB1;
  int sl_prev = 0, sl_cur = 0, sl_next = A2_SLOT;
#define ROT() do { sl_prev = sl_cur; sl_cur = sl_next; sl_next = (sl_next == 2 * A2_SLOT) ? 0 : sl_next + A2_SLOT; } while (0)
#define KLD2(kp, j) do { kf[2 * (j)] = a2_ld8((kp) + (j) * 2048); kf[2 * (j) + 1] = a2_ld8((kp) + (j) * 2048 + 512); } while (0)
  DMA_K(2, 2 * A2_SLOT);
  a2_waitbar<1 + 2 * KN>();
#pragma unroll
  for (int j = 0; j < NDS; ++j) KLD2(kp0, j);
  pA0 = dev_mfma32(kf[0], qr[0], negm); pA1 = dev_mfma32(kf[1], qr[0], negm);
#pragma unroll
  for (int d0 = 1; d0 < NDS; ++d0) { pA0 = dev_mfma32(kf[2 * d0], qr[d0], pA0); pA1 = dev_mfma32(kf[2 * d0 + 1], qr[d0], pA1); }
  dev_mfma_settle(pA0, pA1);
  { float a = dev_max3(pA0[0], pA0[1], pA1[0]), c = dev_max3(pA0[2], pA0[3], pA1[1]); a = dev_max3(a, pA1[2], pA1[3]);
#pragma unroll
    for (int r = 4; r < 16; r += 4) { a = dev_max3(a, pA0[r], pA0[r + 1]); c = dev_max3(c, pA0[r + 2], pA0[r + 3]); a = dev_max3(a, pA1[r], pA1[r + 1]); c = dev_max3(c, pA1[r + 2], pA1[r + 3]); }
    const float dl = a2_swapmax(fmaxf(a, c)); mhat = dl;
#pragma unroll
    for (int r = 0; r < 16; ++r) { pA0[r] = dev_exp2(a2_sub(pA0[r], dl)); pA1[r] = dev_exp2(a2_sub(pA1[r], dl)); }
#pragma unroll
    for (int r = 0; r < 16; ++r) negm[r] = -mhat;
    A2_PIN(negm); }
  a2_waitbar<0>();
  DMA_K(3, 0); DMA_V(1, A2_SLOT);
  ROT();
#pragma unroll
  for (int j = 0; j < NDS; ++j) KLD2(kp0 + sl_cur, j);
  a2_waitbar<KN + 1>();
  s16x4 vlo[8], vhi[8]; u32x4 pw0, pw1, pw2, pw3;
#define PKW(P, B) pk2(P[B], P[(B) + 1])
#define PAF(k) __builtin_bit_cast(bf16x8, pw##k)
#define VFR(i) (bf16x8){vlo[i][0], vlo[i][1], vlo[i][2], vlo[i][3], vhi[i][0], vhi[i][1], vhi[i][2], vhi[i][3]}
#define MX3(a, b, c) __builtin_fmaxf(__builtin_fmaxf((a), (b)), (c))
#define GAPA(MF, A0, A1, A2, A3, W0, W1, PW) do { MF; sacc += A0; sacc += A1; sacc += A2; sacc += A3; A2_PIN(sacc); W0; W1; A2_PIN(PW); A2_SBAR(); } while (0)
#define GAPB(MF, X, B) do { MF; X[B] = dev_exp2(X[B]); X[(B) + 1] = dev_exp2(X[(B) + 1]); X[(B) + 2] = dev_exp2(X[(B) + 2]); X[(B) + 3] = dev_exp2(X[(B) + 3]); A2_PIN(X); A2_SBAR(); } while (0)
#define VRD(i) do { vlo[i] = a2_vtr(vp_ + (((i) >> 2) * 4096 + ((i) & 3) * 1024)); vhi[i] = a2_vtr(vp_ + (((i) >> 2) * 4096 + ((i) & 3) * 1024 + 512)); } while (0)
#define KRD(G, j) do { if (G) { KLD2(kp0 + sl_next, j); A2_SBAR(); } } while (0)
#define STEP(C0, C1, P0, P1, t, GK, GV, GL) do { A2_SBAR(); \
    const a2_lptr vp_ = vp0 + sl_prev; \
    VRD(0); A2_SBAR(); float sacc = (P0[0] + P0[1]); \
    GAPA(C0 = dev_mfma32(kf[0], qr[0], negm), P0[2], P0[3], P0[4], P0[5], pw0[0] = PKW(P0, 0), pw0[1] = PKW(P0, 2), pw0); \
    VRD(4); A2_SBAR(); GAPA(C1 = dev_mfma32(kf[1], qr[0], negm), P0[6], P0[7], P0[8], P0[9], pw0[2] = PKW(P0, 4), pw0[3] = PKW(P0, 6), pw0); \
    VRD(1); A2_SBAR(); GAPA(C0 = dev_mfma32(kf[2], qr[1], C0), P0[10], P0[11], P0[12], P0[13], pw1[0] = PKW(P0, 8), pw1[1] = PKW(P0, 10), pw1); \
    VRD(5); A2_SBAR(); GAPA(C1 = dev_mfma32(kf[3], qr[1], C1), P0[14], P0[15], P1[0], P1[1], pw1[2] = PKW(P0, 12), pw1[3] = PKW(P0, 14), pw1); \
    VRD(2); A2_SBAR(); GAPA(C0 = dev_mfma32(kf[4], qr[2], C0), P1[2], P1[3], P1[4], P1[5], pw2[0] = PKW(P1, 0), pw2[1] = PKW(P1, 2), pw2); \
    VRD(6); A2_SBAR(); GAPA(C1 = dev_mfma32(kf[5], qr[2], C1), P1[6], P1[7], P1[8], P1[9], pw2[2] = PKW(P1, 4), pw2[3] = PKW(P1, 6), pw2); \
    VRD(3); A2_SBAR(); GAPA(C0 = dev_mfma32(kf[6], qr[3], C0), P1[10], P1[11], P1[12], P1[13], pw3[0] = PKW(P1, 8), pw3[1] = PKW(P1, 10), pw3); \
    VRD(7); A2_SBAR(); GAPA(C1 = dev_mfma32(kf[7], qr[3], C1), P1[14], P1[15], 0.f, 0.f, pw3[2] = PKW(P1, 12), pw3[3] = PKW(P1, 14), pw3); \
    if constexpr (NDS == 6) { C0 = dev_mfma32(kf[8], qr[4], C0); A2_SBAR(); C1 = dev_mfma32(kf[9], qr[4], C1); A2_SBAR(); C0 = dev_mfma32(kf[10], qr[5], C0); A2_SBAR(); C1 = dev_mfma32(kf[11], qr[5], C1); A2_SBAR(); } \
    l_reg += sacc; \
    if (GK) { DMA_K((t) + 3, sl_cur); } if (GV) { DMA_V((t) + 1, sl_next); } \
    { float a = MX3(C0[0], C0[1], C1[0]), c_ = MX3(C0[2], C0[3], C1[1]); a = MX3(a, C1[2], C1[3]); \
      _Pragma("unroll") for (int r = 4; r < 16; r += 4) { a = MX3(a, C0[r], C0[r + 1]); c_ = MX3(c_, C0[r + 2], C0[r + 3]); a = MX3(a, C1[r], C1[r + 1]); c_ = MX3(c_, C1[r + 2], C1[r + 3]); } \
      const float rm = a2_swapmax(__builtin_fmaxf(a, c_)); \
      resc = false; \
      if (__builtin_expect(dev_any(rm > (float)THRL), 0)) { const float dl = __builtin_fmaxf(rm, 0.f); mhat += dl; \
        _Pragma("unroll") for (int r = 0; r < 16; ++r) { C0[r] -= dl; C1[r] -= dl; } \
        _Pragma("unroll") for (int r = 0; r < 16; ++r) negm[r] = -mhat; \
        A2_PIN(negm); \
        const float f = dev_exp2(-dl); l_reg *= f; if (hi == 0) wsf[r32] = f; resc = true; } } \
    A2_SBAR(); \
    GAPB(o[0] = dev_mfma32(PAF(0), VFR(0), o[0]), C0, 0); \
    GAPB(o[1] = dev_mfma32(PAF(0), VFR(4), o[1]), C0, 4); \
    KRD(GL, 0); GAPB(o[0] = dev_mfma32(PAF(1), VFR(1), o[0]), C0, 8); \
    KRD(GL, 1); GAPB(o[1] = dev_mfma32(PAF(1), VFR(5), o[1]), C0, 12); \
    KRD(GL, 2); GAPB(o[0] = dev_mfma32(PAF(2), VFR(2), o[0]), C1, 0); \
    KRD(GL, 3); GAPB(o[1] = dev_mfma32(PAF(2), VFR(6), o[1]), C1, 4); \
    if constexpr (NDS == 6) { KRD(GL, 4); } GAPB(o[0] = dev_mfma32(PAF(3), VFR(3), o[0]), C1, 8); \
    if constexpr (NDS == 6) { KRD(GL, 5); } GAPB(o[1] = dev_mfma32(PAF(3), VFR(7), o[1]), C1, 12); \
  } while (0)
  int t = 1;
  for (; t + 5 < NT; t += 2) {
    STEP(pB0, pB1, pA0, pA1, t, true, true, true);     a2_waitbar<KN + 1>(); RESC(); ROT();
    STEP(pA0, pA1, pB0, pB1, t + 1, true, true, true); a2_waitbar<KN + 1>(); RESC(); ROT();
  }
#define ENDW(tt) do { if ((tt) + 3 < NT) { a2_waitbar<KN + 1>(); } else if ((tt) + 2 < NT) { a2_waitbar<1>(); } else { a2_waitbar<0>(); } } while (0)
  for (; t + 1 < NT; t += 2) {
    STEP(pB0, pB1, pA0, pA1, t, (t + 3 < NT), (t + 1 < NT), (t + 1 < NT));         ENDW(t);     RESC(); ROT();
    STEP(pA0, pA1, pB0, pB1, t + 1, (t + 4 < NT), (t + 2 < NT), (t + 2 < NT));     ENDW(t + 1); RESC(); ROT();
  }
  STEP(pB0, pB1, pA0, pA1, NT - 1, false, false, false); RESC();
  { float sacc = pB0[0] + pB0[1];
#pragma unroll
    for (int r = 2; r < 16; ++r) sacc += pB0[r];
#pragma unroll
    for (int r = 0; r < 16; ++r) sacc += pB1[r];
    l_reg += sacc;
    pw0 = (u32x4){PKW(pB0, 0), PKW(pB0, 2), PKW(pB0, 4), PKW(pB0, 6)}; pw1 = (u32x4){PKW(pB0, 8), PKW(pB0, 10), PKW(pB0, 12), PKW(pB0, 14)};
    pw2 = (u32x4){PKW(pB1, 0), PKW(pB1, 2), PKW(pB1, 4), PKW(pB1, 6)}; pw3 = (u32x4){PKW(pB1, 8), PKW(pB1, 10), PKW(pB1, 12), PKW(pB1, 14)};
    const a2_lptr vp_ = vp0 + sl_cur;
#pragma unroll
    for (int i = 0; i < 8; ++i) VRD(i);
    o[0] = dev_mfma32(PAF(0), VFR(0), o[0]); o[1] = dev_mfma32(PAF(0), VFR(4), o[1]); o[0] = dev_mfma32(PAF(1), VFR(1), o[0]); o[1] = dev_mfma32(PAF(1), VFR(5), o[1]);
    o[0] = dev_mfma32(PAF(2), VFR(2), o[0]); o[1] = dev_mfma32(PAF(2), VFR(6), o[1]); o[0] = dev_mfma32(PAF(3), VFR(3), o[0]); o[1] = dev_mfma32(PAF(3), VFR(7), o[1]); }
  l_reg = a2_swapsum(l_reg);
  if (hi == 0) { wsf[32 + r32] = l_reg; if (HALF) { stats[2 * r32] = mhat; stats[2 * r32 + 1] = l_reg; } }
  dev_wave_fence();
  float rli[16];
#pragma unroll
  for (int r = 0; r < 16; ++r) rli[r] = a2_rcp(wsf[32 + crow(r, hi)]);
  { bf16_t* stg = (bf16_t*)(smem + L::OST) + wid * 2048;
#pragma unroll
    for (int r = 0; r < 16; ++r) { const int orow = crow(r, hi);
#pragma unroll
      for (int d0 = 0; d0 < 2; ++d0) stg[orow * 64 + d0 * 32 + r32] = (bf16_t)f2bf_hw(o[d0][r] * rli[r]); }
    dev_wave_fence();
#pragma unroll
    for (int i = 0; i < 4; ++i) { const int row = i * 8 + (lane >> 3), ch = lane & 7; *(u32x4*)(optr + (size_t)row * opitch + ch * 8) = *(const u32x4*)(stg + row * 64 + ch * 8); } }
  dev_bar();
#undef DMA_K
#undef DMA_V
#undef RESC
#undef ROT
#undef KLD2
#undef PKW
#undef PAF
#undef VFR
#undef MX3
#undef GAPA
#undef GAPB
#undef VRD
#undef KRD
#undef STEP
#undef ENDW
}

constexpr int SC_CH = 16, SC_RING = 4, SC_CHB = SC_CH * 1536, SC_YB = SC_RING * SC_CHB;
static_assert(NK % SC_CH == 0 && NK / SC_CH >= 4 && SC_YB + 2 * SC_CH * 32 * 4 <= 131072 - 256 && ATT_LDS <= 131072 - 256, "scan LDS map");
DI int scan_kpos(int s, int d) { return s < C ? T + (d == 0 ? s : C - 1 - s) : (d == 0 ? s - C : T - 1 - (s - C)); }
constexpr int CK = 32, NCHK = NK / CK, U_PREP = 2 * NB * 4 * NCHK;
constexpr int SB_AS = 0, SB_AY = 8192, SB_GS = 12288, SB_GY = 16384, SB_VT = 18432, SB_BYTES = CK * 768;
static_assert(NK % CK == 0 && C % CK == 0 && SB_VT + 4096 <= SB_BYTES, "chunking");
constexpr int PW_REC = 896  , PW_RAW = 0, PW_KC = CK * PW_REC, PW_RT = PW_KC + 4608, PW_BT = PW_RT + 4608, PW_KT = PW_BT + 4608, PW_BHT = PW_KT + 4608, PW_KHT = PW_BHT + 5120, PW_VT = PW_KHT + 5120, PW_GC = PW_VT + 4096,
              PW_KCT = PW_GC + 256, PW_J = PW_KCT + 5120  , PW_TT = PW_J + 4 * 2560  ,
              PW_WT = PW_TT + 2560  , PW_MKJ = PW_WT + 2560  , PW_NBT = PW_MKJ + 2560, PW_X16 = PW_NBT + 2560, PW_WT8 = PW_X16 + 7680  , PW_END = PW_WT8 + 2048;
static_assert(PW_END <= 131072 - 256, "prep LDS map");
DI int chunk_kmin(int c, int d) { const int k0 = scan_kpos(c * CK, d), k1 = scan_kpos(c * CK + CK - 1, d); return k0 < k1 ? k0 : k1; }
DI bf16x8 pack8(const f32x16& x, int s) { u32x4 w;
#pragma unroll
  for (int j = 0; j < 4; ++j) w[j] = pk2(x[8 * s + 2 * j], x[8 * s + 2 * j + 1]);
  return __builtin_bit_cast(bf16x8, w); }
DI bf16x8 pack8lo(const f32x16& x, int s) { u32x4 w;
#pragma unroll
  for (int j = 0; j < 4; ++j) { const float a = x[8 * s + 2 * j], b = x[8 * s + 2 * j + 1]; w[j] = pk2(a - bf2f(f2bf_hw(a)), b - bf2f(f2bf_hw(b))); }
  return __builtin_bit_cast(bf16x8, w); }
DI bf16x8 ld2x8(const bf16_t* p0, const bf16_t* p1) { const u32x2 a = *(const u32x2*)p0, b = *(const u32x2*)p1; return __builtin_bit_cast(bf16x8, (u32x4){a.x, a.y, b.x, b.y}); }

struct PrepDesc { int sin[4], pofs[4]; };
constexpr int PREP_NP = CK * (PW_REC / 16);
static_assert(PREP_NP == 4 * 448, "prep DMA pieces");
DI void prep_desc(int tid, PrepDesc& ds) {
#pragma unroll
  for (int i = 0; i < 4; ++i) { const int idx = i * 448 + (tid - 64), sin = idx / 56, piece = idx % 56; ds.sin[i] = sin; ds.pofs[i] = piece < 24 ? piece * 16 : (piece - 24) * 16 + (1 << 30); }
}
DI void prep_issue(const Params& p, int unit, int tid, const PrepDesc& ds, char* smem) {
  const int wave = tid >> 6; if (wave == 0) return;
  const int chain = dev_uniform(unit / NCHK), c = dev_uniform(unit % NCHK); const int d = chain / (NB * 4), b = (chain / 4) % NB, hd = chain % 4;
  const char* scs = (const char*)(wsp<bf16_t>(p, A_SCS) + (size_t)(b * 4 + hd) * NK * 192); const char* scd = (const char*)(wsp<float>(p, A_SCD) + (size_t)((d * NB + b) * 4 + hd) * NK * 192);
  const long k0 = (long)scan_kpos(c * CK, d); const int sgn = d == 0 ? 1 : -1;
#pragma unroll
  for (int i = 0; i < 4; ++i) { const bool isd = ((ds.pofs[i] >> 30) & 1) != 0; const long rec = k0 + sgn * ds.sin[i]; const char* src = (isd ? scd + rec * 768 : scs + rec * 384) + (ds.pofs[i] & 0xffff);
    dev_glds16(src, smem + PW_RAW + (i * 448 + (wave - 1) * 64) * 16); }
}
DI void prep_chunk(const Params& p, int l, int unit, int next_unit, bool first, const PrepDesc& ds, char* smem) {
  const int tid = TID, lane = tid & 63, wave = tid >> 6, r = lane & 31, h = lane >> 5; const int chain = unit / NCHK, c = unit % NCHK; const int d = chain / (NB * 4), b = (chain / 4) % NB, hd = chain % 4;
  float* scd = wsp<float>(p, A_SCD) + (size_t)((d * NB + b) * 4 + hd) * NK * 192;
  { const int wu = dev_uniform(wave); if (first) dev_vmwait<0>(); else if (wu == 3) dev_vmwait<5>(); else if (wu < 3) dev_vmwait<3>(); else dev_vmwait<2>(); }
  dev_bar();
  const char* raw = smem + PW_RAW;
  for (int rep_b = 0; rep_b < (PROBE_REP == 30 ? 2 : 1); ++rep_b)
  { const int k = tid & 63, t0 = dev_uniform(4 * (tid >> 6)); float Pm0, Pt[4]; const float rkk = p.in(I_RK)[l * 256 + hd * 64 + k];
    const float* lw = (const float*)(raw + 384 + k * 4);
    float l4[4];
#pragma unroll
    for (int q = 0; q < 4; ++q) l4[q] = lw[(t0 + q) * (PW_REC / 4)];
    float* wt = (float*)(smem + PW_WT8);
    wt[wave * 64 + k] = (l4[0] + l4[1]) + (l4[2] + l4[3]);
    dev_bar();
    float base = 0.f, P = 0.f;
#pragma unroll
    for (int w = 0; w < 8; ++w) { const float x = wt[w * 64 + k]; P += x; base += (w < wave) ? x : 0.f; }
    Pm0 = base; Pt[0] = base + l4[0]; Pt[1] = Pt[0] + l4[1]; Pt[2] = Pt[1] + l4[2]; Pt[3] = Pt[2] + l4[3];
    const float gc = dev_exp2(P); float em = dev_exp2(Pm0);
    float bh4[4], kh4[4], vv4[4], kc4[4];
#pragma unroll
    for (int q = 0; q < 4; ++q) { const int t = t0 + q; const bf16_t* rec = (const bf16_t*)(raw + t * PW_REC) + k;
      const float rr = bf2f(rec[0]), vv = bf2f(rec[64]), kk = bf2f(rec[128]), bb = bf2f(rec[320]), kd = bf2f(rec[384]);
      const float et = dev_exp2(Pt[q]), ei = dev_exp2(-Pt[q]), ec = gc * ei;
      ((bf16_t*)(smem + PW_KC))[t * 72 + k] = (bf16_t)f2bf_hw(kk * em); ((bf16_t*)(smem + PW_RT))[t * 72 + k] = (bf16_t)f2bf_hw(rr * et);
      ((bf16_t*)(smem + PW_BT))[t * 72 + k] = (bf16_t)f2bf_hw(bb * ei); ((bf16_t*)(smem + PW_KT))[t * 72 + k] = (bf16_t)f2bf_hw(kd * ei);
      bh4[q] = bb * ec; kh4[q] = kd * ec; vv4[q] = vv; kc4[q] = kk * em;
      const float rho = wave_sum(rr * kd * rkk);
      if (lane == 0) wsp<float>(p, A_RHO)[((size_t)d * MT + kpos_row(b, scan_kpos(c * CK + t, d))) * 4 + hd] = rho;
      em = et; }
    { u32x2 w; w.x = pk2(bh4[0], bh4[1]); w.y = pk2(bh4[2], bh4[3]); *(u32x2*)((bf16_t*)(smem + PW_BHT) + k * 40 + t0) = w;
      w.x = pk2(kh4[0], kh4[1]); w.y = pk2(kh4[2], kh4[3]); *(u32x2*)((bf16_t*)(smem + PW_KHT) + k * 40 + t0) = w;
      w.x = pk2(vv4[0], vv4[1]); w.y = pk2(vv4[2], vv4[3]); *(u32x2*)((bf16_t*)(smem + PW_VT) + k * 32 + t0) = w;
      w.x = pk2(kc4[0], kc4[1]); w.y = pk2(kc4[2], kc4[3]); *(u32x2*)((bf16_t*)(smem + PW_KCT) + k * 40 + t0) = w; }
    if (t0 == 0) ((float*)(smem + PW_GC))[k] = gc; }
  dev_bar();
  if (next_unit < U_PREP) prep_issue(p, next_unit, tid, ds, smem);
  f32x16 nk = zero16();
  auto mm64 = [&](const bf16_t* X, const bf16_t* Y) { f32x16 acc = zero16();
#pragma unroll
    for (int s = 0; s < 4; ++s) acc = dev_mfma32(*(const bf16x8*)(X + r * 72 + 16 * s + 8 * h), *(const bf16x8*)(Y + r * 72 + 16 * s + 8 * h), acc);
    return acc; };
  auto wr_rows = [&](int off, const f32x16& a) { bf16_t* dst = (bf16_t*)(smem + off) + r * 40;
#pragma unroll
    for (int g = 0; g < 4; ++g) { u32x2 w; w.x = pk2(a[4 * g], a[4 * g + 1]); w.y = pk2(a[4 * g + 2], a[4 * g + 3]); *(u32x2*)(dst + 8 * g + 4 * h) = w; } };
  auto aform = [&](int off, int s) { const bf16_t* q = (const bf16_t*)(smem + off) + r * 40 + 16 * s + 4 * h; return ld2x8(q, q + 8); };
  const bf16_t *KC = (const bf16_t*)(smem + PW_KC), *RT = (const bf16_t*)(smem + PW_RT), *BT = (const bf16_t*)(smem + PW_BT), *KT = (const bf16_t*)(smem + PW_KT);
  if (wave == 0) {
    f32x16 M = mm64(BT, KC), MT = mm64(KC, BT);
#pragma unroll
    for (int i = 0; i < 16; ++i) { M[i] = crow(i, h) < r ? M[i] : 0.f; MT[i] = crow(i, h) > r ? MT[i] : 0.f; }
    wr_rows(PW_J, MT);
    wr_rows(PW_TT, M);
    f32x16 Pk = M, PkT = MT, R;
#pragma unroll
    for (int i = 0; i < 16; ++i) R[i] = (crow(i, h) == r ? 1.f : 0.f) - M[i];
#pragma unroll
    for (int lev = 1; lev < 5; ++lev) { dev_wave_fence();
      f32x16 N = zero16(), NT = zero16(), Q = zero16();
#pragma unroll
      for (int s = 0; s < 2; ++s) { N = dev_mfma32(aform(PW_J + (lev - 1) * 2560, s), pack8(Pk, s), N); NT = dev_mfma32(aform(PW_TT, s), pack8(PkT, s), NT);
        if (lev > 1) Q = dev_mfma32(aform(PW_J + (lev - 1) * 2560, s), pack8(R, s), Q); }
      if (lev > 1) {
#pragma unroll
        for (int i = 0; i < 16; ++i) R[i] += Q[i]; }
      Pk = N; PkT = NT; dev_wave_fence();
      wr_rows(PW_J + (lev & 3) * 2560, PkT); if (lev < 4) wr_rows(PW_TT, Pk); }
    { dev_wave_fence(); f32x16 Q = zero16();
#pragma unroll
      for (int s = 0; s < 2; ++s) Q = dev_mfma32(aform(PW_J, s), pack8(R, s), Q);
#pragma unroll
      for (int i = 0; i < 16; ++i) R[i] += Q[i]; }
    wr_rows(PW_WT, R);
  } else if (wave == 1) { f32x16 MkT = mm64(KC, KT);
#pragma unroll
    for (int i = 0; i < 16; ++i) MkT[i] = crow(i, h) > r ? MkT[i] : 0.f;
    wr_rows(PW_MKJ, MkT);
  } else if (wave == 2) { f32x16 Nb = mm64(BT, RT);
#pragma unroll
    for (int i = 0; i < 16; ++i) Nb[i] = crow(i, h) <= r ? Nb[i] : 0.f;
    wr_rows(PW_NBT, Nb);
  } else if (wave == 3) { nk = mm64(KT, RT);
#pragma unroll
    for (int i = 0; i < 16; ++i) nk[i] = crow(i, h) <= r ? nk[i] : 0.f; }
  dev_bar();
  if (wave < 3) { f32x16 Q = zero16(); const bf16_t* WT = (const bf16_t*)(smem + PW_WT) + r * 40; const bf16_t* Bsrc = wave < 2 ? (const bf16_t*)(smem + PW_KCT) + (32 * wave + r) * 40 : (const bf16_t*)(smem + PW_MKJ) + r * 40;
#pragma unroll
    for (int s = 0; s < 2; ++s) Q = dev_mfma32(*(const bf16x8*)(WT + 16 * s + 8 * h), *(const bf16x8*)(Bsrc + 16 * s + 8 * h), Q);
    wr_rows(PW_X16 + (wave < 2 ? 32 * wave : 64) * 80, Q); }
  dev_bar();
  { char* dst = (char*)(scd + (size_t)chunk_kmin(c, d) * 192); const bf16_t* X16 = (const bf16_t*)(smem + PW_X16); const bf16_t* BHT = (const bf16_t*)(smem + PW_BHT); const bf16_t* NBT = (const bf16_t*)(smem + PW_NBT);
    if (wave < 4) { const int sb = wave & 1, kb = wave >> 1;
      f32x16 z = zero16();
#pragma unroll
      for (int s = 0; s < 2; ++s) z = dev_mfma32(*(const bf16x8*)(X16 + (32 * sb + r) * 40 + 16 * s + 8 * h), *(const bf16x8*)(BHT + (32 * kb + r) * 40 + 16 * s + 8 * h), z);
      const float gc = ((const float*)(smem + PW_GC))[32 * kb + r];
#pragma unroll
      for (int i = 0; i < 16; ++i) z[i] = ((32 * sb + crow(i, h)) == (32 * kb + r) ? gc : 0.f) - z[i];
#pragma unroll
      for (int s = 0; s < 2; ++s) *(bf16x8*)(dst + SB_AS + (((kb * 2 + sb) * 2 + s) * 64 + lane) * 16) = pack8(z, s); }
    else if (wave < 6) { const int sb = wave - 4;
      f32x16 z = zero16();
#pragma unroll
      for (int s = 0; s < 2; ++s) z = dev_mfma32(*(const bf16x8*)(X16 + (32 * sb + r) * 40 + 16 * s + 8 * h), *(const bf16x8*)(NBT + r * 40 + 16 * s + 8 * h), z);
      const bf16_t* rt = (const bf16_t*)(smem + PW_RT) + r * 72 + 32 * sb;
#pragma unroll
      for (int g = 0; g < 4; ++g) { const f32x4 rv = ldp4(rt, 8 * g + 4 * h);
#pragma unroll
        for (int e = 0; e < 4; ++e) z[4 * g + e] = rv[e] - z[4 * g + e]; }
#pragma unroll
      for (int s = 0; s < 2; ++s) *(bf16x8*)(dst + SB_AY + ((sb * 2 + s) * 64 + lane) * 16) = pack8(z, s); }
    else { const int kb = wave - 6;
      f32x16 z = zero16();
#pragma unroll
      for (int s = 0; s < 2; ++s) z = dev_mfma32(*(const bf16x8*)(X16 + (64 + r) * 40 + 16 * s + 8 * h), *(const bf16x8*)(BHT + (32 * kb + r) * 40 + 16 * s + 8 * h), z);
      const bf16_t* kh = (const bf16_t*)(smem + PW_KHT) + (32 * kb + r) * 40;
#pragma unroll
      for (int g = 0; g < 4; ++g) { const f32x4 kv = ldp4(kh, 8 * g + 4 * h);
#pragma unroll
        for (int e = 0; e < 4; ++e) z[4 * g + e] = kv[e] - z[4 * g + e]; }
#pragma unroll
      for (int s = 0; s < 2; ++s) *(bf16x8*)(dst + SB_GS + ((kb * 2 + s) * 64 + lane) * 16) = pack8(z, s); }
    if (wave == 3) {
      f32x16 z = zero16();
#pragma unroll
      for (int s = 0; s < 2; ++s) z = dev_mfma32(*(const bf16x8*)(X16 + (64 + r) * 40 + 16 * s + 8 * h), *(const bf16x8*)(NBT + r * 40 + 16 * s + 8 * h), z);
#pragma unroll
      for (int i = 0; i < 16; ++i) z[i] = nk[i] - z[i];
#pragma unroll
      for (int s = 0; s < 2; ++s) *(bf16x8*)(dst + SB_GY + (s * 64 + lane) * 16) = pack8(z, s); }
    if (tid < 256) *(u32x4*)(dst + SB_VT + tid * 16) = *(const u32x4*)(smem + PW_VT + tid * 16); }
  dev_bar();
}
DI void phase_scan_prep(const Params& p, int l, char* smem) { const int G = (int)gridDim.x; int u = (int)blockIdx.x; if (u >= U_PREP) return; PrepDesc ds; prep_desc(TID, ds); prep_issue(p, u, TID, ds, smem);
  for (bool first = true; u < U_PREP; u += G, first = false) prep_chunk(p, l, u, u + G, first, ds, smem);
  dev_vmwait<0>(); dev_bar(); }

constexpr int SQ_RING = 4, SQ_YB = SQ_RING * SB_BYTES;
static_assert(SQ_YB + 2 * CK * 64 * 4 <= 131072 - 256, "scan LDS map");
DI void scan_chain(const Params& p, int chain, char* smem) {
  const int tid = TID, lane = tid & 63, wave = tid >> 6, r = lane & 31, h = lane >> 5; const int d = chain / (NB * 4), b = (chain / 4) % NB, hd = chain % 4;
  const char* scd = (const char*)(wsp<float>(p, A_SCD) + (size_t)((d * NB + b) * 4 + hd) * NK * 192);
  bf16_t* ys = wsp<bf16_t>(p, A_YS) + (size_t)d * MT * 256 + hd * 64; const int sgn = d == 0 ? 1 : -1;
  const int th = tid - 128;
  auto issue = [&](int c) { const char* src = scd + (size_t)dev_uniform(chunk_kmin(c, d)) * 768 + th * 16; char* dst = smem + (c % SQ_RING) * SB_BYTES + (wave - 2) * 1024;
#pragma unroll
    for (int i = 0; i < 4; ++i) dev_glds16(src + i * 6144, dst + i * 6144); };
  auto store_y = [&](int c) { const int m0 = dev_uniform(kpos_row(b, scan_kpos(c * CK, d)));
#pragma unroll
    for (int i = 0; i < 6; ++i) { const int e = (i * 384 + th) & (CK * 64 - 1), st = e >> 6, row = e & 63;
      ys[(size_t)(m0 + sgn * st) * 256 + row] = (bf16_t)f2bf_hw(((const float*)(smem + SQ_YB))[((c & 1) * CK + st) * 64 + row]); } };
  if (wave >= 2) { issue(0); issue(1); issue(2); }
  f32x16 T0 = zero16(), T1 = zero16();
  for (int c = 0; c < NCHK; ++c) {
    if (wave >= 2) { if (c + 2 < NCHK) dev_vmwait<8>(); else dev_vmwait<0>(); }
    dev_bar();
    if (wave < 2) { const int vb = wave; const char* blk = smem + (c % SQ_RING) * SB_BYTES; const bf16_t* vt = (const bf16_t*)(blk + SB_VT) + (32 * vb + r) * 32;
      f32x16 N0 = zero16(), N1 = zero16(), Yt = zero16();
#pragma unroll
      for (int s = 0; s < 2; ++s) { const bf16x8 vf = ld2x8(vt + 16 * s + 4 * h, vt + 16 * s + 8 + 4 * h);
        N0 = dev_mfma32(*(const bf16x8*)(blk + SB_GS + ((0 * 2 + s) * 64 + lane) * 16), vf, N0); N1 = dev_mfma32(*(const bf16x8*)(blk + SB_GS + ((1 * 2 + s) * 64 + lane) * 16), vf, N1);
        Yt = dev_mfma32(*(const bf16x8*)(blk + SB_GY + (s * 64 + lane) * 16), vf, Yt); }
#pragma unroll
      for (int sb = 0; sb < 2; ++sb)
#pragma unroll
        for (int s = 0; s < 2; ++s) { const bf16x8 bh = pack8(sb ? T1 : T0, s), bl = pack8lo(sb ? T1 : T0, s);
          const bf16x8 a0 = *(const bf16x8*)(blk + SB_AS + (((0 * 2 + sb) * 2 + s) * 64 + lane) * 16), a1 = *(const bf16x8*)(blk + SB_AS + (((1 * 2 + sb) * 2 + s) * 64 + lane) * 16), ay = *(const bf16x8*)(blk + SB_AY + ((sb * 2 + s) * 64 + lane) * 16);
          N0 = dev_mfma32(a0, bh, N0); N0 = dev_mfma32(a0, bl, N0); N1 = dev_mfma32(a1, bh, N1); N1 = dev_mfma32(a1, bl, N1); Yt = dev_mfma32(ay, bh, Yt); }
      T0 = N0; T1 = N1;
      float* yb = (float*)(smem + SQ_YB) + (c & 1) * CK * 64;
#pragma unroll
      for (int i = 0; i < 16; ++i) yb[crow(i, h) * 64 + 32 * vb + r] = Yt[i]; }
    if (wave >= 2) { if (c > 0) store_y(c - 1); if (c + 3 < NCHK) issue(c + 3); }
  }
  dev_bar();
  if (wave >= 2) store_y(NCHK - 1);
  dev_vmwait<0>();
  dev_bar();
}

constexpr int U_SCAN = 2 * NB * 4, U_MLA = NB * 4 * (T / 256), U_GQA = GQ_UNITS + GQ_SPLIT  , U_NAT = NB * 4 * (GROWS / 4);
constexpr int U_CGQA = NB * 2 * (C / 128), U_CMLA = NB * 4 * (C / 256), U_CNAT = NB * 4 * (C / 256);
DI void phase_mixer(const Params& p, int l, char* smem, int mode = 0, int qsel = 0) {
  const int tid = TID, wave = tid >> 6; int* qslot = (int*)(smem + 131072 - 256);
  const int total = U_SCAN + U_MLA + U_GQA + U_NAT + (l == 0 ? U_CGQA + U_CMLA + U_CNAT : 0);
  const bf16_t *QG = wsp<bf16_t>(p, A_QG), *KG = wsp<bf16_t>(p, A_KG), *QKVN = wsp<bf16_t>(p, A_QKVN), *KM = wsp<bf16_t>(p, A_KM), *QM = wsp<bf16_t>(p, A_QM), *VM = wsp<bf16_t>(p, A_VM); bf16_t* Y = wsp<bf16_t>(p, A_Y);
  const float SC64 = 0.125f * LOG2E, SC96 = 0.10206207261596575f * LOG2E;
  for (;;) {
    if (tid == 0) *qslot = (int)dev_atomic_add(wsp<unsigned>(p, WS_CTL) + CW_QUEUE + 64 * (l + 2 * qsel), 1u);
    __syncthreads();
    int u = *qslot;
    __syncthreads();
    if (u >= total) break;
    if (mode == 1 && u >= U_SCAN) continue;
    if (mode == 2 && u < U_SCAN) continue;
    if (u < U_SCAN) { scan_chain(p, u, smem); continue; } u -= U_SCAN;
    if (u < U_MLA) { const int qb = u % (T / 256), hd = (u / (T / 256)) % 4, b = u / (4 * (T / 256)); const int m0 = b * T + qb * 256 + wave * 32;
      attn2_unit<6, 8>(smem, QM + (size_t)m0 * 384 + hd * 96, 384, Y + (size_t)m0 * D + 512 + hd * 64, D, KM + hd * 96, 384, VM + hd * 64, 256, b); continue; } u -= U_MLA;
    if (u < U_GQA) { const int half = u >= GQ_UNITS - GQ_SPLIT ? (u - (GQ_UNITS - GQ_SPLIT)) & 1 : -1, su = (u - (GQ_UNITS - GQ_SPLIT)) >> 1; const int uu = half < 0 ? u : GQ_UNITS - GQ_SPLIT + su;
      const int qb = uu % (T / 128), g = (uu / (T / 128)) % 2, b = uu / (2 * (T / 128)); const int hd = 2 * g + (wave >> 2), m0 = b * T + qb * 128 + (wave & 3) * 32;
      if (half < 0) attn2_unit<4, 8>(smem, QG + (size_t)m0 * 256 + hd * 64, 256, Y + (size_t)m0 * D + 256 + hd * 64, D, KG + g * 64, 128, QKVN + 768 + g * 64, 896, b);
      else attn2_unit<4, 8, true>(smem, QG + (size_t)m0 * 256 + hd * 64, 256, wsp<bf16_t>(p, A_GPO) + (size_t)((su * 2 + half) * 8 + wave) * 2048, 64, KG + g * 64, 128, QKVN + 768 + g * 64, 896, b, half,
                            wsp<float>(p, A_GST) + (size_t)((su * 2 + half) * 8 + wave) * 64);
      continue; } u -= U_GQA;
    if (u < U_NAT) { const int rb = u % (GROWS / 4), hd = (u / (GROWS / 4)) % 4, b = u / (4 * (GROWS / 4)); const int qi = 4 * rb + (wave >> 1), c0 = 32 * (wave & 1), m0 = b * T + 64 * qi + c0;
      auto clampr = [](int i) { return i - 4 < 0 ? 0 : (i - 4 > GROWS - 8 ? GROWS - 8 : i - 4); };
      const int kr_lo = clampr(4 * rb), kr_hi = clampr(4 * rb + 3) + 7, nwin = kr_hi - kr_lo + 1;
      for (int e = tid; e < 15 * 31; e += 512) ((float*)(smem + ATT_BIAS))[e] = p.in(I_NATB)[((size_t)(l * 4 + hd) * 15) * 31 + e];
      __syncthreads();
      auto tf = [&](int i) { if (i < nwin) { const int m = b * T + 64 * (kr_lo + i); return TileSrc{QKVN + (size_t)m * 896 + 256 + hd * 64, QKVN + (size_t)m * 896 + 512 + hd * 64, kr_lo + i}; }
        const int m = TL + b * C + 64 * (i - nwin); return TileSrc{QKVN + (size_t)m * 896 + 256 + hd * 64, QKVN + (size_t)m * 896 + 512 + hd * 64, -1}; };
      attn_unit<64, true>(smem, QKVN + (size_t)m0 * 896 + hd * 64, 896, Y + (size_t)m0 * D + 768 + hd * 64, D, nwin + C / 64, tf, 896, 896, SC64, qi, c0); continue; } u -= U_NAT;
    if (u < U_CGQA) { const int qb = u % (C / 128), g = (u / (C / 128)) % 2, b = u / (2 * (C / 128)); const int hd = 2 * g + (wave >> 2), m0 = TL + b * C + qb * 128 + (wave & 3) * 32;
      auto tf = [&](int i) { const int m = TL + b * C + 64 * i; return TileSrc{KG + (size_t)m * 128 + g * 64, QKVN + (size_t)m * 896 + 768 + g * 64, -1}; };
      attn_unit<64, false>(smem, QG + (size_t)m0 * 256 + hd * 64, 256, Y + (size_t)m0 * D + 256 + hd * 64, D, C / 64, tf, 128, 896, 1.0f, 0, 0); continue; } u -= U_CGQA;
    if (u < U_CMLA) { const int qb = u % (C / 256), hd = (u / (C / 256)) % 4, b = u / (4 * (C / 256)); const int m0 = TL + b * C + qb * 256 + wave * 32;
      auto tf = [&](int i) { const int m = TL + b * C + 64 * i; return TileSrc{KM + (size_t)m * 384 + hd * 96, VM + (size_t)m * 256 + hd * 64, -1}; };
      attn_unit<96, false>(smem, QM + (size_t)m0 * 384 + hd * 96, 384, Y + (size_t)m0 * D + 512 + hd * 64, D, C / 64, tf, 384, 256, 1.0f, 0, 0); continue; } u -= U_CMLA;
    { const int qb = u % (C / 256), hd = (u / (C / 256)) % 4, b = u / (4 * (C / 256)); const int m0 = TL + b * C + qb * 256 + wave * 32;
      auto tf = [&](int i) { const int m = TL + b * C + 64 * i; return TileSrc{QKVN + (size_t)m * 896 + 256 + hd * 64, QKVN + (size_t)m * 896 + 512 + hd * 64, -1}; };
      attn_unit<64, false>(smem, QKVN + (size_t)m0 * 896 + hd * 64, 896, Y + (size_t)m0 * D + 768 + hd * 64, D, C / 64, tf, 896, 896, SC64, 0, 0); }
  }
}
#ifndef EMU
template <class F> struct EpiFn {
  static constexpr bool PERM = true, AFTER_DRAIN = false; F f;
  __device__ __forceinline__ void operator()(const pg8::f32x4 (&acc)[2][2][4][2], const pg8::Unit& u, int wr, int wc, int fr, int fq) const {
    int fr_ = fr, fq_ = fq; asm volatile("" : "+v"(fr_), "+v"(fq_));
    const int row0 = u.pm * 256 + wr * 64 + fr_, col0 = u.pc * 256 + wc * 32 + 8 * fq_;
#pragma unroll
    for (int ai = 0; ai < 2; ++ai)
#pragma unroll
      for (int m = 0; m < 4; ++m)
#pragma unroll
        for (int bj = 0; bj < 2; ++bj) { const pg8::f32x4 a = acc[ai][bj][m][0], b = acc[ai][bj][m][1]; const float v[8] = {a[0], a[1], a[2], a[3], b[0], b[1], b[2], b[3]};
          f.store8(u.pm * 256, row0 + ai * 128 + m * 16, col0 + bj * 128, v); __builtin_amdgcn_sched_barrier(0); }
  }
};
struct EpiLoraFn {
  static constexpr bool PERM = true, AFTER_DRAIN = false; EpiLora f;
  __device__ __forceinline__ void operator()(const pg8::f32x4 (&acc)[2][2][4][2], const pg8::Unit& u, int wr, int wc, int fr, int fq) const {
    int fr_ = fr, fq_ = fq; asm volatile("" : "+v"(fr_), "+v"(fq_));
    const int urow = u.pm * 256, row0 = urow + wr * 64 + fr_, cc0 = wc * 32 + 8 * fq_; const int blk = __builtin_amdgcn_readfirstlane(u.pc);
    const int b = row_batch(urow), kpos0 = row_kpos(urow) + (row0 - urow); const Params& p = *f.p; const int l = f.l;
#define LORA_V8(ai, m, bj) const pg8::f32x4 a_ = acc[ai][bj][m][0], b_ = acc[ai][bj][m][1]; const float v[8] = {a_[0], a_[1], a_[2], a_[3], b_[0], b_[1], b_[2], b_[3]}
    if (blk < 2) { f32x4 wv[2][2];
#pragma unroll
      for (int bj = 0; bj < 2; ++bj) { const float* w0 = p.in(I_W0) + (l * 2 + blk) * 256 + cc0 + bj * 128; wv[bj][0] = *(const f32x4*)w0; wv[bj][1] = *(const f32x4*)(w0 + 4); }
#pragma unroll
      for (int ai = 0; ai < 2; ++ai)
#pragma unroll
        for (int m = 0; m < 4; ++m)
#pragma unroll
          for (int bj = 0; bj < 2; ++bj) { LORA_V8(ai, m, bj); const int cc = cc0 + bj * 128; f32x4 oa, ob; lora_lw8(v, wv[bj][0], wv[bj][1], oa, ob);
            float* dst = f.lw_dst(blk, b, cc >> 6, kpos0 + ai * 128 + m * 16, cc & 63); *(f32x4*)dst = oa; *(f32x4*)(dst + 4) = ob; __builtin_amdgcn_sched_barrier(0); }
    } else if (blk < 4) { const int d = blk - 2; f32x4 a0v[2][2], kav[2][2];
#pragma unroll
      for (int bj = 0; bj < 2; ++bj) { const float* a0 = p.in(I_A0) + (l * 2 + d) * 256 + cc0 + bj * 128; const float* ka = p.in(I_KA) + l * 256 + cc0 + bj * 128;
        a0v[bj][0] = *(const f32x4*)a0; a0v[bj][1] = *(const f32x4*)(a0 + 4); kav[bj][0] = *(const f32x4*)ka; kav[bj][1] = *(const f32x4*)(ka + 4); }
#pragma unroll
      for (int ai = 0; ai < 2; ++ai)
#pragma unroll
        for (int mh = 0; mh < 2; ++mh) { LoraIn in[2][2];
#pragma unroll
          for (int mm = 0; mm < 2; ++mm)
#pragma unroll
            for (int bj = 0; bj < 2; ++bj) { const int cc = cc0 + bj * 128, ro = ai * 128 + (2 * mh + mm) * 16; f.bk_load(b, cc >> 6, kpos0 + ro, cc & 63, row0 + ro, cc, in[mm][bj]); }
          __builtin_amdgcn_sched_barrier(0);
#pragma unroll
          for (int mm = 0; mm < 2; ++mm)
#pragma unroll
            for (int bj = 0; bj < 2; ++bj) { const int m = 2 * mh + mm; LORA_V8(ai, m, bj); const int cc = cc0 + bj * 128, ro = ai * 128 + m * 16; u32x4 wb, wk; lora_bk8(v, a0v[bj], kav[bj], in[mm][bj], wb, wk);
              bf16_t* dst = f.bk_dst(d, b, cc >> 6, kpos0 + ro, cc & 63); *(u32x4*)dst = wb; *(u32x4*)(dst + 64) = wk; }
          __builtin_amdgcn_sched_barrier(0); }
    } else {
#pragma unroll
      for (int ai = 0; ai < 2; ++ai)
#pragma unroll
        for (int m = 0; m < 4; ++m)
#pragma unroll
          for (int bj = 0; bj < 2; ++bj) { const pg8::f32x4 a = acc[ai][bj][m][0], b2 = acc[ai][bj][m][1]; u32x4 w; w.x = pk2(a[0], a[1]); w.y = pk2(a[2], a[3]); w.z = pk2(b2[0], b2[1]); w.w = pk2(b2[2], b2[3]);
            *(u32x4*)(wsp<bf16_t>(p, A_RWG) + (size_t)(row0 + ai * 128 + m * 16) * 256 + cc0 + bj * 128) = w; __builtin_amdgcn_sched_barrier(0); }
    }
#undef LORA_V8
  }
};
struct InProjRoute { bf16_t* P; bf16_t* QKVN;
  __device__ __forceinline__ bool route(int cbase, bf16_t*& base, int& pitch) const { if (cbase >= 2720) return false;
    if (cbase >= 1952) { base = QKVN + (cbase - 1952); pitch = 896; } else if (cbase >= 1408 && cbase < 1536) { base = QKVN + 768 + (cbase - 1408); pitch = 896; } else { base = P + cbase; pitch = PW; } return true; } };
struct PlainRoute { bf16_t* O; int ld;
  __device__ __forceinline__ bool route(int cbase, bf16_t*& base, int& pitch) const { base = O + cbase; pitch = ld; return true; } };
template <class R> struct EpiRouteFn {
  static constexpr bool PERM = true, AFTER_DRAIN = false; R r;
  __device__ __forceinline__ void operator()(const pg8::f32x4 (&acc)[2][2][4][2], const pg8::Unit& u, int wr, int wc, int fr, int fq) const {
    int fr_ = fr, fq_ = fq; asm volatile("" : "+v"(fr_), "+v"(fq_));
    const int row0 = u.pm * 256 + wr * 64 + fr_;
#pragma unroll
    for (int bj = 0; bj < 2; ++bj) { const int cbase = __builtin_amdgcn_readfirstlane(u.pc * 256 + wc * 32 + bj * 128); bf16_t* base; int pitch; if (!r.route(cbase, base, pitch)) continue;
      char* lanep = (char*)(base + (size_t)row0 * pitch + 8 * fq_); const size_t rstep = (size_t)pitch * 32;
#pragma unroll
      for (int ai = 0; ai < 2; ++ai)
#pragma unroll
        for (int m = 0; m < 4; ++m) { const pg8::f32x4 a = acc[ai][bj][m][0], b = acc[ai][bj][m][1]; u32x4 w; w.x = pk2(a[0], a[1]); w.y = pk2(a[2], a[3]); w.z = pk2(b[0], b[1]); w.w = pk2(b[2], b[3]);
          *(u32x4*)(lanep + (size_t)(ai * 8 + m) * rstep) = w; __builtin_amdgcn_sched_barrier(0); } }
  }
};
struct EpiSwiGluFn {
  static constexpr bool PERM = true, AFTER_DRAIN = false; bf16_t* O; int ld;
  __device__ __forceinline__ void operator()(const pg8::f32x4 (&acc)[2][2][4][2], const pg8::Unit& u, int wr, int wc, int fr, int fq) const {
    int fr_ = fr, fq_ = fq; asm volatile("" : "+v"(fr_), "+v"(fq_));
    const int row0 = u.pm * 256 + wr * 64 + fr_; const size_t rstep = (size_t)ld * 32;
#pragma unroll
    for (int bj = 0; bj < 2; ++bj) { const int cbase = __builtin_amdgcn_readfirstlane(u.pc * 256 + wc * 32 + bj * 128); char* lanep = (char*)(O + (size_t)row0 * ld + (cbase >> 1) + 4 * fq_);
#pragma unroll
      for (int ai = 0; ai < 2; ++ai)
#pragma unroll
        for (int m = 0; m < 4; ++m) { const pg8::f32x4 a = acc[ai][bj][m][0], b = acc[ai][bj][m][1]; u32x2 w; w.x = pk2(siluf_(a[0]) * a[1], siluf_(a[2]) * a[3]); w.y = pk2(siluf_(b[0]) * b[1], siluf_(b[2]) * b[3]);
          *(u32x2*)(lanep + (size_t)(ai * 8 + m) * rstep) = w; __builtin_amdgcn_sched_barrier(0); } }
  }
};
struct LoraOrder : pg8::StaticOrder {
  __device__ __forceinline__ bool next(int i, pg8::Unit& u) const { if (!pg8::StaticOrder::next(i, u)) return false; u.ko = (u.pn == 4) ? 128 : 0; return true; }
};
struct SliceOrder {
  int nM, nN, nS, sliceK, G, c;
  __device__ __forceinline__ bool next(int i, pg8::Unit& u) const {
    const long L = (long)i * G + c; if (L >= (long)nM * nN * nS) return false;
    const int ks = (int)(L % nS), t = (int)(L / nS); u.pn = t % nN; u.pm = t / nN; u.pc = u.pn; u.ks = ks; u.ko = ks * sliceK; return true;
  }
  __device__ __forceinline__ void a_ready(const pg8::Unit&) const {}
  __device__ __forceinline__ void done(const pg8::Unit&) const {}
};
struct EpiSlab {
  static constexpr bool PERM = true, AFTER_DRAIN = false; float* O; int ld; size_t slab;
  __device__ __forceinline__ void operator()(const pg8::f32x4 (&acc)[2][2][4][2], const pg8::Unit& u, int wr, int wc, int fr, int fq) const {
    int fr_ = fr, fq_ = fq; asm volatile("" : "+v"(fr_), "+v"(fq_));
    const int row0 = u.pm * 256 + wr * 64 + fr_, col0 = u.pc * 256 + wc * 32 + 8 * fq_; float* base = O + (size_t)u.ks * slab;
#pragma unroll
    for (int ai = 0; ai < 2; ++ai)
#pragma unroll
      for (int m = 0; m < 4; ++m)
#pragma unroll
        for (int bj = 0; bj < 2; ++bj) { float* o = base + (size_t)(row0 + ai * 128 + m * 16) * ld + col0 + bj * 128; *(pg8::f32x4*)o = acc[ai][bj][m][0]; *(pg8::f32x4*)(o + 4) = acc[ai][bj][m][1]; __builtin_amdgcn_sched_barrier(0); }
  }
};
struct EpiSlabBf16 {
  static constexpr bool PERM = true, AFTER_DRAIN = false; bf16_t* O; int ld; size_t slab;
  __device__ __forceinline__ void operator()(const pg8::f32x4 (&acc)[2][2][4][2], const pg8::Unit& u, int wr, int wc, int fr, int fq) const {
    int fr_ = fr, fq_ = fq; asm volatile("" : "+v"(fr_), "+v"(fq_));
    const int row0 = u.pm * 256 + wr * 64 + fr_, col0 = u.pc * 256 + wc * 32 + 8 * fq_; bf16_t* base = O + (size_t)u.ks * slab;
#pragma unroll
    for (int ai = 0; ai < 2; ++ai)
#pragma unroll
      for (int m = 0; m < 4; ++m)
#pragma unroll
        for (int bj = 0; bj < 2; ++bj) { const pg8::f32x4 a = acc[ai][bj][m][0], b = acc[ai][bj][m][1]; u32x4 w; w.x = pk2(a[0], a[1]); w.y = pk2(a[2], a[3]); w.z = pk2(b[0], b[1]); w.w = pk2(b[2], b[3]);
          *(u32x4*)(base + (size_t)(row0 + ai * 128 + m * 16) * ld + col0 + bj * 128) = w; __builtin_amdgcn_sched_barrier(0); }
  }
};
struct GroupedOrder {
  int off[NE + 1]; int nN, G, c; int lim = 1 << 20;
  __device__ __forceinline__ bool next(int i, pg8::Unit& u) const {
    const long L = (long)i * G + c; int ntile = off[NE] >> 8; ntile = ntile < lim ? ntile : lim; if (L >= (long)ntile * nN) return false;
    const int pm = (int)(L / nN), pl = (int)(L % nN); int e = 0;
#pragma unroll
    for (int k = 1; k < NE; ++k) e += (pm * 256 >= off[k]) ? 1 : 0;
    u.pm = pm; u.pc = pl; u.pn = e * nN + pl; u.ko = 0; u.ks = 0; return true;
  }
  __device__ __forceinline__ void a_ready(const pg8::Unit&) const {}
  __device__ __forceinline__ void done(const pg8::Unit&) const {}
};

struct GroupedSliceOrder {
  int off[NE + 1]; int nN, G, c, t0, nS, sliceK;
  __device__ __forceinline__ bool next(int i, pg8::Unit& u) const {
    const int L = i * G + c; const int ntile = off[NE] >> 8; if (ntile <= t0 || L >= (ntile - t0) * nN * nS) return false;
    const int ks = L % nS, t = L / nS, pl = t % nN, pm = t0 + t / nN; int e = 0;
#pragma unroll
    for (int k = 1; k < NE; ++k) e += (pm * 256 >= off[k]) ? 1 : 0;
    u.pm = pm; u.pc = pl; u.pn = e * nN + pl; u.ks = ks; u.ko = ks * sliceK; return true;
  }
  __device__ __forceinline__ void a_ready(const pg8::Unit&) const {}
  __device__ __forceinline__ void done(const pg8::Unit&) const {}
};
#ifdef NO_GEMM
#define GEMM_PHASE(...) do {} while (0)
#else
#define GEMM_PHASE(...) pg8::gemm_phase<__VA_ARGS__>
#define GEMM_TWICE(...) do { __VA_ARGS__; if (PROBE_REP == 4) { __VA_ARGS__; } } while (0)
#define GEMM_TWICE_ID(id, ...) do { __VA_ARGS__; if (PROBE_REP == 4 || PROBE_REP == (id)) { __VA_ARGS__; } } while (0)
#endif
#ifdef NO_MIX
#define MIX_PHASE(...) do {} while (0)
#else
#define MIX_PHASE(...) phase_mixer(__VA_ARGS__)
#endif
#ifdef NO_ROW
#define ROW(x) do {} while (0)
#else
#define ROW(x) x
#endif
constexpr int LDS_BYTES = 147456, MISC_OFF = 131072 + 320;
#ifndef PROBE_REP
#define PROBE_REP 0
#endif
#ifndef MK_CUTS
#define MK_CUTS 0
#endif
constexpr int N_PHASES = 26;

#define IN(k) (lo <= (k) && (k) < hi)
#define SEAM(k) do { if (IN(k) && IN((k) + 1)) { xcd_barrier(bar); if (PROBE_REP == 8) xcd_barrier(bar); } } while (0)
template <int L> __device__ __forceinline__ void run_layer(const Params& p, char* smem, PG8_LAS unsigned char* glds, const XcdBarrier& bar, int lo, int hi, int G, int cb) {
  constexpr int l = L; constexpr int pb = 2 + 12 * l;
    if (IN(pb + 0)) { pg8::Gemm g{(const pg8::bf16_t*)(p.ws + A_XN), (const pg8::bf16_t*)(p.ws + WS_WIN) + (size_t)l * PW * D, MT, PW, D}; pg8::StaticOrder S; S.init(MT, PW, G, cb);
      EpiRouteFn<InProjRoute> E{{wsp<bf16_t>(p, A_P), wsp<bf16_t>(p, A_QKVN)}}; GEMM_TWICE_ID(10, GEMM_PHASE(EpiRouteFn<InProjRoute>, pg8::StaticOrder, true, true)(glds, g, S, E)); } SEAM(pb + 0);
    if (IN(pb + 1)) { ROW(phase_prep(p, l)); if (PROBE_REP == 7) phase_prep(p, l); } SEAM(pb + 1);
    if (IN(pb + 2)) {
      { pg8::Gemm g{(const pg8::bf16_t*)(p.ws + A_RWA), (const pg8::bf16_t*)(p.ws + WS_WLORA) + (size_t)l * 1280 * 256, MT, 1280, 128, 256}; LoraOrder S; S.init(MT, 1280, G, cb);
        EpiLoraFn E{{&p, l}}; GEMM_TWICE_ID(17, GEMM_PHASE(EpiLoraFn, LoraOrder, true, true)(glds, g, S, E)); }
      { pg8::Gemm g{(const pg8::bf16_t*)(p.ws + A_CQN), (const pg8::bf16_t*)(p.ws + WS_WUQ) + (size_t)l * 512 * 256, MT, 512, 256}; pg8::StaticOrder S; S.init(MT, 512, G, (cb + 168) % G);
        EpiFn<EpiMlaQ> E{{&p}}; GEMM_TWICE_ID(18, GEMM_PHASE(EpiFn<EpiMlaQ>, pg8::StaticOrder, true, true)(glds, g, S, E)); }
      { pg8::Gemm g{(const pg8::bf16_t*)(p.ws + A_CKVN), (const pg8::bf16_t*)(p.ws + WS_WUKV) + (size_t)l * 512 * 128, MT, 512, 128}; pg8::StaticOrder S; S.init(MT, 512, G, (cb + 32) % G);
        EpiFn<EpiMlaKV> E{{&p}}; GEMM_TWICE_ID(19, GEMM_PHASE(EpiFn<EpiMlaKV>, pg8::StaticOrder, true, true)(glds, g, S, E)); }
    } SEAM(pb + 2);
    if (IN(pb + 3)) { ROW(phase_scan_prep(p, l, smem)); } SEAM(pb + 3);
    if (IN(pb + 4)) { MIX_PHASE(p, l, smem);
      if (PROBE_REP >= 1 && PROBE_REP <= 3) { xcd_barrier(bar); phase_mixer(p, l, smem, PROBE_REP - 1, 1); } } SEAM(pb + 4);
    if (IN(pb + 5)) { ROW(phase_rwkv_out(p, l)); if (PROBE_REP == 7) phase_rwkv_out(p, l); } SEAM(pb + 5);
    if (IN(pb + 6)) {
      { pg8::Gemm g{(const pg8::bf16_t*)(p.ws + A_Y), (const pg8::bf16_t*)(p.ws + WS_WOUT) + (size_t)l * D * D, TL, D, D}; pg8::StaticOrder S; S.init(TL, D, G, cb);
        EpiRouteFn<PlainRoute> E{{wsp<bf16_t>(p, A_YO), D}}; GEMM_TWICE_ID(12, GEMM_PHASE(EpiRouteFn<PlainRoute>, pg8::StaticOrder, true, true)(glds, g, S, E)); }
      if constexpr (l == 0) { pg8::Gemm g{(const pg8::bf16_t*)(p.ws + A_Y) + (size_t)TL * D, (const pg8::bf16_t*)(p.ws + WS_WOUT) + (size_t)l * D * D, TC, D, 256, D}; SliceOrder S{TC / 256, D / 256, OS_NS, 256, G, (cb + 128) % G};
        EpiSlabBf16 E{wsp<bf16_t>(p, A_YOS), D, (size_t)TC * D}; GEMM_PHASE(EpiSlabBf16, SliceOrder, true, true)(glds, g, S, E); }
      if constexpr (l == 1) { ROW(moe_convert(p, smem)); if (PROBE_REP == 6) { __syncthreads(); moe_convert(p, smem); } } } SEAM(pb + 6);
    if (IN(pb + 7)) { ROW(phase_post_mixer(p, l, smem)); } SEAM(pb + 7);
    if constexpr (l == 0) {
      if (IN(pb + 8)) { pg8::Gemm g{(const pg8::bf16_t*)(p.ws + A_XN), (const pg8::bf16_t*)(p.ws + WS_WGU), MT, 2 * FF, D}; pg8::StaticOrder S; S.init(MT, 2 * FF, G, cb);
        EpiSwiGluFn E{wsp<bf16_t>(p, A_ACT), FF}; GEMM_TWICE_ID(13, GEMM_PHASE(EpiSwiGluFn, pg8::StaticOrder, true, true)(glds, g, S, E)); } SEAM(pb + 8);
      if (IN(pb + 9)) {
        { pg8::Gemm g{(const pg8::bf16_t*)(p.ws + A_ACT), (const pg8::bf16_t*)(p.ws + WS_WDN), TL, D, FF}; pg8::StaticOrder S; S.init(TL, D, G, cb);
          EpiRouteFn<PlainRoute> E{{wsp<bf16_t>(p, A_F), D}}; GEMM_TWICE_ID(14, GEMM_PHASE(EpiRouteFn<PlainRoute>, pg8::StaticOrder, true, true)(glds, g, S, E)); }
        { pg8::Gemm g{(const pg8::bf16_t*)(p.ws + A_ACT) + (size_t)TL * FF, (const pg8::bf16_t*)(p.ws + WS_WDN), TC, D, 256, FF}; SliceOrder S{TC / 256, D / 256, FS_NS, 256, G, (cb + 64) % G};
          EpiSlabBf16 E{wsp<bf16_t>(p, A_FS), D, (size_t)TC * D}; GEMM_PHASE(EpiSlabBf16, SliceOrder, true, true)(glds, g, S, E); } } SEAM(pb + 9);
      if (IN(pb + 10)) { ROW(phase_post_ffn0(p)); } SEAM(pb + 10);
    } else {
      if (IN(pb + 8)) { ROW(phase_moe_gather(p, l)); if (PROBE_REP == 21) phase_moe_gather(p, l); } SEAM(pb + 8);
      if (IN(pb + 9)) { GroupedOrder S; moe_offsets(p, S.off); S.nN = 2 * FF / 256; S.G = G; S.c = cb;
        pg8::Gemm g{(const pg8::bf16_t*)(p.ws + A_XG), (const pg8::bf16_t*)(p.ws + A_MWGU), XG_ROWS, NE * 2 * FF, D};
        EpiSwiGluFn E{wsp<bf16_t>(p, A_ACTG), FF}; GEMM_TWICE_ID(15, GEMM_PHASE(EpiSwiGluFn, GroupedOrder, true, true)(glds, g, S, E)); } SEAM(pb + 9);
      if (IN(pb + 10)) {
        { GroupedOrder S; moe_offsets(p, S.off); S.nN = D / 256; S.G = G; S.c = cb; S.lim = MOE_NFULL;
          pg8::Gemm g{(const pg8::bf16_t*)(p.ws + A_ACTG), (const pg8::bf16_t*)(p.ws + A_MWDN), XG_ROWS, NE * D, FF};
          EpiRouteFn<PlainRoute> E{{wsp<bf16_t>(p, A_XG), D}}; GEMM_TWICE_ID(16, GEMM_PHASE(EpiRouteFn<PlainRoute>, GroupedOrder, true, true)(glds, g, S, E)); }
        { GroupedSliceOrder S; moe_offsets(p, S.off); S.nN = D / 256; S.G = G; S.c = cb; S.t0 = MOE_NFULL; S.nS = MOE_NS; S.sliceK = MOE_SK;
          pg8::Gemm g{(const pg8::bf16_t*)(p.ws + A_ACTG), (const pg8::bf16_t*)(p.ws + A_MWDN), XG_ROWS, NE * D, MOE_SK, FF};
          EpiSlab E{wsp<float>(p, WS_MSLAB) - (size_t)MOE_NFULL * 256 * D, D, (size_t)MOE_TAILROWS * D}; GEMM_PHASE(EpiSlab, GroupedSliceOrder, true, true)(glds, g, S, E); }
      } SEAM(pb + 10);
      if (IN(pb + 11)) { ROW(phase_moe_combine(p, l)); }
    }

}
struct Args { const float* in[N_IN]; float* out; unsigned char* ws; int ph_lo, ph_hi; };
static_assert(sizeof(Args) == (N_IN + 2) * 8 + 8, "no padding holes in the argument struct");
constexpr int INTAB_OFF = 131072 + 1024;

__global__ void __launch_bounds__(512, 2) fwd_kernel(Args args) {
  extern __shared__ __attribute__((aligned(16))) unsigned char lds[];
  char* smem = (char*)lds;
  const int tid = threadIdx.x;
  Params p; p.in_ = (LAS cfptr_t*)((LAS unsigned char*)lds + INTAB_OFF); p.out = args.out; p.ws = args.ws;
  for (int u = tid; u < (LDS_BYTES - 131072) / 4; u += 512) ((LAS unsigned*)((LAS unsigned char*)lds + 131072))[u] = 0u;
  if (tid < N_IN) p.in_[tid] = args.in[tid];
  __syncthreads();
  unsigned* ctl = (unsigned*)(p.ws + WS_CTL);
  XcdBarrier bar; bar.bar = ctl + CW_BAR; bar.x = 0; bar.st = nullptr;
  const int lo = args.ph_lo, hi = args.ph_hi;
  if (hi - lo > 1) bar = xcd_barrier_post(ctl + CW_BAR, (volatile LAS unsigned*)((LAS unsigned char*)lds + MISC_OFF) + 8);
  const int G = gridDim.x, cb = blockIdx.x;
  PG8_LAS unsigned char* glds = (PG8_LAS unsigned char*)lds;

  if (IN(0)) { ROW(phase_prologue(p, smem)); if (PROBE_REP == 5) { __syncthreads(); phase_prologue(p, smem); } } SEAM(0);
  if (IN(1)) { ROW(phase_adaln0(p)); if (PROBE_REP == 20) phase_adaln0(p); } SEAM(1);
  run_layer<0>(p, smem, glds, bar, lo, hi, G, cb);
  run_layer<1>(p, smem, glds, bar, lo, hi, G, cb);
#undef IN
#undef SEAM
}

extern "C" void kernel_launch(void* const* d_in, const int* in_sizes, int n_in, void* d_out, int out_size, void* d_ws, size_t ws_size, hipStream_t stream) {
  static int grid = 0;
  if (grid == 0) {
    if (n_in != N_IN || in_sizes[I_X] != TL * D || out_size != TL * D || ws_size < WS_NEED) { fprintf(stderr, "kernel_launch: unexpected shapes / workspace (%zu needed, %zu given)\n", (size_t)WS_NEED, ws_size); grid = -1; return; }
    int dev = 0, cus = 0, per_cu = 0;
    if (hipGetDevice(&dev) != hipSuccess || hipDeviceGetAttribute(&cus, hipDeviceAttributeMultiprocessorCount, dev) != hipSuccess) { grid = -1; return; }
    if (hipFuncSetAttribute((const void*)fwd_kernel, hipFuncAttributeMaxDynamicSharedMemorySize, LDS_BYTES) != hipSuccess) { grid = -1; return; }
    if (hipOccupancyMaxActiveBlocksPerMultiprocessor(&per_cu, (const void*)fwd_kernel, 512, LDS_BYTES) != hipSuccess || per_cu < 1) { fprintf(stderr, "kernel_launch: occupancy query says %d\n", per_cu); }
    (void)hipGetLastError();
    grid = cus;
  }
  if (grid < 0) return;
  if (hipMemsetAsync((char*)d_ws + WS_CTL, 0, CTL_BYTES, stream) != hipSuccess) return;
  Args a{};
  for (int i = 0; i < N_IN; ++i) a.in[i] = (const float*)d_in[i];
  a.out = (float*)d_out; a.ws = (unsigned char*)d_ws;
#if MK_CUTS
  for (int ph = 0; ph < N_PHASES; ++ph) { if (ph == 13) continue; a.ph_lo = ph; a.ph_hi = ph + 1; hipLaunchKernelGGL(fwd_kernel, dim3(grid), dim3(512), LDS_BYTES, stream, a); }
#else
  a.ph_lo = 0; a.ph_hi = N_PHASES; hipLaunchKernelGGL(fwd_kernel, dim3(grid), dim3(512), LDS_BYTES, stream, a);
#endif
}
#endif
```
